# Optimizing an MI355X kernel written in HIP

```python
import jax, jax.numpy as jnp
from jax import lax
import numpy as np

D_MODEL = 1024
BATCH = 8
SEQ = 8192
DEPTH = 2

CTX_LEN = 256
GRID_W = 64
HEAD_DIM = 64
ROPE_THETA = 10000.0
NORM_EPS = 1e-6
A_HEADS = 8
A_KV_HEADS = 2
B_HEADS = 8
B_KV_HEADS = 2
WINDOW = 128
BLOCK = 128
AB_Q_COLS = (A_HEADS + B_HEADS) * HEAD_DIM
AB_KV_COLS = 2 * (A_KV_HEADS + B_KV_HEADS) * HEAD_DIM
AB_IN = AB_Q_COLS + AB_KV_COLS
AB_OUT = (A_HEADS + B_HEADS) * HEAD_DIM
C_HEADS = 12
C_WIDTH = C_HEADS * HEAD_DIM
DECAY_LORA = 64
ICLR_LORA = 64
GATE_LORA = 128
LNX_EPS = 64e-5
C_SPLITS = (C_WIDTH, C_WIDTH, C_WIDTH, DECAY_LORA, DECAY_LORA, ICLR_LORA, ICLR_LORA, GATE_LORA)
C_IN = sum(C_SPLITS)
D_GROUPS = 4
D_GROUP_DIM = 64
D_WIDTH = D_GROUPS * D_GROUP_DIM
POOL_WINDOWS = (2, 4, 8, 16)
CD_IN = C_IN + D_WIDTH
CD_OUT = C_WIDTH + D_WIDTH
FFN_HIDDEN = -(-8 * D_MODEL // (3 * 256)) * 256

kernel_name = "hybrid_prefix_dit_block"


def rms_norm(x, gain, eps=NORM_EPS):
    xf = x.astype(jnp.float32)
    y = xf * lax.rsqrt(jnp.mean(xf * xf, axis=-1, keepdims=True) + eps)
    return (y * gain.astype(jnp.float32)).astype(x.dtype)


def modulate(h, shift, scale):
    return h * (1.0 + scale) + shift


def swiglu(h, w_in, w_out):
    gate, up = jnp.split(h @ w_in, 2, axis=-1)
    return (jax.nn.silu(gate) * up) @ w_out


def axial_rope_tables(n):
    rows = n // GRID_W
    row = jnp.repeat(jnp.arange(rows, dtype=jnp.float32), GRID_W)
    col = jnp.tile(jnp.arange(GRID_W, dtype=jnp.float32), rows)
    n_freq = HEAD_DIM // 4
    inv = ROPE_THETA ** (-jnp.arange(n_freq, dtype=jnp.float32) / n_freq)
    ang = jnp.concatenate([row[:, None] * inv[None, :], col[:, None] * inv[None, :]], axis=-1)
    return jnp.cos(ang), jnp.sin(ang)


def apply_rope(x, cos, sin):
    half = x.shape[-1] // 2
    xf = x.astype(jnp.float32)
    x1, x2 = xf[..., :half], xf[..., half:]
    c = cos[None, :, None, :]
    s = sin[None, :, None, :]
    return jnp.concatenate([x1 * c - x2 * s, x2 * c + x1 * s], axis=-1).astype(x.dtype)


def _heads(z, h):
    return z.reshape(z.shape[0], z.shape[1], h, HEAD_DIM)


def gqa_attend(q, k, v, mask=None, sink=None):
    b, m, hq, d = q.shape
    hkv = k.shape[2]
    g = hq // hkv
    qg = q.reshape(b, m, hkv, g, d)
    s = jnp.einsum("bmkgd,bskd->bkgms", qg, k, preferred_element_type=jnp.float32) * (d ** -0.5)
    if mask is not None:
        s = jnp.where(mask, s, -jnp.inf)
    if sink is not None:
        sk = jnp.broadcast_to(sink.astype(jnp.float32).reshape(1, hkv, g, 1, 1), s.shape[:-1] + (1,))
        s = jnp.concatenate([s, sk], axis=-1)
    p = jax.nn.softmax(s, axis=-1)
    if sink is not None:
        p = p[..., :-1]
    o = jnp.einsum("bkgms,bskd->bmkgd", p.astype(v.dtype), v)
    return o.reshape(b, m, hq * d)


def window_attention(q, k, v, kc, vc, sink):
    b, n, hq, d = q.shape
    n_ctx = kc.shape[1]
    span = BLOCK + 2 * WINDOW
    kp = jnp.pad(k, ((0, 0), (WINDOW, WINDOW), (0, 0), (0, 0)))
    vp = jnp.pad(v, ((0, 0), (WINDOW, WINDOW), (0, 0), (0, 0)))
    r_idx = jnp.arange(BLOCK)
    s_idx = jnp.arange(span)
    ctx_mask = jnp.ones((BLOCK, n_ctx), dtype=bool)

    def one_block(i):
        start = i * BLOCK
        qb = lax.dynamic_slice_in_dim(q, start, BLOCK, axis=1)
        kb = jnp.concatenate([lax.dynamic_slice_in_dim(kp, start, span, axis=1), kc], axis=1)
        vb = jnp.concatenate([lax.dynamic_slice_in_dim(vp, start, span, axis=1), vc], axis=1)
        qpos = start + r_idx
        kpos = start - WINDOW + s_idx
        local = (jnp.abs(qpos[:, None] - kpos[None, :]) <= WINDOW) & ((kpos >= 0) & (kpos < n))[None, :]
        mask = jnp.concatenate([local, ctx_mask], axis=1)
        return gqa_attend(qb, kb, vb, mask=mask, sink=sink)

    out = lax.map(one_block, jnp.arange(n // BLOCK))
    return jnp.moveaxis(out, 0, 1).reshape(b, n, hq * d)


def global_attention(q, k, v, kc, vc):
    b, n, hq, d = q.shape
    kk = jnp.concatenate([k, kc], axis=1)
    vv = jnp.concatenate([v, vc], axis=1)

    def one_block(i):
        qb = lax.dynamic_slice_in_dim(q, i * BLOCK, BLOCK, axis=1)
        return gqa_attend(qb, kk, vv)

    out = lax.map(one_block, jnp.arange(n // BLOCK))
    return jnp.moveaxis(out, 0, 1).reshape(b, n, hq * d)


def _split_q(p):
    aq, bq = jnp.split(p, [A_HEADS * HEAD_DIM], axis=-1)
    return _heads(aq, A_HEADS), _heads(bq, B_HEADS)


def _split_kv(p):
    a = A_KV_HEADS * HEAD_DIM
    bw = B_KV_HEADS * HEAD_DIM
    ak, av, bk, bv = jnp.split(p, [a, 2 * a, 2 * a + bw], axis=-1)
    return _heads(ak, A_KV_HEADS), _heads(av, A_KV_HEADS), _heads(bk, B_KV_HEADS), _heads(bv, B_KV_HEADS)


def mixer_ab(hl, hc, w_in, q_gain, k_gain, sink, w_out, cos, sin, ctx_out):
    pl = hl @ w_in
    aq, bq = _split_q(pl[..., :AB_Q_COLS])
    ak, av, bk, bv = _split_kv(pl[..., AB_Q_COLS:])
    aq = apply_rope(aq, cos, sin)
    ak = apply_rope(ak, cos, sin)
    bq = apply_rope(rms_norm(bq, q_gain), cos, sin)
    bk = apply_rope(rms_norm(bk, k_gain), cos, sin)
    pc = hc @ (w_in if ctx_out else w_in[:, AB_Q_COLS:])
    ak_c, av_c, bk_c, bv_c = _split_kv(pc[..., -AB_KV_COLS:])
    bk_c = rms_norm(bk_c, k_gain)
    ya = window_attention(aq, ak, av, ak_c, av_c, sink)
    yb = global_attention(bq, bk, bv, bk_c, bv_c)
    out_l = jnp.concatenate([ya, yb], axis=-1) @ w_out
    if not ctx_out:
        return out_l, None
    aq_c, bq_c = _split_q(pc[..., :AB_Q_COLS])
    ya_c = gqa_attend(aq_c, ak_c, av_c, sink=sink)
    yb_c = gqa_attend(rms_norm(bq_c, q_gain), bk_c, bv_c)
    out_c = jnp.concatenate([ya_c, yb_c], axis=-1) @ w_out
    return out_l, out_c


def token_shift_centred(u):
    up = jnp.pad(u, ((0, 0), (1, 1), (0, 0)))
    return 0.5 * (up[:, :-2] + up[:, 2:])


def rwkv_prepare(pc, mu, w0, w2, a0, a2, g2, k_k, k_a):
    b, t, _ = pc.shape
    pc = pc.astype(jnp.float32)
    pc = pc + (token_shift_centred(pc) - pc) * mu
    r, k, v, xw_f, xw_b, xa_f, xa_b, xg = jnp.split(pc, np.cumsum(C_SPLITS)[:-1], axis=-1)
    g = jax.nn.sigmoid(xg) @ g2
    kk = _heads(k * k_k, C_HEADS)
    kk = kk / jnp.maximum(jnp.sqrt(jnp.sum(kk * kk, axis=-1, keepdims=True)), 1e-12)
    dirs = []
    for d, (xw, xa) in enumerate(((xw_f, xa_f), (xw_b, xa_b))):
        w_log = -jax.nn.softplus(-(w0[d] + jnp.tanh(xw) @ w2[d])) - 0.5
        a = jax.nn.sigmoid(a0[d] + xa @ a2[d])
        k_d = k * (1.0 + (a - 1.0) * k_a)
        decay = jnp.exp(-jnp.exp(w_log))
        dirs.append((_heads(decay, C_HEADS), _heads(k_d, C_HEADS), kk * _heads(a, C_HEADS)))
    return _heads(r, C_HEADS), _heads(v, C_HEADS), kk, g, dirs


def rwkv7_scan(s0, decay, k, v, kk, bvec, r, reverse):
    xs = (decay, k, v, kk, bvec) + (() if r is None else (r,))
    xs = tuple(jnp.moveaxis(z, 1, 0) for z in xs)

    def step(S, inp):
        w_t, k_t, v_t, kk_t, b_t = inp[:5]
        sa = jnp.einsum("bhvk,bhk->bhv", S, -kk_t)
        S = S * w_t[:, :, None, :] + sa[..., None] * b_t[:, :, None, :] + v_t[..., None] * k_t[:, :, None, :]
        y = None if r is None else jnp.einsum("bhvk,bhk->bhv", S, inp[5])
        return S, y

    s_fin, ys = lax.scan(step, s0, xs, reverse=reverse)
    return s_fin, (None if r is None else jnp.moveaxis(ys, 0, 1))


def rwkv_bidirectional(prep, s0_f, s0_b, with_output):
    r, v, kk, g, dirs = prep
    outs = []
    finals = []
    for (decay, k_d, b_d), s0, rev in zip(dirs, (s0_f, s0_b), (False, True)):
        s_fin, y = rwkv7_scan(s0, decay, k_d, v, kk, b_d, r if with_output else None, rev)
        finals.append(s_fin)
        outs.append(y)
    y = outs[0] + outs[1] if with_output else None
    return y, finals[0], finals[1]


def rwkv_output(y, prep, lnx_w, lnx_b, r_k):
    r, v, kk, g, dirs = prep
    b, t = y.shape[:2]
    mean = jnp.mean(y, axis=-1, keepdims=True)
    var = jnp.mean(jnp.square(y - mean), axis=-1, keepdims=True)
    yn = ((y - mean) * lax.rsqrt(var + LNX_EPS)).reshape(b, t, C_WIDTH) * lnx_w + lnx_b
    bonus = sum(jnp.sum(r * k_d * r_k, axis=-1, keepdims=True) * v for (_, k_d, _) in dirs)
    return (yn + bonus.reshape(b, t, C_WIDTH)) * g


def multiscale_pool(u, pool_w, pool_scale):
    b, t, _ = u.shape
    uf = u.astype(jnp.float32).reshape(b, t, D_GROUPS, D_GROUP_DIM)
    cs = jnp.pad(jnp.cumsum(uf, axis=1), ((0, 0), (1, 0), (0, 0), (0, 0)))
    pos = jnp.arange(t)
    outs = []
    for gi, w in enumerate(POOL_WINDOWS):
        lo = jnp.clip(pos - w // 2, 0, t)
        hi = jnp.clip(pos + (w - 1 - w // 2) + 1, 0, t)
        csg = cs[:, :, gi]
        mean = (csg[:, hi] - csg[:, lo]) / (hi - lo).astype(jnp.float32)[None, :, None]
        outs.append(mean - uf[:, :, gi])
    pooled = jnp.stack(outs, axis=2)
    y = jnp.einsum("btgi,gio->btgo", pooled, pool_w.astype(jnp.float32)).reshape(b, t, D_WIDTH)
    return (y * pool_scale).astype(u.dtype)


def mixer_cd(hl, hc, w_in, mu, w0, w2, a0, a2, g2, k_k, k_a, r_k, lnx_w, lnx_b,
             pool_w, pool_scale, w_out, ctx_out):
    rw = (mu, w0, w2, a0, a2, g2, k_k, k_a)
    b = hl.shape[0]
    pl = hl @ w_in
    pc = hc @ (w_in if ctx_out else w_in[:, :C_IN])
    prep_c = rwkv_prepare(pc[..., :C_IN], *rw)
    zeros = jnp.zeros((b, C_HEADS, HEAD_DIM, HEAD_DIM), jnp.float32)
    yc, s_f, s_b = rwkv_bidirectional(prep_c, zeros, zeros, ctx_out)
    prep_l = rwkv_prepare(pl[..., :C_IN], *rw)
    yl, _, _ = rwkv_bidirectional(prep_l, s_f, s_b, True)
    out_l = jnp.concatenate([rwkv_output(yl, prep_l, lnx_w, lnx_b, r_k).astype(hl.dtype),
                             multiscale_pool(pl[..., C_IN:], pool_w, pool_scale)], axis=-1) @ w_out
    if not ctx_out:
        return out_l, None
    out_c = jnp.concatenate([rwkv_output(yc, prep_c, lnx_w, lnx_b, r_k).astype(hc.dtype),
                             multiscale_pool(pc[..., C_IN:], pool_w, pool_scale)], axis=-1) @ w_out
    return out_l, out_c


def setup_inputs(seed: int = 0) -> dict:
    key = jax.random.key(seed)
    keys = iter(jax.random.split(key, 32))
    f32 = jnp.float32
    n_even = (DEPTH + 1) // 2
    n_odd = DEPTH // 2
    d = D_MODEL

    def nrm(shape, scale):
        return scale * jax.random.normal(next(keys), shape, f32)

    def uni(shape, lo, hi):
        return jax.random.uniform(next(keys), shape, f32, lo, hi)

    return {
        "x": nrm((BATCH, SEQ, d), 1.0),
        "c": nrm((BATCH, d), 1.0),
        "ctx": nrm((BATCH, CTX_LEN, d), 1.0),
        "c_ctx": nrm((d,), 1.0),
        "norm_gain": 1.0 + nrm((DEPTH, 2, d), 0.02),
        "ada_w": nrm((DEPTH, d, 6 * d), 0.5 * d ** -0.5),
        "ada_b": nrm((DEPTH, 6 * d), 0.02),
        "ffn_w_in": nrm((DEPTH, d, 2 * FFN_HIDDEN), d ** -0.5),
        "ffn_w_out": nrm((DEPTH, FFN_HIDDEN, d), FFN_HIDDEN ** -0.5),
        "final_gain": 1.0 + nrm((d,), 0.02),
        "ab_w_in": nrm((n_even, d, AB_IN), d ** -0.5),
        "ab_q_gain": 1.0 + nrm((n_even, HEAD_DIM), 0.02),
        "ab_k_gain": 1.0 + nrm((n_even, HEAD_DIM), 0.02),
        "ab_sink": nrm((n_even, A_HEADS), 0.5),
        "ab_w_out": nrm((n_even, AB_OUT, d), AB_OUT ** -0.5),
        "cd_w_in": nrm((n_odd, d, CD_IN), d ** -0.5),
        "cd_mu": uni((n_odd, C_IN), 0.0, 1.0),
        "cd_w0": uni((n_odd, 2, C_WIDTH), -5.0, 0.0),
        "cd_w2": nrm((n_odd, 2, DECAY_LORA, C_WIDTH), 0.1),
        "cd_a0": nrm((n_odd, 2, C_WIDTH), 0.1),
        "cd_a2": nrm((n_odd, 2, ICLR_LORA, C_WIDTH), 0.1),
        "cd_g2": nrm((n_odd, GATE_LORA, C_WIDTH), GATE_LORA ** -0.5),
        "cd_k_k": 0.85 + nrm((n_odd, C_WIDTH), 0.02),
        "cd_k_a": 1.0 + nrm((n_odd, C_WIDTH), 0.02),
        "cd_r_k": nrm((n_odd, C_HEADS, HEAD_DIM), 0.1),
        "cd_lnx_w": 1.0 + nrm((n_odd, C_WIDTH), 0.02),
        "cd_lnx_b": nrm((n_odd, C_WIDTH), 0.02),
        "cd_pool_w": nrm((n_odd, D_GROUPS, D_GROUP_DIM, D_GROUP_DIM), D_GROUP_DIM ** -0.5),
        "cd_pool_scale": 1.0 + nrm((n_odd, D_WIDTH), 0.02),
        "cd_w_out": nrm((n_odd, CD_OUT, d), CD_OUT ** -0.5),
    }


def reference(x, c, ctx, c_ctx, norm_gain, ada_w, ada_b, ffn_w_in, ffn_w_out, final_gain,
              ab_w_in, ab_q_gain, ab_k_gain, ab_sink, ab_w_out,
              cd_w_in, cd_mu, cd_w0, cd_w2, cd_a0, cd_a2, cd_g2, cd_k_k, cd_k_a, cd_r_k,
              cd_lnx_w, cd_lnx_b, cd_pool_w, cd_pool_scale, cd_w_out):
    n = x.shape[1]
    cos, sin = axial_rope_tables(n)
    xl, xc = x, ctx
    for i in range(DEPTH):
        ctx_out = i < DEPTH - 1
        j = i // 2
        mod_l = jnp.split((jax.nn.silu(c) @ ada_w[i] + ada_b[i])[:, None, :], 6, axis=-1)
        mod_c = jnp.split((jax.nn.silu(c_ctx) @ ada_w[i] + ada_b[i])[None, None, :], 6, axis=-1)
        hl = modulate(rms_norm(xl, norm_gain[i, 0]), mod_l[0], mod_l[1])
        hc = modulate(rms_norm(xc, norm_gain[i, 0]), mod_c[0], mod_c[1])
        if i % 2 == 0:
            yl, yc = mixer_ab(hl, hc, ab_w_in[j], ab_q_gain[j], ab_k_gain[j], ab_sink[j], ab_w_out[j],
                              cos, sin, ctx_out)
        else:
            yl, yc = mixer_cd(hl, hc, cd_w_in[j], cd_mu[j], cd_w0[j], cd_w2[j], cd_a0[j], cd_a2[j],
                              cd_g2[j], cd_k_k[j], cd_k_a[j], cd_r_k[j], cd_lnx_w[j], cd_lnx_b[j],
                              cd_pool_w[j], cd_pool_scale[j], cd_w_out[j], ctx_out)
        xl = xl + mod_l[2] * yl
        xl = xl + mod_l[5] * swiglu(modulate(rms_norm(xl, norm_gain[i, 1]), mod_l[3], mod_l[4]),
                                    ffn_w_in[i], ffn_w_out[i])
        if ctx_out:
            xc = xc + mod_c[2] * yc
            xc = xc + mod_c[5] * swiglu(modulate(rms_norm(xc, norm_gain[i, 1]), mod_c[3], mod_c[4]),
                                        ffn_w_in[i], ffn_w_out[i])
    return rms_norm(xl, final_gain)
```

```cpp
#include <hip/hip_runtime.h>
#include <hip/hip_cooperative_groups.h>
#include <cstdio>
#include <cstdint>
namespace cg = cooperative_groups;

typedef unsigned short bf16_t;
typedef short bf16x8 __attribute__((ext_vector_type(8)));
typedef float f32x4 __attribute__((ext_vector_type(4)));
typedef float f32x16 __attribute__((ext_vector_type(16)));
typedef float f32x2 __attribute__((ext_vector_type(2)));
typedef unsigned u32x4 __attribute__((ext_vector_type(4)));
typedef unsigned u32x2 __attribute__((ext_vector_type(2)));
#define DI __device__ __forceinline__

constexpr int NLAT = 65536, NCTX = 2048, NTOK = NLAT + NCTX, DM = 1024, SEQ = 8192, CTXL = 256;
constexpr int FFH = 2816, CDIN = 2944, KVLEN = SEQ + CTXL;
constexpr float EPS = 1e-6f, LNX_EPS = 64e-5f;
constexpr float QSCALE = 0.125f * 1.4426950408889634f, LOG2E = 1.4426950408889634f;

constexpr size_t MB = 1u << 20;
constexpr size_t OFF_WAB_IN = 0, OFF_WAB_OUT = 3 * MB, OFF_WCD_IN = 5 * MB, OFF_WCD_OUT = 11 * MB, OFF_WFFN_IN = 13 * MB, OFF_WFFN_OUT = 35 * MB,
                 OFF_WG2 = 46 * MB, OFF_MOD = 47 * MB, OFF_MODP = 48 * MB, OFF_ROPE = 52 * MB, OFF_XLC = 53 * MB, OFF_H = 61 * MB, OFF_BIG = 193 * MB;
constexpr size_t OFF_PL0 = OFF_BIG, OFF_KB = OFF_BIG + 198 * MB, OFF_VT = OFF_BIG + 231 * MB;
constexpr size_t OFF_HID = OFF_BIG;
constexpr size_t OFF_PL1 = OFF_BIG, OFF_YF = OFF_BIG + 380 * MB, OFF_YB = OFF_BIG + 476 * MB, OFF_AG = OFF_BIG + 572 * MB, OFF_BONUS = OFF_BIG + 588 * MB;
constexpr size_t WFFN_IN_SZ = 11 * MB, WFFN_OUT_SZ = (size_t)1024 * 2816 * 2;

struct Params {
    const float *x, *c, *ctx, *c_ctx, *norm_gain, *ada_w, *ada_b, *ffn_w_in, *ffn_w_out, *final_gain, *ab_w_in, *ab_q_gain, *ab_k_gain, *ab_sink, *ab_w_out,
        *cd_w_in, *cd_mu, *cd_w0, *cd_w2, *cd_a0, *cd_a2, *cd_g2, *cd_k_k, *cd_k_a, *cd_r_k, *cd_lnx_w, *cd_lnx_b, *cd_pool_w, *cd_pool_scale, *cd_w_out;
    float* out; unsigned char* ws;
};

DI float bf2f(bf16_t b) { return __uint_as_float(((unsigned)b) << 16); }
typedef __bf16 bf16x2v __attribute__((ext_vector_type(2)));
DI unsigned pk2(float lo, float hi) { const f32x2 v = {lo, hi}; return __builtin_bit_cast(unsigned, __builtin_convertvector(v, bf16x2v)); }
DI bf16_t f2bf(float f) { return __builtin_bit_cast(bf16_t, (__bf16)f); }
DI float lo16(unsigned u) { return __uint_as_float(u << 16); }
DI float hi16(unsigned u) { return __uint_as_float(u & 0xffff0000u); }
DI float sigmoidf_(float x) { return __builtin_amdgcn_rcpf(1.0f + __builtin_amdgcn_exp2f(-1.4426950408889634f * x)); }
DI float quad_sum(float x) {
    x += __int_as_float(__builtin_amdgcn_mov_dpp(__float_as_int(x), 0xB1, 0xf, 0xf, true));
    x += __int_as_float(__builtin_amdgcn_mov_dpp(__float_as_int(x), 0x4E, 0xf, 0xf, true));
    return x;
}
DI float oct_sum(float x) { x = quad_sum(x); x += __int_as_float(__builtin_amdgcn_mov_dpp(__float_as_int(x), 0x141, 0xf, 0xf, true)); return x; }
DI int otid() { int t = threadIdx.x; asm volatile("" : "+v"(t)); return t; }
DI unsigned swz(int row, int chunk) { return (unsigned)row * 128u + (unsigned)((chunk ^ ((row >> 1) & 7)) << 4); }
#define MFMA32(a, b, c) __builtin_amdgcn_mfma_f32_32x32x16_bf16((a), (b), (c), 0, 0, 0)
#define MFMA16(a, b, c) __builtin_amdgcn_mfma_f32_16x16x32_bf16((a), (b), (c), 0, 0, 0)
DI int crow(int r, int hi) { return (r & 3) + 8 * (r >> 2) + 4 * hi; }

template <class Epi>
DI void gemm_phase(const bf16_t* __restrict__ A, int lda, const bf16_t* __restrict__ Bt, int ldb, int M, int N, int K, const Epi& epi, unsigned char* lds) {
    const int tid = otid(), lane = tid & 63, wave = tid >> 6, wm = wave >> 1, wn = wave & 1;
    const int nNt = N / 128, nk = K / 64;
    const int lr = tid >> 3, lc = tid & 7, l31 = lane & 31, lh = lane >> 5;
    const int G8 = gridDim.x >> 3, xcd = blockIdx.x & 7, lb = blockIdx.x >> 3, mper = (M / 128) >> 3, per = mper * nNt;
    for (int lt = lb; lt < per; lt += G8) {
        const int grp = lt / (8 * nNt), q = lt - grp * 8 * nNt, gs = (mper - grp * 8) < 8 ? (mper - grp * 8) : 8;
        const int tn = q / gs, tm = xcd * mper + grp * 8 + (q - tn * gs);
        const bf16_t* Ag = A + (size_t)(tm * 128 + lr) * lda + lc * 8;
        const bf16_t* Bg = Bt + (size_t)(tn * 128 + lr) * ldb + lc * 8;
        f32x16 acc[2][2];
#pragma unroll
        for (int i = 0; i < 2; ++i)
#pragma unroll
            for (int j = 0; j < 2; ++j)
#pragma unroll
                for (int r = 0; r < 16; ++r) acc[i][j][r] = 0.f;
        u32x4 ra0[4], rb0[4], ra1[4], rb1[4];
#define G_LOAD(RA, RB, KT) { _Pragma("unroll") for (int i = 0; i < 4; ++i) { RA[i] = *(const u32x4*)(Ag + (size_t)(32 * i) * lda + (KT) * 64); RB[i] = *(const u32x4*)(Bg + (size_t)(32 * i) * ldb + (KT) * 64); } }
#define G_STORE(RA, RB, BUF) { _Pragma("unroll") for (int i = 0; i < 4; ++i) { *(u32x4*)((BUF) + swz(lr + 32 * i, lc)) = RA[i]; *(u32x4*)((BUF) + 16384 + swz(lr + 32 * i, lc)) = RB[i]; } }
#define G_COMPUTE(BUF) { _Pragma("unroll") for (int ks = 0; ks < 4; ++ks) { bf16x8 af[2], bfr[2]; \
            _Pragma("unroll") for (int i = 0; i < 2; ++i) { af[i] = *(const bf16x8*)((BUF) + swz(wm * 64 + i * 32 + l31, 2 * ks + lh)); bfr[i] = *(const bf16x8*)((BUF) + 16384 + swz(wn * 64 + i * 32 + l31, 2 * ks + lh)); } \
            _Pragma("unroll") for (int i = 0; i < 2; ++i) _Pragma("unroll") for (int j = 0; j < 2; ++j) acc[i][j] = MFMA32(af[i], bfr[j], acc[i][j]); } }
        G_LOAD(ra0, rb0, 0)
        if (nk > 1) G_LOAD(ra1, rb1, 1)
        G_STORE(ra0, rb0, lds)
        __syncthreads();
        for (int kt = 0; kt < nk; kt += 2) {
            if (kt + 2 < nk) G_LOAD(ra0, rb0, kt + 2)
            G_COMPUTE(lds)
            if (kt + 1 < nk) G_STORE(ra1, rb1, lds + 32768)
            __syncthreads();
            if (kt + 1 < nk) {
                if (kt + 3 < nk) G_LOAD(ra1, rb1, kt + 3)
                G_COMPUTE(lds + 32768)
                if (kt + 2 < nk) G_STORE(ra0, rb0, lds)
                __syncthreads();
            }
        }
#undef G_LOAD
#undef G_STORE
#undef G_COMPUTE
        int lane_e = lane; asm volatile("" : "+v"(lane_e));
        epi.template operator()<2>(acc, tm * 128 + wm * 64, tn * 128 + wn * 64, lane_e);
    }
}

template <class Epi>
DI void gemm256_phase(const bf16_t* __restrict__ A, int lda, const bf16_t* __restrict__ Bt, int ldb, int M, int N, int K, const Epi& epi, unsigned char* lds) {
    const int tid = otid(), lane = tid & 63, wave = tid >> 6, wm = wave >> 1, wn = wave & 1;
    const int nNt = N / 256, nk = K / 64;
    const int lr = tid >> 3, lc = tid & 7, l31 = lane & 31, lh = lane >> 5;
    const int G8 = gridDim.x >> 3, xcd = blockIdx.x & 7, lb = blockIdx.x >> 3, mper = (M / 128) >> 3, per = mper * nNt;
    const unsigned c0 = (unsigned)(lh ^ ((l31 >> 1) & 7)), roA = (unsigned)(wm * 8192 + l31 * 128), roB = (unsigned)(16384 + wn * 16384 + l31 * 128);
    for (int lt = lb; lt < per; lt += G8) {
        const int grp = lt / (8 * nNt), q = lt - grp * 8 * nNt, gs = (mper - grp * 8) < 8 ? (mper - grp * 8) : 8;
        const int tn = q / gs, tm = xcd * mper + grp * 8 + (q - tn * gs);
        const bf16_t* Au = A + (size_t)(tm * 128) * lda;
        const bf16_t* Bu = Bt + (size_t)(tn * 256) * ldb;
        const unsigned voA = (unsigned)(lr * lda + lc * 8), voB = (unsigned)(lr * ldb + lc * 8);
        f32x16 acc[2][4];
#pragma unroll
        for (int i = 0; i < 2; ++i)
#pragma unroll
            for (int j = 0; j < 4; ++j)
#pragma unroll
                for (int r = 0; r < 16; ++r) acc[i][j][r] = 0.f;
        u32x4 ra[4], rb[8];
#pragma unroll
        for (int i = 0; i < 4; ++i) ra[i] = *(const u32x4*)((Au + (size_t)(32 * i) * lda) + voA);
#pragma unroll
        for (int i = 0; i < 8; ++i) rb[i] = *(const u32x4*)((Bu + (size_t)(32 * i) * ldb) + voB);
        for (int kt = 0; kt < nk; ++kt) {
#pragma unroll
            for (int i = 0; i < 4; ++i) *(u32x4*)(lds + swz(lr + 32 * i, lc)) = ra[i];
#pragma unroll
            for (int i = 0; i < 8; ++i) *(u32x4*)(lds + 16384 + swz(lr + 32 * i, lc)) = rb[i];
            __syncthreads();
            if (kt + 1 < nk) {
#pragma unroll
                for (int i = 0; i < 4; ++i) ra[i] = *(const u32x4*)((Au + (size_t)(32 * i) * lda + (kt + 1) * 64) + voA);
#pragma unroll
                for (int i = 0; i < 8; ++i) rb[i] = *(const u32x4*)((Bu + (size_t)(32 * i) * ldb + (kt + 1) * 64) + voB);
            }
            __builtin_amdgcn_s_setprio(1);
#pragma unroll 2
            for (int ks = 0; ks < 4; ++ks) {
                bf16x8 af[2], bfr[4];
                const unsigned xo = (c0 ^ (unsigned)(2 * ks)) << 4;
#pragma unroll
                for (int i = 0; i < 2; ++i) af[i] = *(const bf16x8*)(lds + (roA + xo) + i * 4096);
#pragma unroll
                for (int j = 0; j < 4; ++j) bfr[j] = *(const bf16x8*)(lds + (roB + xo) + j * 4096);
#pragma unroll
                for (int i = 0; i < 2; ++i)
#pragma unroll
                    for (int j = 0; j < 4; ++j) acc[i][j] = MFMA32(af[i], bfr[j], acc[i][j]);
            }
            __builtin_amdgcn_s_setprio(0);
            __syncthreads();
        }
        int lane_e = lane; asm volatile("" : "+v"(lane_e));
        epi.template operator()<4>(acc, tm * 128 + wm * 64, tn * 256 + wn * 128, lane_e);
    }
}

DI int cu(int r) { return (r & 3) + 8 * (r >> 2); }
struct EpiStoreBf16 {
    bf16_t* C; int ldc;
    template <int NI> DI void operator()(const f32x16 (&acc)[2][NI], int row0, int col0, int lane) const {
        if (col0 >= ldc) return;
        const unsigned lo = (unsigned)(4 * (lane >> 5) * ldc + (lane & 31));
        bf16_t* base = C + (size_t)row0 * ldc + col0;
#pragma unroll
        for (int mi = 0; mi < 2; ++mi)
#pragma unroll
            for (int ni = 0; ni < NI; ++ni)
#pragma unroll
                for (int r = 0; r < 16; ++r) (base + (size_t)(32 * mi + cu(r)) * ldc + 32 * ni)[lo] = f2bf(acc[mi][ni][r]);
    }
};
struct EpiResidual {
    const float* srcL; const float* srcC; float* dstL; float* dstC; const float* mod; int gate_idx;
    template <int NI> DI void operator()(const f32x16 (&acc)[2][NI], int row0, int col0, int lane) const {
        const bool lat = row0 < NLAT;
        const float* src = (lat ? srcL + (size_t)row0 * DM : srcC + (size_t)(row0 - NLAT) * DM) + col0;
        float* dst = (lat ? dstL + (size_t)row0 * DM : dstC + (size_t)(row0 - NLAT) * DM) + col0;
        const float* g = mod + ((lat ? (row0 >> 13) : 8) * 6 + gate_idx) * 1024 + col0;
        const unsigned l31 = lane & 31, lo = (unsigned)(4 * (lane >> 5) * DM) + l31;
#pragma unroll
        for (int ni = 0; ni < NI; ++ni) {
            const float gv = (g + 32 * ni)[l31];
            float sv[32];
#pragma unroll
            for (int q = 0; q < 32; ++q) sv[q] = (src + (32 * (q >> 4) + cu(q & 15)) * DM + 32 * ni)[lo];
#pragma unroll
            for (int q = 0; q < 32; ++q) (dst + (32 * (q >> 4) + cu(q & 15)) * DM + 32 * ni)[lo] = sv[q] + gv * acc[q >> 4][ni][q & 15];
            asm volatile("" ::: "memory");
        }
    }
};
struct EpiSwiglu {
    bf16_t* Hd;
    template <int NI> DI void operator()(const f32x16 (&acc)[2][NI], int row0, int col0, int lane) const {
        const unsigned lo = (unsigned)(4 * (lane >> 5) * FFH + (lane & 31));
        bf16_t* base = Hd + (size_t)row0 * FFH + (col0 >> 1);
#pragma unroll
        for (int pr = 0; pr < NI / 2; ++pr)
#pragma unroll
            for (int mi = 0; mi < 2; ++mi)
#pragma unroll
                for (int r = 0; r < 16; ++r) { const float g = acc[mi][2 * pr][r], u = acc[mi][2 * pr + 1][r]; (base + (32 * mi + cu(r)) * FFH + 32 * pr)[lo] = f2bf(g * sigmoidf_(g) * u); }
    }
};
struct EpiGateMul {
    bf16_t* Y;
    template <int NI> DI void operator()(const f32x16 (&acc)[2][NI], int row0, int col0, int lane) const {
        const unsigned lo = (unsigned)(4 * (lane >> 5) * DM + (lane & 31));
        bf16_t* base = Y + (size_t)row0 * DM + col0;
#pragma unroll
        for (int mi = 0; mi < 2; ++mi)
#pragma unroll
            for (int ni = 0; ni < NI; ++ni)
#pragma unroll
                for (int r = 0; r < 16; ++r) { bf16_t* p = base + (32 * mi + cu(r)) * DM + 32 * ni; p[lo] = f2bf(bf2f(p[lo]) * acc[mi][ni][r]); }
    }
};

DI void transpose_tile(const float* __restrict__ W, int ldw, int K, bf16_t* __restrict__ Wt, int k0, int n0, int ffn_map, float* t  ) {
    const int tid = otid();
    {
        const int n = tid & 63; int src = n0 + n;
        if (ffn_map) { const int np = n0 + n; const int j32 = np >> 6, s = (np >> 5) & 1, i = np & 31; src = s * FFH + j32 * 32 + i; }
#pragma unroll
        for (int i = 0; i < 16; ++i) { const int k = i * 4 + (tid >> 6); t[k * 65 + n] = W[(size_t)(k0 + k) * ldw + src]; }
    }
    __syncthreads();
#pragma unroll
    for (int i = 0; i < 2; ++i) {
        const int n = (tid >> 3) + 32 * i, kc = tid & 7;
        u32x4 v;
        v.x = pk2(t[(kc * 8 + 0) * 65 + n], t[(kc * 8 + 1) * 65 + n]); v.y = pk2(t[(kc * 8 + 2) * 65 + n], t[(kc * 8 + 3) * 65 + n]);
        v.z = pk2(t[(kc * 8 + 4) * 65 + n], t[(kc * 8 + 5) * 65 + n]); v.w = pk2(t[(kc * 8 + 6) * 65 + n], t[(kc * 8 + 7) * 65 + n]);
        *(u32x4*)(Wt + (size_t)(n0 + n) * K + k0 + kc * 8) = v;
    }
    __syncthreads();
}
DI void prep_phase(const Params& P, unsigned char* lds) {
    float* t = (float*)lds;
    unsigned char* ws = P.ws;
    for (int j = blockIdx.x; j < 5880; j += gridDim.x) {
        const float* W; int ldw, K, Nout, map = 0, jj = j; bf16_t* Wt;
        if (jj < 384) { W = P.ab_w_in; ldw = 1536; K = 1024; Nout = 1536; Wt = (bf16_t*)(ws + OFF_WAB_IN); }
        else if ((jj -= 384) < 256) { W = P.ab_w_out; ldw = 1024; K = 1024; Nout = 1024; Wt = (bf16_t*)(ws + OFF_WAB_OUT); }
        else if ((jj -= 256) < 736) { W = P.cd_w_in; ldw = CDIN; K = 1024; Nout = CDIN; Wt = (bf16_t*)(ws + OFF_WCD_IN); }
        else if ((jj -= 736) < 256) { W = P.cd_w_out; ldw = 1024; K = 1024; Nout = 1024; Wt = (bf16_t*)(ws + OFF_WCD_OUT); }
        else if ((jj -= 256) < 2816) { const int l = jj / 1408; jj -= l * 1408; W = P.ffn_w_in + (size_t)l * 1024 * 5632; ldw = 5632; K = 1024; Nout = 5632; map = 1; Wt = (bf16_t*)(ws + OFF_WFFN_IN + l * WFFN_IN_SZ); }
        else if ((jj -= 2816) < 1408) { const int l = jj / 704; jj -= l * 704; W = P.ffn_w_out + (size_t)l * FFH * 1024; ldw = 1024; K = FFH; Nout = 1024; Wt = (bf16_t*)(ws + OFF_WFFN_OUT + l * WFFN_OUT_SZ); }
        else { jj -= 1408; W = P.cd_g2; ldw = 768; K = 128; Nout = 768; Wt = (bf16_t*)(ws + OFF_WG2); }
        const int nNt = Nout / 64; const int kt = jj / nNt, nt = jj - kt * nNt;
        transpose_tile(W, ldw, K, Wt, kt * 64, nt * 64, map, t);
    }
    float* MODP = (float*)(ws + OFF_MODP);
    for (int j = blockIdx.x; j < 384; j += gridDim.x) {
        const int l = j / 192, r2 = j % 192, ks = r2 / 24, cb = r2 % 24;
        const int tid = otid();
        __syncthreads();
        for (int e = tid; e < 9 * 128; e += 256) { const int r = e >> 7, kk = e & 127; const float v = r < 8 ? P.c[r * 1024 + ks * 128 + kk] : P.c_ctx[ks * 128 + kk]; t[e] = v * sigmoidf_(v); }
        __syncthreads();
        const int col = cb * 256 + tid;
        const float* w = P.ada_w + ((size_t)l * 1024 + ks * 128) * 6144 + col;
        float a[9];
#pragma unroll
        for (int r = 0; r < 9; ++r) a[r] = 0.f;
#pragma unroll 4
        for (int kk = 0; kk < 128; ++kk) { const float wv = w[(size_t)kk * 6144];
#pragma unroll
            for (int r = 0; r < 9; ++r) a[r] += t[r * 128 + kk] * wv; }
#pragma unroll
        for (int r = 0; r < 9; ++r) MODP[((size_t)(ks * 2 + l) * 9 + r) * 6144 + col] = a[r];
    }
    if (blockIdx.x == 0) {
        float* ct = (float*)(ws + OFF_ROPE); float* st = ct + 2048;
        for (int e = otid(); e < 2048; e += 256) {
            const int pos = e >> 4, j = e & 15;
            const float inv = exp2f(-(float)j * (13.287712379549449f / 16.0f));
            const float ang = (float)pos * inv;
            double rev = (double)ang * 0.15915494309189535; rev -= floor(rev);
            const float rv = (float)rev;
            ct[e] = __builtin_amdgcn_cosf(rv); st[e] = __builtin_amdgcn_sinf(rv);
        }
    }
}
DI void modfinal_phase(const Params& P) {
    const float* MODP = (const float*)(P.ws + OFF_MODP); float* MOD = (float*)(P.ws + OFF_MOD);
    for (int e = blockIdx.x * 256 + otid(); e < 2 * 9 * 6144; e += gridDim.x * 256) {
        const int l = e / (9 * 6144), col = e % 6144;
        float s = P.ada_b[l * 6144 + col];
#pragma unroll
        for (int ks = 0; ks < 8; ++ks) s += MODP[(size_t)ks * (2 * 9 * 6144) + e];
        MOD[e] = s;
    }
}

DI void rownorm_phase(const float* srcL, const float* srcC, int M, const float* __restrict__ gain, const float* __restrict__ mod, int shift_idx, int scale_idx, bf16_t* __restrict__ H) {
    const int lane = otid() & 63, wave = otid() >> 6;
    for (int row = blockIdx.x * 4 + wave; row < M; row += gridDim.x * 4) {
        const bool lat = row < NLAT;
        const float* src = lat ? srcL + (size_t)row * DM : srcC + (size_t)(row - NLAT) * DM;
        const float* mrow = mod + (lat ? (row >> 13) : 8) * 6144;
        f32x4 v[4]; float ss = 0.f;
#pragma unroll
        for (int i = 0; i < 4; ++i) { v[i] = *(const f32x4*)(src + (i * 64 + lane) * 4); ss += v[i].x * v[i].x + v[i].y * v[i].y + v[i].z * v[i].z + v[i].w * v[i].w; }
#pragma unroll
        for (int o = 32; o > 0; o >>= 1) ss += __shfl_xor(ss, o);
        const float rs = rsqrtf(ss * (1.0f / 1024.0f) + EPS);
#pragma unroll
        for (int i = 0; i < 4; ++i) {
            const int col = (i * 64 + lane) * 4;
            const f32x4 g = *(const f32x4*)(gain + col), sc = *(const f32x4*)(mrow + scale_idx * 1024 + col), sh = *(const f32x4*)(mrow + shift_idx * 1024 + col);
            const f32x4 y = (v[i] * rs * g) * (sc + 1.0f) + sh;
            u32x2 o; o.x = pk2(y.x, y.y); o.y = pk2(y.z, y.w);
            *(u32x2*)(H + (size_t)row * DM + col) = o;
        }
    }
}
DI void finalnorm_phase(const Params& P) {
    const int lane = otid() & 63, wave = otid() >> 6;
    for (int row = blockIdx.x * 4 + wave; row < NLAT; row += gridDim.x * 4) {
        float* src = P.out + (size_t)row * DM;
        f32x4 v[4]; float ss = 0.f;
#pragma unroll
        for (int i = 0; i < 4; ++i) { v[i] = *(const f32x4*)(src + (i * 64 + lane) * 4); ss += v[i].x * v[i].x + v[i].y * v[i].y + v[i].z * v[i].z + v[i].w * v[i].w; }
#pragma unroll
        for (int o = 32; o > 0; o >>= 1) ss += __shfl_xor(ss, o);
        const float rs = rsqrtf(ss * (1.0f / 1024.0f) + EPS);
#pragma unroll
        for (int i = 0; i < 4; ++i) { const int col = (i * 64 + lane) * 4; *(f32x4*)(src + col) = v[i] * rs * *(const f32x4*)(P.final_gain + col); }
    }
}

DI void qkprep_phase(const Params& P) {
    bf16_t* PL = (bf16_t*)(P.ws + OFF_PL0); bf16_t* KB = (bf16_t*)(P.ws + OFF_KB); bf16_t* VT = (bf16_t*)(P.ws + OFF_VT);
    const float* ct = (const float*)(P.ws + OFF_ROPE); const float* st = ct + 2048;
    const int tid = otid(), hw = tid >> 5, i = tid & 31;
    for (int unit = blockIdx.x; unit < NTOK / 64; unit += gridDim.x) {
        const int row0 = unit * 64; const bool lat = row0 < NLAT;
        const int b = lat ? (row0 >> 13) : ((row0 - NLAT) >> 8);
        const int pos0 = lat ? (row0 & 8191) : SEQ + ((row0 - NLAT) & 255);
        for (int it = 0; it < 40; ++it) {
            float xa[4], xb[4];
#pragma unroll
            for (int u = 0; u < 4; ++u) {
                const int task = hw + 8 * (4 * it + u); const int tok = task / 20, slot = task - tok * 20;
                const int col = slot < 16 ? slot * 64 : (slot < 18 ? 1024 + (slot - 16) * 64 : 1280 + (slot - 18) * 64);
                const bf16_t* p = PL + (size_t)(row0 + tok) * 1536 + col;
                xa[u] = bf2f(p[i]); xb[u] = bf2f(p[i + 32]);
            }
#pragma unroll
            for (int u = 0; u < 4; ++u) {
                const int task = hw + 8 * (4 * it + u); const int tok = task / 20, slot = task - tok * 20;
                const int col = slot < 16 ? slot * 64 : (slot < 18 ? 1024 + (slot - 16) * 64 : 1280 + (slot - 18) * 64);
                bf16_t* p = PL + (size_t)(row0 + tok) * 1536 + col;
                float x1 = xa[u], x2 = xb[u];
                const bool isB = (slot >= 8 && slot < 16) || slot >= 18;
                if (isB) {
                    float ss = x1 * x1 + x2 * x2;
#pragma unroll
                    for (int o = 16; o > 0; o >>= 1) ss += __shfl_xor(ss, o);
                    const float rs = rsqrtf(ss * (1.0f / 64.0f) + EPS);
                    const float* g = slot < 16 ? P.ab_q_gain : P.ab_k_gain;
                    x1 = x1 * rs * g[i]; x2 = x2 * rs * g[i + 32];
                }
                if (lat) {
                    const int t = pos0 + tok; const int pos = i < 16 ? (t >> 6) : (t & 63);
                    const float c = ct[pos * 16 + (i & 15)], sn = st[pos * 16 + (i & 15)];
                    const float o1 = x1 * c - x2 * sn, o2 = x2 * c + x1 * sn; x1 = o1; x2 = o2;
                }
                if (slot < 16) { p[i] = f2bf(x1 * QSCALE); p[i + 32] = f2bf(x2 * QSCALE); }
                else { bf16_t* kp = KB + ((size_t)(b * 4 + (slot - 16)) * KVLEN + pos0 + tok) * 64; kp[i] = f2bf(x1); kp[i + 32] = f2bf(x2); }
            }
        }
        const int d = tid & 63, tg = tid >> 6;
#pragma unroll
        for (int vs = 0; vs < 4; ++vs) {
            const int col = 1024 + (vs < 2 ? 128 + vs * 64 : 384 + (vs - 2) * 64);
            const bf16_t* src = PL + (size_t)(row0 + 16 * tg) * 1536 + col + d;
            unsigned v[16];
#pragma unroll
            for (int j = 0; j < 16; ++j) v[j] = src[(size_t)j * 1536];
            u32x4 a, bq;
            a.x = v[0] | (v[1] << 16); a.y = v[2] | (v[3] << 16); a.z = v[8] | (v[9] << 16); a.w = v[10] | (v[11] << 16);
            bq.x = v[4] | (v[5] << 16); bq.y = v[6] | (v[7] << 16); bq.z = v[12] | (v[13] << 16); bq.w = v[14] | (v[15] << 16);
            bf16_t* dst = VT + ((size_t)(b * 4 + vs) * 64 + d) * KVLEN + pos0 + 16 * tg;
            *(u32x4*)dst = a; *(u32x4*)(dst + 8) = bq;
        }
    }
}

DI void attn_phase(const Params& P, unsigned char* lds) {
    const bf16_t* PL = (const bf16_t*)(P.ws + OFF_PL0); const bf16_t* KB = (const bf16_t*)(P.ws + OFF_KB); const bf16_t* VT = (const bf16_t*)(P.ws + OFF_VT);
    bf16_t* Y = (bf16_t*)(P.ws + OFF_H);
    const int tid = otid(), lane = tid & 63, wave = tid >> 6, l31 = lane & 31, lh = lane >> 5;
    const int lr = tid >> 3, lc = tid & 7;
    for (int unit = blockIdx.x; unit < 8448; unit += gridDim.x) {
        int b, hq, kvh, qrow0, nW, wlo, qpos0 = 0; bool masked = false, has_sink;
        if (unit < 8192) {
            const int u = unit & 4095; b = u >> 9; const int r = u & 511, kvl = r >> 8, hl = (r >> 6) & 3, qb = r & 63;
            qrow0 = b * SEQ + qb * 128; qpos0 = qb * 128;
            if (unit < 4096) { hq = 8 + kvl * 4 + hl; kvh = 2 + kvl; nW = 132; wlo = 0; has_sink = false; }
            else { hq = kvl * 4 + hl; kvh = kvl; masked = true; has_sink = true;
                   const int s0 = qpos0 - 128 < 0 ? 0 : qpos0 - 128, s1 = qpos0 + 256 > SEQ ? SEQ : qpos0 + 256; wlo = s0 >> 6; nW = (s1 >> 6) - wlo; }
        } else { const int u = unit - 8192; b = u >> 5; hq = (u >> 1) & 15; const int qb = u & 1; kvh = hq < 8 ? (hq >> 2) : 2 + ((hq - 8) >> 2);
                 qrow0 = NLAT + b * CTXL + qb * 128; nW = 0; wlo = 0; has_sink = hq < 8; }
        const int nt = masked ? nW + 4 : (nW ? nW : 4);
        const int qrow = qrow0 + 32 * wave + l31;
        const int qpos = qpos0 + 32 * wave + l31;
        bf16x8 qf[4];
        { const bf16_t* qp = PL + (size_t)qrow * 1536 + hq * 64 + 8 * lh;
#pragma unroll
          for (int ks = 0; ks < 4; ++ks) qf[ks] = *(const bf16x8*)(qp + 16 * ks); }
        f32x16 o[2];
#pragma unroll
        for (int r = 0; r < 16; ++r) { o[0][r] = 0.f; o[1][r] = 0.f; }
        float m = -1e30f, l = 0.f;
        const bf16_t* kbase = KB + (size_t)(b * 4 + kvh) * KVLEN * 64;
        const bf16_t* vbase = VT + (size_t)(b * 4 + kvh) * 64 * KVLEN;
        u32x4 rk[2], rv[2];
        auto tile_of = [&](int i) __attribute__((always_inline)) { return (masked && i >= nW) ? 128 + (i - nW) : wlo + i + ((!masked && nW == 0) ? 128 : 0); };
        {
            const int p0 = tile_of(0) * 64;
#pragma unroll
            for (int j = 0; j < 2; ++j) { rk[j] = *(const u32x4*)(kbase + (size_t)(p0 + lr + 32 * j) * 64 + lc * 8); rv[j] = *(const u32x4*)(vbase + (size_t)(lr + 32 * j) * KVLEN + p0 + lc * 8); }
#pragma unroll
            for (int j = 0; j < 2; ++j) { *(u32x4*)(lds + swz(lr + 32 * j, lc)) = rk[j]; *(u32x4*)(lds + 8192 + swz(lr + 32 * j, lc)) = rv[j]; }
        }
        __syncthreads();
        for (int i = 0; i < nt; ++i) {
            unsigned char* cur = lds + (i & 1) * 16384; unsigned char* nxt = lds + ((i + 1) & 1) * 16384;
            const int p0 = tile_of(i) * 64; const bool more = i + 1 < nt;
            if (more) { const int p1 = tile_of(i + 1) * 64;
#pragma unroll
                for (int j = 0; j < 2; ++j) { rk[j] = *(const u32x4*)(kbase + (size_t)(p1 + lr + 32 * j) * 64 + lc * 8); rv[j] = *(const u32x4*)(vbase + (size_t)(lr + 32 * j) * KVLEN + p1 + lc * 8); } }
            const bool wtile = masked && i < nW;
            bool active = true;
            if (wtile) { const int qmin = qpos0 + 32 * wave; active = (p0 <= qmin + 31 + 128) && (p0 + 63 >= qmin - 128); }
            if (active) {
                f32x16 s[2];
                __builtin_amdgcn_s_setprio(1);
#pragma unroll
                for (int kt = 0; kt < 2; ++kt) {
                    const f32x16 z16 = {0.f, 0.f, 0.f, 0.f, 0.f, 0.f, 0.f, 0.f, 0.f, 0.f, 0.f, 0.f, 0.f, 0.f, 0.f, 0.f};
#pragma unroll
                    for (int ks = 0; ks < 4; ++ks) { const bf16x8 kf = *(const bf16x8*)(cur + swz(32 * kt + l31, 2 * ks + lh)); s[kt] = ks == 0 ? MFMA32(kf, qf[0], z16) : MFMA32(kf, qf[ks], s[kt]); }
                }
                __builtin_amdgcn_s_setprio(0);
                if (wtile) {
#pragma unroll
                    for (int kt = 0; kt < 2; ++kt)
#pragma unroll
                        for (int r = 0; r < 16; ++r) { const int kp = p0 + 32 * kt + crow(r, lh); const int dlt = qpos - kp; if (dlt > 128 || dlt < -128) s[kt][r] = -INFINITY; }
                }
                float mx = s[0][0];
#pragma unroll
                for (int kt = 0; kt < 2; ++kt)
#pragma unroll
                    for (int r = 0; r < 16; ++r) mx = fmaxf(mx, s[kt][r]);
                { auto rr = __builtin_amdgcn_permlane32_swap(__float_as_uint(mx), __float_as_uint(mx), false, false);
                  mx = fmaxf(__uint_as_float(rr[0]), __uint_as_float(rr[1])); }
                const float mn = (mx > m + 8.0f) ? mx : m;
                if (__builtin_amdgcn_ballot_w64(mn != m) != 0ull) {
                    const float alpha = __builtin_amdgcn_exp2f(m - mn);
                    l *= alpha;
#pragma unroll
                    for (int r = 0; r < 16; ++r) { o[0][r] *= alpha; o[1][r] *= alpha; }
                    m = mn;
                }
                f32x2 ps2 = {0.f, 0.f}; const f32x2 mn2 = {mn, mn};
#pragma unroll
                for (int kt = 0; kt < 2; ++kt)
#pragma unroll
                    for (int r = 0; r < 16; r += 2) {
                        const f32x2 d = (f32x2){s[kt][r], s[kt][r + 1]} - mn2;
                        const f32x2 pv = {__builtin_amdgcn_exp2f(d.x), __builtin_amdgcn_exp2f(d.y)};
                        s[kt][r] = pv.x; s[kt][r + 1] = pv.y; ps2 += pv;
                    }
                l += ps2.x + ps2.y;
                __builtin_amdgcn_s_setprio(1);
#pragma unroll
                for (int kt = 0; kt < 2; ++kt)
#pragma unroll
                    for (int sx = 0; sx < 2; ++sx) {
                        union { u32x4 u; bf16x8 h; } pf;
                        pf.u.x = pk2(s[kt][8 * sx + 0], s[kt][8 * sx + 1]); pf.u.y = pk2(s[kt][8 * sx + 2], s[kt][8 * sx + 3]);
                        pf.u.z = pk2(s[kt][8 * sx + 4], s[kt][8 * sx + 5]); pf.u.w = pk2(s[kt][8 * sx + 6], s[kt][8 * sx + 7]);
#pragma unroll
                        for (int dt = 0; dt < 2; ++dt) { const bf16x8 vf = *(const bf16x8*)(cur + 8192 + swz(32 * dt + l31, 2 * (2 * kt + sx) + lh)); o[dt] = MFMA32(vf, pf.h, o[dt]); }
                    }
                __builtin_amdgcn_s_setprio(0);
            }
            if (more) {
#pragma unroll
                for (int j = 0; j < 2; ++j) { *(u32x4*)(nxt + swz(lr + 32 * j, lc)) = rk[j]; *(u32x4*)(nxt + 8192 + swz(lr + 32 * j, lc)) = rv[j]; }
            }
            __syncthreads();
        }
        l += __shfl_xor(l, 32);
        if (has_sink) l += __builtin_amdgcn_exp2f(P.ab_sink[hq] * LOG2E - m);
        const float inv = 1.0f / l;
        bf16_t* yp = Y + (size_t)qrow * DM + hq * 64 + 4 * lh;
#pragma unroll
        for (int dt = 0; dt < 2; ++dt)
#pragma unroll
            for (int g = 0; g < 4; ++g) { u32x2 w; w.x = pk2(o[dt][4 * g] * inv, o[dt][4 * g + 1] * inv); w.y = pk2(o[dt][4 * g + 2] * inv, o[dt][4 * g + 3] * inv); *(u32x2*)(yp + 32 * dt + 8 * g) = w; }
    }
}

DI float mix1(const bf16_t* p, bool hp, bool hn, float mu) {
    const float x = bf2f(p[0]); const float xp = hp ? bf2f(*(p - CDIN)) : 0.f; const float xn = hn ? bf2f(*(p + CDIN)) : 0.f;
    return x + (0.5f * (xp + xn) - x) * mu;
}
DI void mix8(const bf16_t* p, bool hp, bool hn, const float (&mu)[8], float (&o)[8]) {
    const u32x4 z = {0u, 0u, 0u, 0u};
    const u32x4 x = *(const u32x4*)p; const u32x4 xp = hp ? *(const u32x4*)(p - CDIN) : z; const u32x4 xn = hn ? *(const u32x4*)(p + CDIN) : z;
#pragma unroll
    for (int i = 0; i < 4; ++i) {
        const float a0 = lo16(x[i]), a1 = hi16(x[i]);
        o[2 * i] = a0 + (0.5f * (lo16(xp[i]) + lo16(xn[i])) - a0) * mu[2 * i];
        o[2 * i + 1] = a1 + (0.5f * (hi16(xp[i]) + hi16(xn[i])) - a1) * mu[2 * i + 1];
    }
}
template <int MODE>
DI void scan_chain(const Params& P, int chain, unsigned char* lds) {
    const int otid_ = otid(); const int lane = otid_ & 63, wave = (otid_ >> 6) ^ (((((int)blockIdx.x >> 8) ^ (int)blockIdx.x) & 1) ? 2 : 0), tid = wave * 64 + lane;
    const int half = chain & 1, chn = chain >> 1;
    const int b = chn / 24, rem = chn % 24, h = rem >> 1, dir = rem & 1;
    const bf16_t* PL = (const bf16_t*)(P.ws + OFF_PL1);
    bf16_t* Yd = (bf16_t*)(P.ws + (dir ? OFF_YB : OFF_YF));
    float* BON = (float*)(P.ws + OFF_BONUS) + (size_t)dir * NLAT * 12;
    float* buf = (float*)lds;
    float* ybuf = buf + 2 * 6144;
    const int NCH = 528;
    f32x2 S0[4], S1[4];
#pragma unroll
    for (int j = 0; j < 4; ++j) { S0[j] = (f32x2){0.f, 0.f}; S1[j] = (f32x2){0.f, 0.f}; }
    const int q8 = lane & 7, r0 = 32 * half + 16 * (wave & 1) + (lane >> 3), r1 = r0 + 8;
    const int kg = lane >> 4, n16 = lane & 15;
    bf16x8 lf[4][2];
    if (wave >= 2) {
        const float* l2 = (wave == 2 ? P.cd_a2 : P.cd_w2) + (size_t)dir * 64 * 768;
#pragma unroll
        for (int nt = 0; nt < 4; ++nt)
#pragma unroll
            for (int ks = 0; ks < 2; ++ks) {
                union { u32x4 u; bf16x8 hh; } f; const float* s = l2 + (size_t)(32 * ks + 8 * kg) * 768 + 64 * h + 16 * nt + n16;
                f.u.x = pk2(s[0], s[768]); f.u.y = pk2(s[2 * 768], s[3 * 768]); f.u.z = pk2(s[4 * 768], s[5 * 768]); f.u.w = pk2(s[6 * 768], s[7 * 768]);
                lf[nt][ks] = f.hh;
            }
    }
    float* cw = buf + 13312 + (wave & 1) * 384;
    if (wave >= 2) {
        const int ch = lane;
        if (wave == 2) { cw[ch] = P.cd_a0[dir * 768 + 64 * h + ch]; cw[64 + ch] = P.cd_k_k[64 * h + ch]; cw[128 + ch] = P.cd_k_a[64 * h + ch]; cw[192 + ch] = P.cd_r_k[64 * h + ch];
                         cw[256 + ch] = P.cd_mu[768 + 64 * h + ch]; cw[320 + ch] = P.cd_mu[64 * h + ch]; }
        else { cw[ch] = P.cd_w0[dir * 768 + 64 * h + ch]; cw[256 + ch] = P.cd_mu[1536 + 64 * h + ch]; cw[320 + ch] = P.cd_mu[64 * h + ch]; }
        buf[13312 + 768 + (wave - 2) * 64 + ch] = P.cd_mu[(wave == 2 ? 2432 : 2304) + 64 * dir + ch];
        asm volatile("s_waitcnt lgkmcnt(0)" ::: "memory");
    }
    auto chunk_info = [&](int c, int& seqrow0, int& len, int& t0) __attribute__((always_inline)) {
        if (c < 16) { seqrow0 = NLAT + b * CTXL; len = CTXL; t0 = dir ? 240 - 16 * c : 16 * c; }
        else { const int cc = c - 16; seqrow0 = b * SEQ; len = SEQ; t0 = dir ? SEQ - 16 - 16 * cc : 16 * cc; }
    };
    u32x4 xr[3][2], ar[3][2];
    auto issue_loads = [&](int c) __attribute__((always_inline)) {
        int seqrow0, len, t0; chunk_info(c, seqrow0, len, t0);
        const u32x4 z4 = {0u, 0u, 0u, 0u};
        { const int tok = lane >> 2, cq = lane & 3, t = t0 + tok; const bool hp = t > 0, hn = t + 1 < len;
          const bf16_t* prow = PL + (size_t)(seqrow0 + t) * CDIN + 64 * h + 16 * cq + (wave == 2 ? 768 : 1536);
#pragma unroll
          for (int j = 0; j < 2; ++j) { xr[1][j] = *(const u32x4*)(prow + 8 * j); xr[0][j] = hp ? *(const u32x4*)(prow - CDIN + 8 * j) : z4; xr[2][j] = hn ? *(const u32x4*)(prow + CDIN + 8 * j) : z4; } }
        { const int ta = t0 + n16; const bool hpa = ta > 0, hna = ta + 1 < len;
          const bf16_t* p = PL + (size_t)(seqrow0 + ta) * CDIN + (wave == 2 ? 2432 : 2304) + 64 * dir + 8 * kg;
#pragma unroll
          for (int ks = 0; ks < 2; ++ks) { ar[1][ks] = *(const u32x4*)(p + 32 * ks); ar[0][ks] = hpa ? *(const u32x4*)(p - CDIN + 32 * ks) : z4; ar[2][ks] = hna ? *(const u32x4*)(p + CDIN + 32 * ks) : z4; } }
    };
    auto produce = [&](int c) __attribute__((always_inline)) {
        int seqrow0, len, t0; chunk_info(c, seqrow0, len, t0);
        float* bb = buf + (c & 1) * 6144;
        float* scr = buf + 14336 + (wave - 2) * 1024;
        const int tok = lane >> 2, cq = lane & 3, t = t0 + tok; const bool hp = t > 0, hn = t + 1 < len;
        const bf16_t* prow = PL + (size_t)(seqrow0 + t) * CDIN + 64 * h + 16 * cq;
        const int cb = 64 * h + 16 * cq;
        const int xcol = wave == 2 ? 768 : 1536;
        const u32x4 z4 = {0u, 0u, 0u, 0u};
        u32x4 rr_[3][2];
#pragma unroll
        for (int j = 0; j < 2; ++j) { rr_[1][j] = *(const u32x4*)(prow + 8 * j); rr_[0][j] = hp ? *(const u32x4*)(prow - CDIN + 8 * j) : z4; rr_[2][j] = hn ? *(const u32x4*)(prow + CDIN + 8 * j) : z4; }
        bf16x8 af[2];
        {
            const float* mulp = buf + 13312 + 768 + (wave - 2) * 64 + 8 * kg;
#pragma unroll
            for (int ks = 0; ks < 2; ++ks) {
                const f32x4 m0 = *(const f32x4*)(mulp + 32 * ks), m1 = *(const f32x4*)(mulp + 32 * ks + 4);
                float xv[8];
#pragma unroll
                for (int e = 0; e < 4; ++e) {
                    const float a0 = lo16(ar[1][ks][e]), a1 = hi16(ar[1][ks][e]);
                    const float mu0 = e < 2 ? m0[2 * e] : m1[2 * e - 4], mu1 = e < 2 ? m0[2 * e + 1] : m1[2 * e - 3];
                    xv[2 * e] = a0 + (0.5f * (lo16(ar[0][ks][e]) + lo16(ar[2][ks][e])) - a0) * mu0;
                    xv[2 * e + 1] = a1 + (0.5f * (hi16(ar[0][ks][e]) + hi16(ar[2][ks][e])) - a1) * mu1;
                }
                if (wave == 3) {
#pragma unroll
                    for (int j = 0; j < 8; ++j) xv[j] = 1.0f - 2.0f * __builtin_amdgcn_rcpf(1.0f + __builtin_amdgcn_exp2f(2.8853900817779268f * xv[j]));
                }
                union { u32x4 u; bf16x8 hh; } f; f.u.x = pk2(xv[0], xv[1]); f.u.y = pk2(xv[2], xv[3]); f.u.z = pk2(xv[4], xv[5]); f.u.w = pk2(xv[6], xv[7]);
                af[ks] = f.hh;
            }
        }
        f32x4 acc[4];
#pragma unroll
        for (int nt = 0; nt < 4; ++nt) { acc[nt] = (f32x4){0.f, 0.f, 0.f, 0.f};
#pragma unroll
            for (int ks = 0; ks < 2; ++ks) acc[nt] = MFMA16(af[ks], lf[nt][ks], acc[nt]); }
#pragma unroll
        for (int nt = 0; nt < 4; ++nt)
#pragma unroll
            for (int rg = 0; rg < 4; ++rg) scr[(4 * kg + rg) * 64 + 16 * nt + n16] = acc[nt][rg];
        asm volatile("s_waitcnt lgkmcnt(0)" ::: "memory");
        const float* prep_ = scr + tok * 64 + 16 * cq;
        float xm[16];
        {
            const float* mux = cw + 256 + 16 * cq;
#pragma unroll
            for (int j = 0; j < 2; ++j)
#pragma unroll
                for (int e = 0; e < 4; ++e) {
                    const f32x2 mx2 = *(const f32x2*)(mux + 8 * j + 2 * e);
                    const float a0 = lo16(xr[1][j][e]), a1 = hi16(xr[1][j][e]);
                    xm[8 * j + 2 * e] = a0 + (0.5f * (lo16(xr[0][j][e]) + lo16(xr[2][j][e])) - a0) * mx2.x;
                    xm[8 * j + 2 * e + 1] = a1 + (0.5f * (hi16(xr[0][j][e]) + hi16(xr[2][j][e])) - a1) * mx2.y;
                }
        }
        float* o = bb + tok * 64 + 16 * cq;
        const float* mur = cw + 320 + 16 * cq;
        if (wave == 2) {
            float ss = 0.f, bonus = 0.f;
#pragma unroll
            for (int j = 0; j < 4; ++j) { const f32x4 kkc = *(const f32x4*)(cw + 64 + 16 * cq + 4 * j);
#pragma unroll
                for (int e = 0; e < 4; ++e) { const float kr = xm[4 * j + e] * kkc[e]; ss += kr * kr; } }
            ss = quad_sum(ss);
            const float inv = __builtin_amdgcn_rcpf(fmaxf(__builtin_amdgcn_sqrtf(ss), 1e-12f));
#pragma unroll
            for (int j = 0; j < 4; ++j) {
                asm volatile("" ::: "memory");
                const f32x4 a0 = *(const f32x4*)(cw + 16 * cq + 4 * j), kkc = *(const f32x4*)(cw + 64 + 16 * cq + 4 * j),
                            kac = *(const f32x4*)(cw + 128 + 16 * cq + 4 * j), rkc = *(const f32x4*)(cw + 192 + 16 * cq + 4 * j), mr = *(const f32x4*)(mur + 4 * j);
                const f32x4 pre = *(const f32x4*)(prep_ + 4 * j);
                f32x4 vkd, vb, vkk;
#pragma unroll
                for (int e = 0; e < 4; ++e) {
                    const int ix = 4 * j + e, jj = ix >> 3, ee = (ix & 7) >> 1; const bool hi = ix & 1;
                    const float r1 = hi ? hi16(rr_[1][jj][ee]) : lo16(rr_[1][jj][ee]), r0 = hi ? hi16(rr_[0][jj][ee]) : lo16(rr_[0][jj][ee]), r2 = hi ? hi16(rr_[2][jj][ee]) : lo16(rr_[2][jj][ee]);
                    const float r = r1 + (0.5f * (r0 + r2) - r1) * mr[e];
                    const float a = sigmoidf_(a0[e] + pre[e]);
                    const float kk = xm[ix] * kkc[e] * inv, kd = xm[ix] * (1.0f + (a - 1.0f) * kac[e]);
                    bonus += r * kd * rkc[e]; vkd[e] = kd; vb[e] = kk * a; vkk[e] = kk;
                }
                *(f32x4*)(o + 1024 + 4 * j) = vkd; *(f32x4*)(o + 2048 + 4 * j) = vb; *(f32x4*)(o + 3072 + 4 * j) = vkk;
            }
            bonus = quad_sum(bonus);
            if (c >= 16 && cq == 0 && half == 0) BON[(size_t)(seqrow0 + t) * 12 + h] = bonus;
        } else {
#pragma unroll
            for (int j = 0; j < 4; ++j) {
                asm volatile("" ::: "memory");
                const f32x4 w0 = *(const f32x4*)(cw + 16 * cq + 4 * j), mr = *(const f32x4*)(mur + 4 * j);
                const f32x4 pre = *(const f32x4*)(prep_ + 4 * j);
                f32x4 vw, vr, vv;
#pragma unroll
                for (int e = 0; e < 4; ++e) {
                    const int ix = 4 * j + e, jj = ix >> 3, ee = (ix & 7) >> 1; const bool hi = ix & 1;
                    const float r1 = hi ? hi16(rr_[1][jj][ee]) : lo16(rr_[1][jj][ee]), r0 = hi ? hi16(rr_[0][jj][ee]) : lo16(rr_[0][jj][ee]), r2 = hi ? hi16(rr_[2][jj][ee]) : lo16(rr_[2][jj][ee]);
                    vr[e] = r1 + (0.5f * (r0 + r2) - r1) * mr[e];
                    const float xs = -(w0[e] + pre[e]); const float sp = fmaxf(xs, 0.f) + 0.6931471805599453f * __builtin_amdgcn_logf(1.0f + __builtin_amdgcn_exp2f(-1.4426950408889634f * fabsf(xs)));
                    vw[e] = __builtin_amdgcn_exp2f(-1.4426950408889634f * __builtin_amdgcn_exp2f(-1.4426950408889634f * (sp + 0.5f))); vv[e] = xm[ix];
                }
                *(f32x4*)(o + 4 * j) = vw; *(f32x4*)(o + 4096 + 4 * j) = vr; *(f32x4*)(o + 5120 + 4 * j) = vv;
            }
        }
    };
    auto flush_y = [&](int c) __attribute__((always_inline)) {
        int seqrow0, len, t0; chunk_info(c, seqrow0, len, t0);
        const int p = tid - 128, tok = p >> 3, rl = (p & 7) * 4, rg = 32 * half + rl;
        const f32x4 a = *(const f32x4*)(ybuf + (c & 1) * 512 + tok * 32 + rl);
        u32x2 w; w.x = pk2(a.x, a.y); w.y = pk2(a.z, a.w);
        *(u32x2*)(Yd + (size_t)(seqrow0 + t0 + tok) * 768 + 64 * h + rg) = w;
    };
    struct SV { f32x4 kk[2], bv[2], kd[2], w[2], rr[2]; float v0, v1; };
#define SLOAD(S, TK) { const float* base_ = bb + (TK) * 64 + 8 * q8; \
        S.kk[0] = *(const f32x4*)(base_ + 3072); S.kk[1] = *(const f32x4*)(base_ + 3076); \
        S.bv[0] = *(const f32x4*)(base_ + 2048); S.bv[1] = *(const f32x4*)(base_ + 2052); S.kd[0] = *(const f32x4*)(base_ + 1024); S.kd[1] = *(const f32x4*)(base_ + 1028); \
        S.w[0] = *(const f32x4*)(base_); S.w[1] = *(const f32x4*)(base_ + 4); S.rr[0] = *(const f32x4*)(base_ + 4096); S.rr[1] = *(const f32x4*)(base_ + 4100); \
        S.v0 = bb[5 * 1024 + (TK) * 64 + r0]; S.v1 = bb[5 * 1024 + (TK) * 64 + r1]; }
#define SSTEP(S, TK) { \
        f32x2 a0 = {0.f, 0.f}, a1 = {0.f, 0.f}; \
        _Pragma("unroll") for (int j = 0; j < 4; ++j) { const f32x2 kj = {S.kk[j >> 1][2 * (j & 1)], S.kk[j >> 1][2 * (j & 1) + 1]}; a0 += S0[j] * kj; a1 += S1[j] * kj; } \
        const float sa0 = -oct_sum(a0.x + a0.y), sa1 = -oct_sum(a1.x + a1.y); \
        f32x2 y0 = {0.f, 0.f}, y1 = {0.f, 0.f}; \
        _Pragma("unroll") for (int j = 0; j < 4; ++j) { const int jj = j >> 1, e = 2 * (j & 1); \
            const f32x2 wj = {S.w[jj][e], S.w[jj][e + 1]}, bj = {S.bv[jj][e], S.bv[jj][e + 1]}, kj = {S.kd[jj][e], S.kd[jj][e + 1]}, rj = {S.rr[jj][e], S.rr[jj][e + 1]}; \
            S0[j] = S0[j] * wj + (bj * sa0 + kj * S.v0); S1[j] = S1[j] * wj + (bj * sa1 + kj * S.v1); \
            y0 += S0[j] * rj; y1 += S1[j] * rj; } \
        const float yy0 = oct_sum(y0.x + y0.y), yy1 = oct_sum(y1.x + y1.y); \
        if (q8 == 0) { yb[(TK) * 32 + (r0 & 31)] = yy0; yb[(TK) * 32 + (r1 & 31)] = yy1; } }
    auto scan_chunk = [&](int c) __attribute__((always_inline)) {
        const float* bb = buf + (c & 1) * 6144; float* yb = ybuf + (c & 1) * 512;
        const int t0s = dir ? 15 : 0, dt = dir ? -1 : 1;
        SV A, B;
        SLOAD(A, t0s)
        for (int ii = 0; ii < 16; ii += 2) {
            const int ta = t0s + dt * ii, tb = ta + dt, tc = tb + dt;
            SLOAD(B, tb)
            SSTEP(A, ta)
            if (ii + 2 < 16) SLOAD(A, tc)
            SSTEP(B, tb)
        }
    };
    if (__builtin_amdgcn_readfirstlane(wave) < 2) __builtin_amdgcn_s_setprio(2);
    if (wave >= 2) { issue_loads(0); produce(0); issue_loads(1); }
    __syncthreads();
    for (int c = 0; c < NCH; ++c) {
        if (wave < 2) { if (MODE != 1) scan_chunk(c); }
        else if (MODE != 2) {
            if (c >= 17) flush_y(c - 1);
            if (c + 1 < NCH) produce(c + 1);
            if (c + 2 < NCH) issue_loads(c + 2);
        }
        __syncthreads();
    }
    if (wave >= 2) flush_y(NCH - 1);
    __builtin_amdgcn_s_setprio(0);
    __syncthreads();
}

DI void pool_units(const Params& P, int first, int stride, unsigned char* lds) {
    const bf16_t* PL = (const bf16_t*)(P.ws + OFF_PL1); bf16_t* Y = (bf16_t*)(P.ws + OFF_H); bf16_t* AG = (bf16_t*)(P.ws + OFF_AG);
    float* pl = (float*)lds;
    const int tid = otid(), g = tid >> 6, i = tid & 63;
    float pw[64];
#pragma unroll
    for (int ii = 0; ii < 64; ++ii) pw[ii] = P.cd_pool_w[(size_t)(g * 64 + ii) * 64 + i];
    const float scale = P.cd_pool_scale[tid];
    const int wl = 1 << g, wr = 1 << g;
    float mug[8];
#pragma unroll
    for (int j = 0; j < 8; ++j) mug[j] = P.cd_mu[2560 + 8 * (tid & 15) + j];
    for (int u = first; u < NLAT / 32; u += stride) {
        const int row0 = u * 32, b = row0 >> 13, t0 = row0 & 8191;
        const bf16_t* col = PL + (size_t)(b * SEQ) * CDIN + 2688 + tid;
        __syncthreads();
        {
            int lo = t0 - wl < 0 ? 0 : t0 - wl, hi = t0 + wr > SEQ ? SEQ : t0 + wr;
            float sum = 0.f;
            for (int s = lo; s < hi; ++s) sum += bf2f(col[(size_t)s * CDIN]);
            for (int tok = 0; tok < 32; ++tok) {
                const int t = t0 + tok;
                lo = t - wl < 0 ? 0 : t - wl; hi = t + wr > SEQ ? SEQ : t + wr;
                pl[tok * 256 + tid] = sum / (float)(hi - lo) - bf2f(col[(size_t)t * CDIN]);
                if (t + wr < SEQ) sum += bf2f(col[(size_t)(t + wr) * CDIN]);
                if (t - wl >= 0) sum -= bf2f(col[(size_t)(t - wl) * CDIN]);
            }
        }
        __syncthreads();
        for (int tok = 0; tok < 32; ++tok) {
            const float* pp = pl + tok * 256 + g * 64; float acc = 0.f;
#pragma unroll
            for (int ii = 0; ii < 16; ++ii) { const f32x4 v = *(const f32x4*)(pp + 4 * ii); acc += v.x * pw[4 * ii] + v.y * pw[4 * ii + 1] + v.z * pw[4 * ii + 2] + v.w * pw[4 * ii + 3]; }
            Y[(size_t)(row0 + tok) * DM + 768 + tid] = f2bf(acc * scale);
        }
#pragma unroll
        for (int hh = 0; hh < 2; ++hh) {
            const int tok = (tid >> 4) + 16 * hh, t = t0 + tok;
            float xv[8]; mix8(PL + (size_t)(row0 + tok) * CDIN + 2560 + 8 * (tid & 15), t > 0, t + 1 < SEQ, mug, xv);
            u32x4 w; w.x = pk2(sigmoidf_(xv[0]), sigmoidf_(xv[1])); w.y = pk2(sigmoidf_(xv[2]), sigmoidf_(xv[3])); w.z = pk2(sigmoidf_(xv[4]), sigmoidf_(xv[5])); w.w = pk2(sigmoidf_(xv[6]), sigmoidf_(xv[7]));
            *(u32x4*)(AG + (size_t)(row0 + tok) * 128 + 8 * (tid & 15)) = w;
        }
    }
    __syncthreads();
}
DI void scan_phase(const Params& P, unsigned char* lds) {
    const int G = gridDim.x;
#ifndef SCAN_REP
#define SCAN_REP 1
#endif
#ifdef SCAN_PROBE
    for (int c = blockIdx.x; c < 384; c += G) scan_chain<SCAN_PROBE>(P, c, lds);
#endif
    for (int c = blockIdx.x; c < 384; c += G) scan_chain<0>(P, c, lds);
    if (G > 384) { if ((int)blockIdx.x >= 384) pool_units(P, blockIdx.x - 384, G - 384, lds); }
    else pool_units(P, blockIdx.x, G, lds);
}
DI void zpass_phase(const Params& P) {
    const bf16_t* PL = (const bf16_t*)(P.ws + OFF_PL1); const bf16_t* YF = (const bf16_t*)(P.ws + OFF_YF); const bf16_t* YB = (const bf16_t*)(P.ws + OFF_YB);
    const float* BON = (const float*)(P.ws + OFF_BONUS); bf16_t* Y = (bf16_t*)(P.ws + OFF_H);
    const int tid = otid(), hw = tid >> 5, i = tid & 31;
    const int stride = gridDim.x * 8;
    for (int task0 = blockIdx.x * 8 + hw; task0 < NLAT * 12; task0 += 4 * stride) {
        unsigned ya[4], yb[4]; float bon[4]; unsigned short vr[4][6];
#pragma unroll
        for (int u = 0; u < 4; ++u) {
            const int task = task0 + u * stride; const bool ok = task < NLAT * 12;
            const int row = ok ? task / 12 : 0, h = ok ? task - row * 12 : 0, t = row & 8191, c = 64 * h + 2 * i;
            ya[u] = *(const unsigned*)(YF + (size_t)row * 768 + c); yb[u] = *(const unsigned*)(YB + (size_t)row * 768 + c);
            bon[u] = BON[(size_t)row * 12 + h] + BON[(size_t)NLAT * 12 + (size_t)row * 12 + h];
            const bf16_t* pv = PL + (size_t)row * CDIN + 1536 + c;
            const unsigned cur = *(const unsigned*)pv, prv = t > 0 ? *(const unsigned*)(pv - CDIN) : 0u, nxt = t + 1 < SEQ ? *(const unsigned*)(pv + CDIN) : 0u;
            vr[u][0] = (unsigned short)(cur & 0xffff); vr[u][1] = (unsigned short)(cur >> 16); vr[u][2] = (unsigned short)(prv & 0xffff); vr[u][3] = (unsigned short)(prv >> 16);
            vr[u][4] = (unsigned short)(nxt & 0xffff); vr[u][5] = (unsigned short)(nxt >> 16);
        }
#pragma unroll
        for (int u = 0; u < 4; ++u) {
            const int task = task0 + u * stride; const bool ok = task < NLAT * 12;
            const int row = ok ? task / 12 : 0, h = ok ? task - row * 12 : 0, c = 64 * h + 2 * i;
            const float y0 = lo16(ya[u]) + lo16(yb[u]), y1 = hi16(ya[u]) + hi16(yb[u]);
            float sm = y0 + y1;
#pragma unroll
            for (int o = 16; o > 0; o >>= 1) sm += __shfl_xor(sm, o);
            const float mean = sm * (1.0f / 64.0f); const float d0 = y0 - mean, d1 = y1 - mean;
            float vs = d0 * d0 + d1 * d1;
#pragma unroll
            for (int o = 16; o > 0; o >>= 1) vs += __shfl_xor(vs, o);
            const float rs = rsqrtf(vs * (1.0f / 64.0f) + LNX_EPS);
            const float x0 = bf2f(vr[u][0]), x1 = bf2f(vr[u][1]);
            const float v0 = x0 + (0.5f * (bf2f(vr[u][2]) + bf2f(vr[u][4])) - x0) * P.cd_mu[1536 + c], v1 = x1 + (0.5f * (bf2f(vr[u][3]) + bf2f(vr[u][5])) - x1) * P.cd_mu[1536 + c + 1];
            const float z0 = d0 * rs * P.cd_lnx_w[c] + P.cd_lnx_b[c] + bon[u] * v0, z1 = d1 * rs * P.cd_lnx_w[c + 1] + P.cd_lnx_b[c + 1] + bon[u] * v1;
            if (ok) *(unsigned*)(Y + (size_t)row * DM + c) = pk2(z0, z1);
        }
    }
}


constexpr size_t OFF_BAR = OFF_ROPE + 512 * 1024;
#define XB_TMO      128
#define XB_XCNT(j)  (256  + 64 * (j))
#define XB_XSUB(j)  (1280 + 64 * (j))
#define XB_XGEN(j)  (2304 + 64 * (j))
#define XB_TOP      3328
#define XB_TOPGEN   3392
#define XCD_BAR_WORDS 3456
#define XB_SPIN_CAP (1u << 22)
DI unsigned xb_ld(unsigned* p)              { return __hip_atomic_load(p, __ATOMIC_RELAXED, __HIP_MEMORY_SCOPE_AGENT); }
DI unsigned xb_add(unsigned* p, unsigned v) { return __hip_atomic_fetch_add(p, v, __ATOMIC_RELAXED, __HIP_MEMORY_SCOPE_AGENT); }
DI unsigned xb_xcc_id() { return (unsigned)__builtin_amdgcn_s_getreg((3 << 11) | 20) & 0xFu; }
#define XB_SPIN(cond, bar) do { unsigned _sp = 0; while (cond) { __builtin_amdgcn_s_sleep(1); \
    if ((++_sp & 255u) == 0u) { if (xb_ld(&(bar)[XB_TMO])) break; if (_sp > XB_SPIN_CAP) { atomicAdd(&(bar)[XB_TMO], 1u); break; } } } } while (0)
struct XcdBar { unsigned* bar; unsigned x, nloc, nx; };
DI void xcd_barrier(const XcdBar& b) {
    asm volatile("s_waitcnt vmcnt(0)" ::: "memory");
    __syncthreads();
    if (threadIdx.x == 0) {
        unsigned* bar = b.bar;
        __builtin_amdgcn_s_waitcnt(0);
        const unsigned nloc = b.nloc, nx = b.nx;
        const unsigned old = xb_add(&bar[XB_XSUB(b.x)], 1u);
        const unsigned gen = old / nloc;
        if (old + 1u == (gen + 1u) * nloc) {
            __builtin_amdgcn_fence(__ATOMIC_RELEASE, "agent");
            asm volatile("s_waitcnt vmcnt(0)" ::: "memory");
            const unsigned og = xb_add(&bar[XB_TOP], 1u);
            const unsigned tg = og / nx;
            if (og + 1u == (tg + 1u) * nx) xb_add(&bar[XB_TOPGEN], 1u);
            else XB_SPIN(xb_ld(&bar[XB_TOPGEN]) == tg, bar);
            __builtin_amdgcn_fence(__ATOMIC_ACQUIRE, "agent");
            xb_add(&bar[XB_XGEN(b.x)], 1u);
            asm volatile("s_waitcnt vmcnt(0)" ::: "memory");
        } else {
            XB_SPIN(xb_ld(&bar[XB_XGEN(b.x)]) == gen, bar);
            __builtin_amdgcn_fence(__ATOMIC_ACQUIRE, "agent");
            asm volatile("s_waitcnt vmcnt(0)" ::: "memory");
        }
    }
    __syncthreads();
}

#ifndef PHASE_MASK
#define PHASE_MASK 0xffff
#endif
#ifndef PHASE_LIMIT
#define PHASE_LIMIT 100
#endif
#ifndef REP_IDX
#define REP_IDX -1
#endif
#ifndef REP_N
#define REP_N 2
#endif
#define PH(n, idx) if ((((PHASE_MASK) >> (n)) & 1) && ((idx) < (PHASE_LIMIT) || (n) == 8))
__global__ void __launch_bounds__(256, 2) fwd_megakernel(Params P) {
    __shared__ __attribute__((aligned(16))) unsigned char lds[65536];
    cg::grid_group grid = cg::this_grid();
    XcdBar xb; xb.bar = (unsigned*)(P.ws + OFF_BAR); xb.x = xb_xcc_id();
    if (threadIdx.x == 0) (void)xb_add(&xb.bar[XB_XCNT(xb.x)], 1u);
    unsigned char* ws = P.ws;
    const float* MOD = (const float*)(ws + OFF_MOD);
    bf16_t* H = (bf16_t*)(ws + OFF_H);
    float* XLC = (float*)(ws + OFF_XLC);
    PH(0, 0) prep_phase(P, lds);
    grid.sync();
    {
        unsigned mine = 0u, cnt = 0u;
#pragma unroll
        for (unsigned j = 0; j < 16; ++j) { const unsigned c = xb_ld(&xb.bar[XB_XCNT(j)]); cnt += (c > 0u) ? 1u : 0u; mine = (j == xb.x) ? c : mine; }
        xb.nloc = __builtin_amdgcn_readfirstlane(mine > 0u ? mine : 1u); xb.nx = __builtin_amdgcn_readfirstlane(cnt > 0u ? cnt : 1u);
    }
    PH(1, 1) modfinal_phase(P);
    xcd_barrier(xb);
    PH(2, 2) rownorm_phase(P.x, P.ctx, NTOK, P.norm_gain, MOD, 0, 1, H);
    xcd_barrier(xb);
    PH(3, 3) gemm256_phase((const bf16_t*)H, DM, (const bf16_t*)(ws + OFF_WAB_IN), DM, NTOK, 1536, DM, EpiStoreBf16{(bf16_t*)(ws + OFF_PL0), 1536}, lds);
    xcd_barrier(xb);
    PH(4, 4) qkprep_phase(P);
    xcd_barrier(xb);
    PH(5, 5) attn_phase(P, lds);
#if REP_IDX == 5
    { xcd_barrier(xb); attn_phase(P, lds); }
#endif
    xcd_barrier(xb);
    PH(3, 6) gemm256_phase((const bf16_t*)H, DM, (const bf16_t*)(ws + OFF_WAB_OUT), DM, NTOK, DM, DM, EpiResidual{P.x, P.ctx, P.out, XLC, MOD, 2}, lds);
    xcd_barrier(xb);
    PH(2, 7) rownorm_phase(P.out, XLC, NTOK, P.norm_gain + 1024, MOD, 3, 4, H);
    xcd_barrier(xb);
    PH(3, 8) gemm256_phase((const bf16_t*)H, DM, (const bf16_t*)(ws + OFF_WFFN_IN), DM, NTOK, 5632, DM, EpiSwiglu{(bf16_t*)(ws + OFF_HID)}, lds);
#if REP_IDX == 8
    { xcd_barrier(xb); gemm256_phase((const bf16_t*)H, DM, (const bf16_t*)(ws + OFF_WFFN_IN), DM, NTOK, 5632, DM, EpiSwiglu{(bf16_t*)(ws + OFF_HID)}, lds); }
#endif
    xcd_barrier(xb);
    PH(3, 9) gemm256_phase((const bf16_t*)(ws + OFF_HID), FFH, (const bf16_t*)(ws + OFF_WFFN_OUT), FFH, NTOK, DM, FFH, EpiResidual{P.out, XLC, P.out, XLC, MOD, 5}, lds);
    xcd_barrier(xb);
    const float* MOD1 = MOD + 9 * 6144;
    PH(2, 10) rownorm_phase(P.out, XLC, NTOK, P.norm_gain + 2048, MOD1, 0, 1, H);
    xcd_barrier(xb);
    PH(3, 11) gemm256_phase((const bf16_t*)H, DM, (const bf16_t*)(ws + OFF_WCD_IN), DM, NTOK, 3072, DM, EpiStoreBf16{(bf16_t*)(ws + OFF_PL1), CDIN}, lds);
    xcd_barrier(xb);
    PH(6, 12) scan_phase(P, lds);
#if REP_IDX == 12
    { xcd_barrier(xb); scan_phase(P, lds); }
#endif
    xcd_barrier(xb);
    PH(7, 13) zpass_phase(P);
    xcd_barrier(xb);
    PH(3, 14) gemm256_phase((const bf16_t*)(ws + OFF_AG), 128, (const bf16_t*)(ws + OFF_WG2), 128, NLAT, 768, 128, EpiGateMul{H}, lds);
    xcd_barrier(xb);
    PH(3, 15) gemm256_phase((const bf16_t*)H, DM, (const bf16_t*)(ws + OFF_WCD_OUT), DM, NLAT, DM, DM, EpiResidual{P.out, XLC, P.out, XLC, MOD1, 2}, lds);
    xcd_barrier(xb);
    PH(2, 16) rownorm_phase(P.out, XLC, NLAT, P.norm_gain + 3072, MOD1, 3, 4, H);
    xcd_barrier(xb);
    PH(3, 17) gemm256_phase((const bf16_t*)H, DM, (const bf16_t*)(ws + OFF_WFFN_IN + WFFN_IN_SZ), DM, NLAT, 5632, DM, EpiSwiglu{(bf16_t*)(ws + OFF_HID)}, lds);
    xcd_barrier(xb);
    PH(3, 18) gemm256_phase((const bf16_t*)(ws + OFF_HID), FFH, (const bf16_t*)(ws + OFF_WFFN_OUT + WFFN_OUT_SZ), FFH, NLAT, DM, FFH, EpiResidual{P.out, XLC, P.out, XLC, MOD1, 5}, lds);
    xcd_barrier(xb);
    PH(8, 19) finalnorm_phase(P);
}

extern "C" void kernel_launch(void* const* d_in, const int* in_sizes, int n_in, void* d_out, int out_size, void* d_ws, size_t ws_size, hipStream_t stream) {
    static int grid_blocks = 0;
    if (!grid_blocks) {
        int dev = 0, cus = 0, per_cu = 0;
        hipGetDevice(&dev);
        hipDeviceGetAttribute(&cus, hipDeviceAttributeMultiprocessorCount, dev);
        hipOccupancyMaxActiveBlocksPerMultiprocessor(&per_cu, (const void*)fwd_megakernel, 256, 0);
        if (per_cu < 1) per_cu = 1;
        if (per_cu > 2) per_cu = 2;
        grid_blocks = cus * per_cu;
    }
    Params p{};
    const float** pp = (const float**)&p;
    for (int i = 0; i < 30; ++i) pp[i] = (const float*)d_in[i];
    p.out = (float*)d_out; p.ws = (unsigned char*)d_ws;
    (void)hipMemsetAsync((unsigned char*)d_ws + OFF_BAR, 0, XCD_BAR_WORDS * 4, stream);
    void* args[] = {&p};
    hipError_t e = hipLaunchCooperativeKernel((const void*)fwd_megakernel, dim3(grid_blocks), dim3(256), args, 0, stream);
    if (e != hipSuccess) fprintf(stderr, "cooperative launch failed: %s (grid %d)\n", hipGetErrorString(e), grid_blocks);
}
```

```cpp
#include <hip/hip_runtime.h>
#include <hip/hip_cooperative_groups.h>
#include <cstdio>
#include <cstdint>
namespace cg = cooperative_groups;

typedef unsigned short bf16_t;
typedef short bf16x8 __attribute__((ext_vector_type(8)));
typedef float f32x4 __attribute__((ext_vector_type(4)));
typedef float f32x16 __attribute__((ext_vector_type(16)));
typedef float f32x2 __attribute__((ext_vector_type(2)));
typedef unsigned u32x4 __attribute__((ext_vector_type(4)));
typedef unsigned u32x2 __attribute__((ext_vector_type(2)));
#define DI __device__ __forceinline__

constexpr int NLAT = 65536, NCTX = 2048, NTOK = NLAT + NCTX, DM = 1024, SEQ = 8192, CTXL = 256;
constexpr int FFH = 2816, CDIN = 2944, KVLEN = SEQ + CTXL;
constexpr float EPS = 1e-6f, LNX_EPS = 64e-5f;
constexpr float QSCALE = 0.125f * 1.4426950408889634f, LOG2E = 1.4426950408889634f;

constexpr size_t MB = 1u << 20;
constexpr size_t OFF_WAB_IN = 0, OFF_WAB_OUT = 3 * MB, OFF_WCD_IN = 5 * MB, OFF_WCD_OUT = 11 * MB, OFF_WFFN_IN = 13 * MB, OFF_WFFN_OUT = 35 * MB,
                 OFF_WG2 = 46 * MB, OFF_MOD = 47 * MB, OFF_MODP = 48 * MB, OFF_ROPE = 52 * MB, OFF_XLC = 53 * MB, OFF_H = 61 * MB, OFF_BIG = 193 * MB;
constexpr size_t OFF_PL0 = OFF_BIG, OFF_KB = OFF_BIG + 198 * MB, OFF_VT = OFF_BIG + 231 * MB;
constexpr size_t OFF_HID = OFF_BIG;
constexpr size_t OFF_PL1 = OFF_BIG, OFF_YF = OFF_BIG + 380 * MB, OFF_YB = OFF_BIG + 476 * MB, OFF_AG = OFF_BIG + 572 * MB, OFF_BONUS = OFF_BIG + 588 * MB;
constexpr size_t WFFN_IN_SZ = 11 * MB, WFFN_OUT_SZ = (size_t)1024 * 2816 * 2;

struct Params {
    const float *x, *c, *ctx, *c_ctx, *norm_gain, *ada_w, *ada_b, *ffn_w_in, *ffn_w_out, *final_gain, *ab_w_in, *ab_q_gain, *ab_k_gain, *ab_sink, *ab_w_out,
        *cd_w_in, *cd_mu, *cd_w0, *cd_w2, *cd_a0, *cd_a2, *cd_g2, *cd_k_k, *cd_k_a, *cd_r_k, *cd_lnx_w, *cd_lnx_b, *cd_pool_w, *cd_pool_scale, *cd_w_out;
    float* out; unsigned char* ws;
};

DI float bf2f(bf16_t b) { return __uint_as_float(((unsigned)b) << 16); }
typedef __bf16 bf16x2v __attribute__((ext_vector_type(2)));
DI unsigned pk2(float lo, float hi) { const f32x2 v = {lo, hi}; return __builtin_bit_cast(unsigned, __builtin_convertvector(v, bf16x2v)); }
DI bf16_t f2bf(float f) { return __builtin_bit_cast(bf16_t, (__bf16)f); }
DI float lo16(unsigned u) { return __uint_as_float(u << 16); }
DI float hi16(unsigned u) { return __uint_as_float(u & 0xffff0000u); }
DI float sigmoidf_(float x) { return __builtin_amdgcn_rcpf(1.0f + __builtin_amdgcn_exp2f(-1.4426950408889634f * x)); }
DI float quad_sum(float x) {
    x += __int_as_float(__builtin_amdgcn_mov_dpp(__float_as_int(x), 0xB1, 0xf, 0xf, true));
    x += __int_as_float(__builtin_amdgcn_mov_dpp(__float_as_int(x), 0x4E, 0xf, 0xf, true));
    return x;
}
DI float oct_sum(float x) { x = quad_sum(x); x += __int_as_float(__builtin_amdgcn_mov_dpp(__float_as_int(x), 0x141, 0xf, 0xf, true)); return x; }
DI int otid() { int t = threadIdx.x; asm volatile("" : "+v"(t)); return t; }
DI unsigned swz(int row, int chunk) { return (unsigned)row * 128u + (unsigned)((chunk ^ ((row >> 1) & 7)) << 4); }
#define MFMA32(a, b, c) __builtin_amdgcn_mfma_f32_32x32x16_bf16((a), (b), (c), 0, 0, 0)
#define MFMA16(a, b, c) __builtin_amdgcn_mfma_f32_16x16x32_bf16((a), (b), (c), 0, 0, 0)
DI int crow(int r, int hi) { return (r & 3) + 8 * (r >> 2) + 4 * hi; }

template <class Epi>
DI void gemm_phase(const bf16_t* __restrict__ A, int lda, const bf16_t* __restrict__ Bt, int ldb, int M, int N, int K, const Epi& epi, unsigned char* lds) {
    const int tid = otid(), lane = tid & 63, wave = tid >> 6, wm = wave >> 1, wn = wave & 1;
    const int nNt = N / 128, nk = K / 64;
    const int lr = tid >> 3, lc = tid & 7, l31 = lane & 31, lh = lane >> 5;
    const int G8 = gridDim.x >> 3, xcd = blockIdx.x & 7, lb = blockIdx.x >> 3, mper = (M / 128) >> 3, per = mper * nNt;
    for (int lt = lb; lt < per; lt += G8) {
        const int grp = lt / (8 * nNt), q = lt - grp * 8 * nNt, gs = (mper - grp * 8) < 8 ? (mper - grp * 8) : 8;
        const int tn = q / gs, tm = xcd * mper + grp * 8 + (q - tn * gs);
        const bf16_t* Ag = A + (size_t)(tm * 128 + lr) * lda + lc * 8;
        const bf16_t* Bg = Bt + (size_t)(tn * 128 + lr) * ldb + lc * 8;
        f32x16 acc[2][2];
#pragma unroll
        for (int i = 0; i < 2; ++i)
#pragma unroll
            for (int j = 0; j < 2; ++j)
#pragma unroll
                for (int r = 0; r < 16; ++r) acc[i][j][r] = 0.f;
        u32x4 ra0[4], rb0[4], ra1[4], rb1[4];
#define G_LOAD(RA, RB, KT) { _Pragma("unroll") for (int i = 0; i < 4; ++i) { RA[i] = *(const u32x4*)(Ag + (size_t)(32 * i) * lda + (KT) * 64); RB[i] = *(const u32x4*)(Bg + (size_t)(32 * i) * ldb + (KT) * 64); } }
#define G_STORE(RA, RB, BUF) { _Pragma("unroll") for (int i = 0; i < 4; ++i) { *(u32x4*)((BUF) + swz(lr + 32 * i, lc)) = RA[i]; *(u32x4*)((BUF) + 16384 + swz(lr + 32 * i, lc)) = RB[i]; } }
#define G_COMPUTE(BUF) { _Pragma("unroll") for (int ks = 0; ks < 4; ++ks) { bf16x8 af[2], bfr[2]; \
            _Pragma("unroll") for (int i = 0; i < 2; ++i) { af[i] = *(const bf16x8*)((BUF) + swz(wm * 64 + i * 32 + l31, 2 * ks + lh)); bfr[i] = *(const bf16x8*)((BUF) + 16384 + swz(wn * 64 + i * 32 + l31, 2 * ks + lh)); } \
            _Pragma("unroll") for (int i = 0; i < 2; ++i) _Pragma("unroll") for (int j = 0; j < 2; ++j) acc[i][j] = MFMA32(af[i], bfr[j], acc[i][j]); } }
        G_LOAD(ra0, rb0, 0)
        if (nk > 1) G_LOAD(ra1, rb1, 1)
        G_STORE(ra0, rb0, lds)
        __syncthreads();
        for (int kt = 0; kt < nk; kt += 2) {
            if (kt + 2 < nk) G_LOAD(ra0, rb0, kt + 2)
            G_COMPUTE(lds)
            if (kt + 1 < nk) G_STORE(ra1, rb1, lds + 32768)
            __syncthreads();
            if (kt + 1 < nk) {
                if (kt + 3 < nk) G_LOAD(ra1, rb1, kt + 3)
                G_COMPUTE(lds + 32768)
                if (kt + 2 < nk) G_STORE(ra0, rb0, lds)
                __syncthreads();
            }
        }
#undef G_LOAD
#undef G_STORE
#undef G_COMPUTE
        int lane_e = lane; asm volatile("" : "+v"(lane_e));
        epi.template operator()<2>(acc, tm * 128 + wm * 64, tn * 128 + wn * 64, lane_e);
    }
}

template <class Epi>
DI void gemm256_phase(const bf16_t* __restrict__ A, int lda, const bf16_t* __restrict__ Bt, int ldb, int M, int N, int K, const Epi& epi, unsigned char* lds) {
    const int tid = otid(), lane = tid & 63, wave = tid >> 6, wm = wave >> 1, wn = wave & 1;
    const int nNt = N / 256, nk = K / 64;
    const int lr = tid >> 3, lc = tid & 7, l31 = lane & 31, lh = lane >> 5;
    const int G8 = gridDim.x >> 3, xcd = blockIdx.x & 7, lb = blockIdx.x >> 3, mper = (M / 128) >> 3, per = mper * nNt;
    const unsigned c0 = (unsigned)(lh ^ ((l31 >> 1) & 7)), roA = (unsigned)(wm * 8192 + l31 * 128), roB = (unsigned)(16384 + wn * 16384 + l31 * 128);
    for (int lt = lb; lt < per; lt += G8) {
        const int grp = lt / (8 * nNt), q = lt - grp * 8 * nNt, gs = (mper - grp * 8) < 8 ? (mper - grp * 8) : 8;
        const int tn = q / gs, tm = xcd * mper + grp * 8 + (q - tn * gs);
        const bf16_t* Au = A + (size_t)(tm * 128) * lda;
        const bf16_t* Bu = Bt + (size_t)(tn * 256) * ldb;
        const unsigned voA = (unsigned)(lr * lda + lc * 8), voB = (unsigned)(lr * ldb + lc * 8);
        f32x16 acc[2][4];
#pragma unroll
        for (int i = 0; i < 2; ++i)
#pragma unroll
            for (int j = 0; j < 4; ++j)
#pragma unroll
                for (int r = 0; r < 16; ++r) acc[i][j][r] = 0.f;
        u32x4 ra[4], rb[8];
#pragma unroll
        for (int i = 0; i < 4; ++i) ra[i] = *(const u32x4*)((Au + (size_t)(32 * i) * lda) + voA);
#pragma unroll
        for (int i = 0; i < 8; ++i) rb[i] = *(const u32x4*)((Bu + (size_t)(32 * i) * ldb) + voB);
        for (int kt = 0; kt < nk; ++kt) {
#pragma unroll
            for (int i = 0; i < 4; ++i) *(u32x4*)(lds + swz(lr + 32 * i, lc)) = ra[i];
#pragma unroll
            for (int i = 0; i < 8; ++i) *(u32x4*)(lds + 16384 + swz(lr + 32 * i, lc)) = rb[i];
            __syncthreads();
            if (kt + 1 < nk) {
#pragma unroll
                for (int i = 0; i < 4; ++i) ra[i] = *(const u32x4*)((Au + (size_t)(32 * i) * lda + (kt + 1) * 64) + voA);
#pragma unroll
                for (int i = 0; i < 8; ++i) rb[i] = *(const u32x4*)((Bu + (size_t)(32 * i) * ldb + (kt + 1) * 64) + voB);
            }
            __builtin_amdgcn_s_setprio(1);
#pragma unroll 2
            for (int ks = 0; ks < 4; ++ks) {
                bf16x8 af[2], bfr[4];
                const unsigned xo = (c0 ^ (unsigned)(2 * ks)) << 4;
#pragma unroll
                for (int i = 0; i < 2; ++i) af[i] = *(const bf16x8*)(lds + (roA + xo) + i * 4096);
#pragma unroll
                for (int j = 0; j < 4; ++j) bfr[j] = *(const bf16x8*)(lds + (roB + xo) + j * 4096);
#pragma unroll
                for (int i = 0; i < 2; ++i)
#pragma unroll
                    for (int j = 0; j < 4; ++j) acc[i][j] = MFMA32(af[i], bfr[j], acc[i][j]);
            }
            __builtin_amdgcn_s_setprio(0);
            __syncthreads();
        }
        int lane_e = lane; asm volatile("" : "+v"(lane_e));
        epi.template operator()<4>(acc, tm * 128 + wm * 64, tn * 256 + wn * 128, lane_e);
    }
}

DI int cu(int r) { return (r & 3) + 8 * (r >> 2); }
struct EpiStoreBf16 {
    bf16_t* C; int ldc;
    template <int NI> DI void operator()(const f32x16 (&acc)[2][NI], int row0, int col0, int lane) const {
        if (col0 >= ldc) return;
        const unsigned lo = (unsigned)(4 * (lane >> 5) * ldc + (lane & 31));
        bf16_t* base = C + (size_t)row0 * ldc + col0;
#pragma unroll
        for (int mi = 0; mi < 2; ++mi)
#pragma unroll
            for (int ni = 0; ni < NI; ++ni)
#pragma unroll
                for (int r = 0; r < 16; ++r) (base + (size_t)(32 * mi + cu(r)) * ldc + 32 * ni)[lo] = f2bf(acc[mi][ni][r]);
    }
};
struct EpiResidual {
    const float* srcL; const float* srcC; float* dstL; float* dstC; const float* mod; int gate_idx;
    template <int NI> DI void operator()(const f32x16 (&acc)[2][NI], int row0, int col0, int lane) const {
        const bool lat = row0 < NLAT;
        const float* src = (lat ? srcL + (size_t)row0 * DM : srcC + (size_t)(row0 - NLAT) * DM) + col0;
        float* dst = (lat ? dstL + (size_t)row0 * DM : dstC + (size_t)(row0 - NLAT) * DM) + col0;
        const float* g = mod + ((lat ? (row0 >> 13) : 8) * 6 + gate_idx) * 1024 + col0;
        const unsigned l31 = lane & 31, lo = (unsigned)(4 * (lane >> 5) * DM) + l31;
#pragma unroll
        for (int ni = 0; ni < NI; ++ni) {
            const float gv = (g + 32 * ni)[l31];
            float sv[32];
#pragma unroll
            for (int q = 0; q < 32; ++q) sv[q] = (src + (32 * (q >> 4) + cu(q & 15)) * DM + 32 * ni)[lo];
#pragma unroll
            for (int q = 0; q < 32; ++q) (dst + (32 * (q >> 4) + cu(q & 15)) * DM + 32 * ni)[lo] = sv[q] + gv * acc[q >> 4][ni][q & 15];
            asm volatile("" ::: "memory");
        }
    }
};
struct EpiInprojL0 {
    bf16_t* C; const float* qgain; const float* ct; const float* st;
    template <int NI> DI void operator()(const f32x16 (&acc)[2][NI], int row0, int col0, int lane) const {
        const int l31 = lane & 31, lh = lane >> 5;
        const unsigned lo = (unsigned)(4 * lh * 1536 + l31);
        bf16_t* base = C + (size_t)row0 * 1536 + col0;
        if (col0 >= 1024) {
#pragma unroll
            for (int mi = 0; mi < 2; ++mi)
#pragma unroll
                for (int ni = 0; ni < NI; ++ni)
#pragma unroll
                    for (int r = 0; r < 16; ++r) (base + (size_t)(32 * mi + cu(r)) * 1536 + 32 * ni)[lo] = f2bf(acc[mi][ni][r]);
            return;
        }
        const bool lat = row0 < NLAT, isB = col0 >= 512;
        const int tlane = (row0 & 8191) + 4 * lh;
        const float g1 = qgain[l31], g2 = qgain[l31 + 32];
#pragma unroll
        for (int mi = 0; mi < 2; ++mi)
#pragma unroll
            for (int r = 0; r < 16; ++r) {
                float c = 1.f, sn = 0.f;
                if (lat) { const int t = tlane + 32 * mi + cu(r); const int pos = l31 < 16 ? (t >> 6) : (t & 63); c = ct[pos * 16 + (l31 & 15)]; sn = st[pos * 16 + (l31 & 15)]; }
#pragma unroll
                for (int hp = 0; hp < NI / 2; ++hp) {
                    float x1 = acc[mi][2 * hp][r], x2 = acc[mi][2 * hp + 1][r];
                    if (isB) {
                        float ss = x1 * x1 + x2 * x2;
#pragma unroll
                        for (int o = 16; o > 0; o >>= 1) ss += __shfl_xor(ss, o);
                        const float rs = rsqrtf(ss * (1.0f / 64.0f) + EPS);
                        x1 = x1 * rs * g1; x2 = x2 * rs * g2;
                    }
                    const float o1 = x1 * c - x2 * sn, o2 = x2 * c + x1 * sn;
                    bf16_t* p = base + (size_t)(32 * mi + cu(r)) * 1536 + 64 * hp;
                    p[lo] = f2bf(o1 * QSCALE); (p + 32)[lo] = f2bf(o2 * QSCALE);
                }
            }
    }
};
struct EpiSwiglu {
    bf16_t* Hd;
    template <int NI> DI void operator()(const f32x16 (&acc)[2][NI], int row0, int col0, int lane) const {
        const unsigned lo = (unsigned)(4 * (lane >> 5) * FFH + (lane & 31));
        bf16_t* base = Hd + (size_t)row0 * FFH + (col0 >> 1);
#pragma unroll
        for (int pr = 0; pr < NI / 2; ++pr)
#pragma unroll
            for (int mi = 0; mi < 2; ++mi)
#pragma unroll
                for (int r = 0; r < 16; ++r) { const float g = acc[mi][2 * pr][r], u = acc[mi][2 * pr + 1][r]; (base + (32 * mi + cu(r)) * FFH + 32 * pr)[lo] = f2bf(g * sigmoidf_(g) * u); }
    }
};
struct EpiGateMul {
    bf16_t* Y;
    template <int NI> DI void operator()(const f32x16 (&acc)[2][NI], int row0, int col0, int lane) const {
        const unsigned lo = (unsigned)(4 * (lane >> 5) * DM + (lane & 31));
        bf16_t* base = Y + (size_t)row0 * DM + col0;
#pragma unroll
        for (int mi = 0; mi < 2; ++mi)
#pragma unroll
            for (int ni = 0; ni < NI; ++ni)
#pragma unroll
                for (int r = 0; r < 16; ++r) { bf16_t* p = base + (32 * mi + cu(r)) * DM + 32 * ni; p[lo] = f2bf(bf2f(p[lo]) * acc[mi][ni][r]); }
    }
};

DI void transpose_tile(const float* __restrict__ W, int ldw, int K, bf16_t* __restrict__ Wt, int k0, int n0, int ffn_map, float* t  ) {
    const int tid = otid();
    {
        const int n = tid & 63; int src = n0 + n;
        if (ffn_map) { const int np = n0 + n; const int j32 = np >> 6, s = (np >> 5) & 1, i = np & 31; src = s * FFH + j32 * 32 + i; }
#pragma unroll
        for (int i = 0; i < 16; ++i) { const int k = i * 4 + (tid >> 6); t[k * 65 + n] = W[(size_t)(k0 + k) * ldw + src]; }
    }
    __syncthreads();
#pragma unroll
    for (int i = 0; i < 2; ++i) {
        const int n = (tid >> 3) + 32 * i, kc = tid & 7;
        u32x4 v;
        v.x = pk2(t[(kc * 8 + 0) * 65 + n], t[(kc * 8 + 1) * 65 + n]); v.y = pk2(t[(kc * 8 + 2) * 65 + n], t[(kc * 8 + 3) * 65 + n]);
        v.z = pk2(t[(kc * 8 + 4) * 65 + n], t[(kc * 8 + 5) * 65 + n]); v.w = pk2(t[(kc * 8 + 6) * 65 + n], t[(kc * 8 + 7) * 65 + n]);
        *(u32x4*)(Wt + (size_t)(n0 + n) * K + k0 + kc * 8) = v;
    }
    __syncthreads();
}
DI void prep_phase(const Params& P, unsigned char* lds) {
    float* t = (float*)lds;
    unsigned char* ws = P.ws;
    for (int j = blockIdx.x; j < 5880; j += gridDim.x) {
        const float* W; int ldw, K, Nout, map = 0, jj = j; bf16_t* Wt;
        if (jj < 384) { W = P.ab_w_in; ldw = 1536; K = 1024; Nout = 1536; Wt = (bf16_t*)(ws + OFF_WAB_IN); }
        else if ((jj -= 384) < 256) { W = P.ab_w_out; ldw = 1024; K = 1024; Nout = 1024; Wt = (bf16_t*)(ws + OFF_WAB_OUT); }
        else if ((jj -= 256) < 736) { W = P.cd_w_in; ldw = CDIN; K = 1024; Nout = CDIN; Wt = (bf16_t*)(ws + OFF_WCD_IN); }
        else if ((jj -= 736) < 256) { W = P.cd_w_out; ldw = 1024; K = 1024; Nout = 1024; Wt = (bf16_t*)(ws + OFF_WCD_OUT); }
        else if ((jj -= 256) < 2816) { const int l = jj / 1408; jj -= l * 1408; W = P.ffn_w_in + (size_t)l * 1024 * 5632; ldw = 5632; K = 1024; Nout = 5632; map = 1; Wt = (bf16_t*)(ws + OFF_WFFN_IN + l * WFFN_IN_SZ); }
        else if ((jj -= 2816) < 1408) { const int l = jj / 704; jj -= l * 704; W = P.ffn_w_out + (size_t)l * FFH * 1024; ldw = 1024; K = FFH; Nout = 1024; Wt = (bf16_t*)(ws + OFF_WFFN_OUT + l * WFFN_OUT_SZ); }
        else { jj -= 1408; W = P.cd_g2; ldw = 768; K = 128; Nout = 768; Wt = (bf16_t*)(ws + OFF_WG2); }
        const int nNt = Nout / 64; const int kt = jj / nNt, nt = jj - kt * nNt;
        transpose_tile(W, ldw, K, Wt, kt * 64, nt * 64, map, t);
    }
    float* MODP = (float*)(ws + OFF_MODP);
    for (int j = blockIdx.x; j < 384; j += gridDim.x) {
        const int l = j / 192, r2 = j % 192, ks = r2 / 24, cb = r2 % 24;
        const int tid = otid();
        __syncthreads();
        for (int e = tid; e < 9 * 128; e += 256) { const int r = e >> 7, kk = e & 127; const float v = r < 8 ? P.c[r * 1024 + ks * 128 + kk] : P.c_ctx[ks * 128 + kk]; t[e] = v * sigmoidf_(v); }
        __syncthreads();
        const int col = cb * 256 + tid;
        const float* w = P.ada_w + ((size_t)l * 1024 + ks * 128) * 6144 + col;
        float a[9];
#pragma unroll
        for (int r = 0; r < 9; ++r) a[r] = 0.f;
#pragma unroll 4
        for (int kk = 0; kk < 128; ++kk) { const float wv = w[(size_t)kk * 6144];
#pragma unroll
            for (int r = 0; r < 9; ++r) a[r] += t[r * 128 + kk] * wv; }
#pragma unroll
        for (int r = 0; r < 9; ++r) MODP[((size_t)(ks * 2 + l) * 9 + r) * 6144 + col] = a[r];
    }
    if (blockIdx.x == 0) {
        float* ct = (float*)(ws + OFF_ROPE); float* st = ct + 2048;
        for (int e = otid(); e < 2048; e += 256) {
            const int pos = e >> 4, j = e & 15;
            const float inv = exp2f(-(float)j * (13.287712379549449f / 16.0f));
            const float ang = (float)pos * inv;
            double rev = (double)ang * 0.15915494309189535; rev -= floor(rev);
            const float rv = (float)rev;
            ct[e] = __builtin_amdgcn_cosf(rv); st[e] = __builtin_amdgcn_sinf(rv);
        }
    }
}
DI void modfinal_phase(const Params& P) {
    const float* MODP = (const float*)(P.ws + OFF_MODP); float* MOD = (float*)(P.ws + OFF_MOD);
    for (int e = blockIdx.x * 256 + otid(); e < 2 * 9 * 6144; e += gridDim.x * 256) {
        const int l = e / (9 * 6144), col = e % 6144;
        float s = P.ada_b[l * 6144 + col];
#pragma unroll
        for (int ks = 0; ks < 8; ++ks) s += MODP[(size_t)ks * (2 * 9 * 6144) + e];
        MOD[e] = s;
    }
}

DI void rownorm_phase(const float* srcL, const float* srcC, int M, const float* __restrict__ gain, const float* __restrict__ mod, int shift_idx, int scale_idx, bf16_t* __restrict__ H) {
    const int lane = otid() & 63, wave = otid() >> 6;
    for (int row = blockIdx.x * 4 + wave; row < M; row += gridDim.x * 4) {
        const bool lat = row < NLAT;
        const float* src = lat ? srcL + (size_t)row * DM : srcC + (size_t)(row - NLAT) * DM;
        const float* mrow = mod + (lat ? (row >> 13) : 8) * 6144;
        f32x4 v[4]; float ss = 0.f;
#pragma unroll
        for (int i = 0; i < 4; ++i) { v[i] = *(const f32x4*)(src + (i * 64 + lane) * 4); ss += v[i].x * v[i].x + v[i].y * v[i].y + v[i].z * v[i].z + v[i].w * v[i].w; }
#pragma unroll
        for (int o = 32; o > 0; o >>= 1) ss += __shfl_xor(ss, o);
        const float rs = rsqrtf(ss * (1.0f / 1024.0f) + EPS);
#pragma unroll
        for (int i = 0; i < 4; ++i) {
            const int col = (i * 64 + lane) * 4;
            const f32x4 g = *(const f32x4*)(gain + col), sc = *(const f32x4*)(mrow + scale_idx * 1024 + col), sh = *(const f32x4*)(mrow + shift_idx * 1024 + col);
            const f32x4 y = (v[i] * rs * g) * (sc + 1.0f) + sh;
            u32x2 o; o.x = pk2(y.x, y.y); o.y = pk2(y.z, y.w);
            *(u32x2*)(H + (size_t)row * DM + col) = o;
        }
    }
}
DI void finalnorm_phase(const Params& P) {
    const int lane = otid() & 63, wave = otid() >> 6;
    for (int row = blockIdx.x * 4 + wave; row < NLAT; row += gridDim.x * 4) {
        float* src = P.out + (size_t)row * DM;
        f32x4 v[4]; float ss = 0.f;
#pragma unroll
        for (int i = 0; i < 4; ++i) { v[i] = *(const f32x4*)(src + (i * 64 + lane) * 4); ss += v[i].x * v[i].x + v[i].y * v[i].y + v[i].z * v[i].z + v[i].w * v[i].w; }
#pragma unroll
        for (int o = 32; o > 0; o >>= 1) ss += __shfl_xor(ss, o);
        const float rs = rsqrtf(ss * (1.0f / 1024.0f) + EPS);
#pragma unroll
        for (int i = 0; i < 4; ++i) { const int col = (i * 64 + lane) * 4; *(f32x4*)(src + col) = v[i] * rs * *(const f32x4*)(P.final_gain + col); }
    }
}

DI void qkprep_phase(const Params& P) {
    bf16_t* PL = (bf16_t*)(P.ws + OFF_PL0); bf16_t* KB = (bf16_t*)(P.ws + OFF_KB); bf16_t* VT = (bf16_t*)(P.ws + OFF_VT);
    const float* ct = (const float*)(P.ws + OFF_ROPE); const float* st = ct + 2048;
    const int tid = otid(), hw = tid >> 5, i = tid & 31;
    for (int unit = blockIdx.x; unit < NTOK / 64; unit += gridDim.x) {
        const int row0 = unit * 64; const bool lat = row0 < NLAT;
        const int b = lat ? (row0 >> 13) : ((row0 - NLAT) >> 8);
        const int pos0 = lat ? (row0 & 8191) : SEQ + ((row0 - NLAT) & 255);
        for (int it = 0; it < 8; ++it) {
            float xa[4], xb[4];
#pragma unroll
            for (int u = 0; u < 4; ++u) {
                const int task = hw + 8 * (4 * it + u); const int tok = task >> 2, slot = 16 + (task & 3);
                const int col = slot < 16 ? slot * 64 : (slot < 18 ? 1024 + (slot - 16) * 64 : 1280 + (slot - 18) * 64);
                const bf16_t* p = PL + (size_t)(row0 + tok) * 1536 + col;
                xa[u] = bf2f(p[i]); xb[u] = bf2f(p[i + 32]);
            }
#pragma unroll
            for (int u = 0; u < 4; ++u) {
                const int task = hw + 8 * (4 * it + u); const int tok = task >> 2, slot = 16 + (task & 3);
                const int col = slot < 16 ? slot * 64 : (slot < 18 ? 1024 + (slot - 16) * 64 : 1280 + (slot - 18) * 64);
                bf16_t* p = PL + (size_t)(row0 + tok) * 1536 + col;
                float x1 = xa[u], x2 = xb[u];
                const bool isB = (slot >= 8 && slot < 16) || slot >= 18;
                if (isB) {
                    float ss = x1 * x1 + x2 * x2;
#pragma unroll
                    for (int o = 16; o > 0; o >>= 1) ss += __shfl_xor(ss, o);
                    const float rs = rsqrtf(ss * (1.0f / 64.0f) + EPS);
                    const float* g = slot < 16 ? P.ab_q_gain : P.ab_k_gain;
                    x1 = x1 * rs * g[i]; x2 = x2 * rs * g[i + 32];
                }
                if (lat) {
                    const int t = pos0 + tok; const int pos = i < 16 ? (t >> 6) : (t & 63);
                    const float c = ct[pos * 16 + (i & 15)], sn = st[pos * 16 + (i & 15)];
                    const float o1 = x1 * c - x2 * sn, o2 = x2 * c + x1 * sn; x1 = o1; x2 = o2;
                }
                if (slot < 16) { p[i] = f2bf(x1 * QSCALE); p[i + 32] = f2bf(x2 * QSCALE); }
                else { bf16_t* kp = KB + ((size_t)(b * 4 + (slot - 16)) * KVLEN + pos0 + tok) * 64; kp[i] = f2bf(x1); kp[i + 32] = f2bf(x2); }
            }
        }
        const int d = tid & 63, tg = tid >> 6;
#pragma unroll
        for (int vs = 0; vs < 4; ++vs) {
            const int col = 1024 + (vs < 2 ? 128 + vs * 64 : 384 + (vs - 2) * 64);
            const bf16_t* src = PL + (size_t)(row0 + 16 * tg) * 1536 + col + d;
            unsigned v[16];
#pragma unroll
            for (int j = 0; j < 16; ++j) v[j] = src[(size_t)j * 1536];
            u32x4 a, bq;
            a.x = v[0] | (v[1] << 16); a.y = v[2] | (v[3] << 16); a.z = v[8] | (v[9] << 16); a.w = v[10] | (v[11] << 16);
            bq.x = v[4] | (v[5] << 16); bq.y = v[6] | (v[7] << 16); bq.z = v[12] | (v[13] << 16); bq.w = v[14] | (v[15] << 16);
            bf16_t* dst = VT + ((size_t)(b * 4 + vs) * 64 + d) * KVLEN + pos0 + 16 * tg;
            *(u32x4*)dst = a; *(u32x4*)(dst + 8) = bq;
        }
    }
}

DI void attn_phase(const Params& P, unsigned char* lds) {
    const bf16_t* PL = (const bf16_t*)(P.ws + OFF_PL0); const bf16_t* KB = (const bf16_t*)(P.ws + OFF_KB); const bf16_t* VT = (const bf16_t*)(P.ws + OFF_VT);
    bf16_t* Y = (bf16_t*)(P.ws + OFF_H);
    const int tid = otid(), lane = tid & 63, wave = tid >> 6, l31 = lane & 31, lh = lane >> 5;
    const int lr = tid >> 3, lc = tid & 7;
    for (int unit = blockIdx.x; unit < 8448; unit += gridDim.x) {
        int b, hq, kvh, qrow0, nW, wlo, qpos0 = 0; bool masked = false, has_sink;
        if (unit < 8192) {
            const int u = unit & 4095; b = u >> 9; const int r = u & 511, kvl = r >> 8, hl = (r >> 6) & 3, qb = r & 63;
            qrow0 = b * SEQ + qb * 128; qpos0 = qb * 128;
            if (unit < 4096) { hq = 8 + kvl * 4 + hl; kvh = 2 + kvl; nW = 132; wlo = 0; has_sink = false; }
            else { hq = kvl * 4 + hl; kvh = kvl; masked = true; has_sink = true;
                   const int s0 = qpos0 - 128 < 0 ? 0 : qpos0 - 128, s1 = qpos0 + 256 > SEQ ? SEQ : qpos0 + 256; wlo = s0 >> 6; nW = (s1 >> 6) - wlo; }
        } else { const int u = unit - 8192; b = u >> 5; hq = (u >> 1) & 15; const int qb = u & 1; kvh = hq < 8 ? (hq >> 2) : 2 + ((hq - 8) >> 2);
                 qrow0 = NLAT + b * CTXL + qb * 128; nW = 0; wlo = 0; has_sink = hq < 8; }
        const int nt = masked ? nW + 4 : (nW ? nW : 4);
        const int qrow = qrow0 + 32 * wave + l31;
        const int qpos = qpos0 + 32 * wave + l31;
        bf16x8 qf[4];
        { const bf16_t* qp = PL + (size_t)qrow * 1536 + hq * 64 + 8 * lh;
#pragma unroll
          for (int ks = 0; ks < 4; ++ks) qf[ks] = *(const bf16x8*)(qp + 16 * ks); }
        f32x16 o[2];
#pragma unroll
        for (int r = 0; r < 16; ++r) { o[0][r] = 0.f; o[1][r] = 0.f; }
        float m = -1e30f, l = 0.f;
        const bf16_t* kbase = KB + (size_t)(b * 4 + kvh) * KVLEN * 64;
        const bf16_t* vbase = VT + (size_t)(b * 4 + kvh) * 64 * KVLEN;
        u32x4 rk[2], rv[2];
        auto tile_of = [&](int i) __attribute__((always_inline)) { return (masked && i >= nW) ? 128 + (i - nW) : wlo + i + ((!masked && nW == 0) ? 128 : 0); };
        {
            const int p0 = tile_of(0) * 64;
#pragma unroll
            for (int j = 0; j < 2; ++j) { rk[j] = *(const u32x4*)(kbase + (size_t)(p0 + lr + 32 * j) * 64 + lc * 8); rv[j] = *(const u32x4*)(vbase + (size_t)(lr + 32 * j) * KVLEN + p0 + lc * 8); }
#pragma unroll
            for (int j = 0; j < 2; ++j) { *(u32x4*)(lds + swz(lr + 32 * j, lc)) = rk[j]; *(u32x4*)(lds + 8192 + swz(lr + 32 * j, lc)) = rv[j]; }
        }
        __syncthreads();
        for (int i = 0; i < nt; ++i) {
            unsigned char* cur = lds + (i & 1) * 16384; unsigned char* nxt = lds + ((i + 1) & 1) * 16384;
            const int p0 = tile_of(i) * 64; const bool more = i + 1 < nt;
            if (more) { const int p1 = tile_of(i + 1) * 64;
#pragma unroll
                for (int j = 0; j < 2; ++j) { rk[j] = *(const u32x4*)(kbase + (size_t)(p1 + lr + 32 * j) * 64 + lc * 8); rv[j] = *(const u32x4*)(vbase + (size_t)(lr + 32 * j) * KVLEN + p1 + lc * 8); } }
            const bool wtile = masked && i < nW;
            bool active = true;
            if (wtile) { const int qmin = qpos0 + 32 * wave; active = (p0 <= qmin + 31 + 128) && (p0 + 63 >= qmin - 128); }
            if (active) {
                f32x16 s[2];
                __builtin_amdgcn_s_setprio(1);
#pragma unroll
                for (int kt = 0; kt < 2; ++kt) {
#pragma unroll
                    for (int r = 0; r < 16; ++r) s[kt][r] = 0.f;
#pragma unroll
                    for (int ks = 0; ks < 4; ++ks) { const bf16x8 kf = *(const bf16x8*)(cur + swz(32 * kt + l31, 2 * ks + lh)); s[kt] = MFMA32(kf, qf[ks], s[kt]); }
                }
                __builtin_amdgcn_s_setprio(0);
                if (wtile) {
#pragma unroll
                    for (int kt = 0; kt < 2; ++kt)
#pragma unroll
                        for (int r = 0; r < 16; ++r) { const int kp = p0 + 32 * kt + crow(r, lh); const int dlt = qpos - kp; if (dlt > 128 || dlt < -128) s[kt][r] = -INFINITY; }
                }
                float mx = s[0][0];
#pragma unroll
                for (int kt = 0; kt < 2; ++kt)
#pragma unroll
                    for (int r = 0; r < 16; ++r) mx = fmaxf(mx, s[kt][r]);
                mx = fmaxf(mx, __shfl_xor(mx, 32));
                const float mn = (mx > m + 8.0f) ? mx : m;
                if (__builtin_amdgcn_ballot_w64(mn != m) != 0ull) {
                    const float alpha = __builtin_amdgcn_exp2f(m - mn);
                    l *= alpha;
#pragma unroll
                    for (int r = 0; r < 16; ++r) { o[0][r] *= alpha; o[1][r] *= alpha; }
                    m = mn;
                }
                float ps = 0.f;
#pragma unroll
                for (int kt = 0; kt < 2; ++kt)
#pragma unroll
                    for (int r = 0; r < 16; ++r) { const float pv = __builtin_amdgcn_exp2f(s[kt][r] - mn); s[kt][r] = pv; ps += pv; }
                l += ps;
                __builtin_amdgcn_s_setprio(1);
#pragma unroll
                for (int kt = 0; kt < 2; ++kt)
#pragma unroll
                    for (int sx = 0; sx < 2; ++sx) {
                        union { u32x4 u; bf16x8 h; } pf;
                        pf.u.x = pk2(s[kt][8 * sx + 0], s[kt][8 * sx + 1]); pf.u.y = pk2(s[kt][8 * sx + 2], s[kt][8 * sx + 3]);
                        pf.u.z = pk2(s[kt][8 * sx + 4], s[kt][8 * sx + 5]); pf.u.w = pk2(s[kt][8 * sx + 6], s[kt][8 * sx + 7]);
#pragma unroll
                        for (int dt = 0; dt < 2; ++dt) { const bf16x8 vf = *(const bf16x8*)(cur + 8192 + swz(32 * dt + l31, 2 * (2 * kt + sx) + lh)); o[dt] = MFMA32(vf, pf.h, o[dt]); }
                    }
                __builtin_amdgcn_s_setprio(0);
            }
            if (more) {
#pragma unroll
                for (int j = 0; j < 2; ++j) { *(u32x4*)(nxt + swz(lr + 32 * j, lc)) = rk[j]; *(u32x4*)(nxt + 8192 + swz(lr + 32 * j, lc)) = rv[j]; }
            }
            __syncthreads();
        }
        l += __shfl_xor(l, 32);
        if (has_sink) l += __builtin_amdgcn_exp2f(P.ab_sink[hq] * LOG2E - m);
        const float inv = 1.0f / l;
        bf16_t* yp = Y + (size_t)qrow * DM + hq * 64 + 4 * lh;
#pragma unroll
        for (int dt = 0; dt < 2; ++dt)
#pragma unroll
            for (int g = 0; g < 4; ++g) { u32x2 w; w.x = pk2(o[dt][4 * g] * inv, o[dt][4 * g + 1] * inv); w.y = pk2(o[dt][4 * g + 2] * inv, o[dt][4 * g + 3] * inv); *(u32x2*)(yp + 32 * dt + 8 * g) = w; }
    }
}

DI float mix1(const bf16_t* p, bool hp, bool hn, float mu) {
    const float x = bf2f(p[0]); const float xp = hp ? bf2f(*(p - CDIN)) : 0.f; const float xn = hn ? bf2f(*(p + CDIN)) : 0.f;
    return x + (0.5f * (xp + xn) - x) * mu;
}
DI void mix8(const bf16_t* p, bool hp, bool hn, const float (&mu)[8], float (&o)[8]) {
    const u32x4 z = {0u, 0u, 0u, 0u};
    const u32x4 x = *(const u32x4*)p; const u32x4 xp = hp ? *(const u32x4*)(p - CDIN) : z; const u32x4 xn = hn ? *(const u32x4*)(p + CDIN) : z;
#pragma unroll
    for (int i = 0; i < 4; ++i) {
        const float a0 = lo16(x[i]), a1 = hi16(x[i]);
        o[2 * i] = a0 + (0.5f * (lo16(xp[i]) + lo16(xn[i])) - a0) * mu[2 * i];
        o[2 * i + 1] = a1 + (0.5f * (hi16(xp[i]) + hi16(xn[i])) - a1) * mu[2 * i + 1];
    }
}
template <int MODE>
DI void scan_chain(const Params& P, int chain, unsigned char* lds) {
    const int otid_ = otid(); const int lane = otid_ & 63, wave = (otid_ >> 6) ^ (((((int)blockIdx.x >> 8) ^ (int)blockIdx.x) & 1) ? 2 : 0), tid = wave * 64 + lane;
    const int half = chain & 1, chn = chain >> 1;
    const int b = chn / 24, rem = chn % 24, h = rem >> 1, dir = rem & 1;
    const bf16_t* PL = (const bf16_t*)(P.ws + OFF_PL1);
    bf16_t* Yd = (bf16_t*)(P.ws + (dir ? OFF_YB : OFF_YF));
    float* BON = (float*)(P.ws + OFF_BONUS) + (size_t)dir * NLAT * 12;
    float* buf = (float*)lds;
    float* ybuf = buf + 2 * 6144;
    const int NCH = 528;
    f32x2 S0[4], S1[4];
#pragma unroll
    for (int j = 0; j < 4; ++j) { S0[j] = (f32x2){0.f, 0.f}; S1[j] = (f32x2){0.f, 0.f}; }
    const int q8 = lane & 7, r0 = 32 * half + 16 * (wave & 1) + (lane >> 3), r1 = r0 + 8;
    const int kg = lane >> 4, n16 = lane & 15;
    bf16x8 lf[4][2];
    if (wave >= 2) {
        const float* l2 = (wave == 2 ? P.cd_a2 : P.cd_w2) + (size_t)dir * 64 * 768;
#pragma unroll
        for (int nt = 0; nt < 4; ++nt)
#pragma unroll
            for (int ks = 0; ks < 2; ++ks) {
                union { u32x4 u; bf16x8 hh; } f; const float* s = l2 + (size_t)(32 * ks + 8 * kg) * 768 + 64 * h + 16 * nt + n16;
                f.u.x = pk2(s[0], s[768]); f.u.y = pk2(s[2 * 768], s[3 * 768]); f.u.z = pk2(s[4 * 768], s[5 * 768]); f.u.w = pk2(s[6 * 768], s[7 * 768]);
                lf[nt][ks] = f.hh;
            }
    }
    float* cw = buf + 13312 + (wave & 1) * 384;
    if (wave >= 2) {
        const int ch = lane;
        if (wave == 2) { cw[ch] = P.cd_a0[dir * 768 + 64 * h + ch]; cw[64 + ch] = P.cd_k_k[64 * h + ch]; cw[128 + ch] = P.cd_k_a[64 * h + ch]; cw[192 + ch] = P.cd_r_k[64 * h + ch];
                         cw[256 + ch] = P.cd_mu[768 + 64 * h + ch]; cw[320 + ch] = P.cd_mu[64 * h + ch]; }
        else { cw[ch] = P.cd_w0[dir * 768 + 64 * h + ch]; cw[256 + ch] = P.cd_mu[1536 + 64 * h + ch]; cw[320 + ch] = P.cd_mu[64 * h + ch]; }
        buf[13312 + 768 + (wave - 2) * 64 + ch] = P.cd_mu[(wave == 2 ? 2432 : 2304) + 64 * dir + ch];
        asm volatile("s_waitcnt lgkmcnt(0)" ::: "memory");
    }
    auto chunk_info = [&](int c, int& seqrow0, int& len, int& t0) __attribute__((always_inline)) {
        if (c < 16) { seqrow0 = NLAT + b * CTXL; len = CTXL; t0 = dir ? 240 - 16 * c : 16 * c; }
        else { const int cc = c - 16; seqrow0 = b * SEQ; len = SEQ; t0 = dir ? SEQ - 16 - 16 * cc : 16 * cc; }
    };
    u32x4 xr[3][2], ar[3][2];
    auto issue_loads = [&](int c) __attribute__((always_inline)) {
        int seqrow0, len, t0; chunk_info(c, seqrow0, len, t0);
        const u32x4 z4 = {0u, 0u, 0u, 0u};
        { const int tok = lane >> 2, cq = lane & 3, t = t0 + tok; const bool hp = t > 0, hn = t + 1 < len;
          const bf16_t* prow = PL + (size_t)(seqrow0 + t) * CDIN + 64 * h + 16 * cq + (wave == 2 ? 768 : 1536);
#pragma unroll
          for (int j = 0; j < 2; ++j) { xr[1][j] = *(const u32x4*)(prow + 8 * j); xr[0][j] = hp ? *(const u32x4*)(prow - CDIN + 8 * j) : z4; xr[2][j] = hn ? *(const u32x4*)(prow + CDIN + 8 * j) : z4; } }
        { const int ta = t0 + n16; const bool hpa = ta > 0, hna = ta + 1 < len;
          const bf16_t* p = PL + (size_t)(seqrow0 + ta) * CDIN + (wave == 2 ? 2432 : 2304) + 64 * dir + 8 * kg;
#pragma unroll
          for (int ks = 0; ks < 2; ++ks) { ar[1][ks] = *(const u32x4*)(p + 32 * ks); ar[0][ks] = hpa ? *(const u32x4*)(p - CDIN + 32 * ks) : z4; ar[2][ks] = hna ? *(const u32x4*)(p + CDIN + 32 * ks) : z4; } }
    };
    auto produce = [&](int c) __attribute__((always_inline)) {
        int seqrow0, len, t0; chunk_info(c, seqrow0, len, t0);
        float* bb = buf + (c & 1) * 6144;
        float* scr = buf + 14336 + (wave - 2) * 1024;
        const int tok = lane >> 2, cq = lane & 3, t = t0 + tok; const bool hp = t > 0, hn = t + 1 < len;
        const bf16_t* prow = PL + (size_t)(seqrow0 + t) * CDIN + 64 * h + 16 * cq;
        const int cb = 64 * h + 16 * cq;
        const int xcol = wave == 2 ? 768 : 1536;
        const u32x4 z4 = {0u, 0u, 0u, 0u};
        u32x4 rr_[3][2];
#pragma unroll
        for (int j = 0; j < 2; ++j) { rr_[1][j] = *(const u32x4*)(prow + 8 * j); rr_[0][j] = hp ? *(const u32x4*)(prow - CDIN + 8 * j) : z4; rr_[2][j] = hn ? *(const u32x4*)(prow + CDIN + 8 * j) : z4; }
        bf16x8 af[2];
        {
            const float* mulp = buf + 13312 + 768 + (wave - 2) * 64 + 8 * kg;
#pragma unroll
            for (int ks = 0; ks < 2; ++ks) {
                const f32x4 m0 = *(const f32x4*)(mulp + 32 * ks), m1 = *(const f32x4*)(mulp + 32 * ks + 4);
                float xv[8];
#pragma unroll
                for (int e = 0; e < 4; ++e) {
                    const float a0 = lo16(ar[1][ks][e]), a1 = hi16(ar[1][ks][e]);
                    const float mu0 = e < 2 ? m0[2 * e] : m1[2 * e - 4], mu1 = e < 2 ? m0[2 * e + 1] : m1[2 * e - 3];
                    xv[2 * e] = a0 + (0.5f * (lo16(ar[0][ks][e]) + lo16(ar[2][ks][e])) - a0) * mu0;
                    xv[2 * e + 1] = a1 + (0.5f * (hi16(ar[0][ks][e]) + hi16(ar[2][ks][e])) - a1) * mu1;
                }
                if (wave == 3) {
#pragma unroll
                    for (int j = 0; j < 8; ++j) xv[j] = 1.0f - 2.0f * __builtin_amdgcn_rcpf(1.0f + __builtin_amdgcn_exp2f(2.8853900817779268f * xv[j]));
                }
                union { u32x4 u; bf16x8 hh; } f; f.u.x = pk2(xv[0], xv[1]); f.u.y = pk2(xv[2], xv[3]); f.u.z = pk2(xv[4], xv[5]); f.u.w = pk2(xv[6], xv[7]);
                af[ks] = f.hh;
            }
        }
        f32x4 acc[4];
#pragma unroll
        for (int nt = 0; nt < 4; ++nt) { acc[nt] = (f32x4){0.f, 0.f, 0.f, 0.f};
#pragma unroll
            for (int ks = 0; ks < 2; ++ks) acc[nt] = MFMA16(af[ks], lf[nt][ks], acc[nt]); }
#pragma unroll
        for (int nt = 0; nt < 4; ++nt)
#pragma unroll
            for (int rg = 0; rg < 4; ++rg) scr[(4 * kg + rg) * 64 + 16 * nt + n16] = acc[nt][rg];
        asm volatile("s_waitcnt lgkmcnt(0)" ::: "memory");
        const float* prep_ = scr + tok * 64 + 16 * cq;
        float xm[16];
        {
            const float* mux = cw + 256 + 16 * cq;
#pragma unroll
            for (int j = 0; j < 2; ++j)
#pragma unroll
                for (int e = 0; e < 4; ++e) {
                    const f32x2 mx2 = *(const f32x2*)(mux + 8 * j + 2 * e);
                    const float a0 = lo16(xr[1][j][e]), a1 = hi16(xr[1][j][e]);
                    xm[8 * j + 2 * e] = a0 + (0.5f * (lo16(xr[0][j][e]) + lo16(xr[2][j][e])) - a0) * mx2.x;
                    xm[8 * j + 2 * e + 1] = a1 + (0.5f * (hi16(xr[0][j][e]) + hi16(xr[2][j][e])) - a1) * mx2.y;
                }
        }
        float* o = bb + tok * 64 + 16 * cq;
        const float* mur = cw + 320 + 16 * cq;
        if (wave == 2) {
            float ss = 0.f, bonus = 0.f;
#pragma unroll
            for (int j = 0; j < 4; ++j) { const f32x4 kkc = *(const f32x4*)(cw + 64 + 16 * cq + 4 * j);
#pragma unroll
                for (int e = 0; e < 4; ++e) { const float kr = xm[4 * j + e] * kkc[e]; ss += kr * kr; } }
            ss = quad_sum(ss);
            const float inv = __builtin_amdgcn_rcpf(fmaxf(__builtin_amdgcn_sqrtf(ss), 1e-12f));
#pragma unroll
            for (int j = 0; j < 4; ++j) {
                asm volatile("" ::: "memory");
                const f32x4 a0 = *(const f32x4*)(cw + 16 * cq + 4 * j), kkc = *(const f32x4*)(cw + 64 + 16 * cq + 4 * j),
                            kac = *(const f32x4*)(cw + 128 + 16 * cq + 4 * j), rkc = *(const f32x4*)(cw + 192 + 16 * cq + 4 * j), mr = *(const f32x4*)(mur + 4 * j);
                const f32x4 pre = *(const f32x4*)(prep_ + 4 * j);
                f32x4 vkd, vb, vkk;
#pragma unroll
                for (int e = 0; e < 4; ++e) {
                    const int ix = 4 * j + e, jj = ix >> 3, ee = (ix & 7) >> 1; const bool hi = ix & 1;
                    const float r1 = hi ? hi16(rr_[1][jj][ee]) : lo16(rr_[1][jj][ee]), r0 = hi ? hi16(rr_[0][jj][ee]) : lo16(rr_[0][jj][ee]), r2 = hi ? hi16(rr_[2][jj][ee]) : lo16(rr_[2][jj][ee]);
                    const float r = r1 + (0.5f * (r0 + r2) - r1) * mr[e];
                    const float a = sigmoidf_(a0[e] + pre[e]);
                    const float kk = xm[ix] * kkc[e] * inv, kd = xm[ix] * (1.0f + (a - 1.0f) * kac[e]);
                    bonus += r * kd * rkc[e]; vkd[e] = kd; vb[e] = kk * a; vkk[e] = kk;
                }
                *(f32x4*)(o + 1024 + 4 * j) = vkd; *(f32x4*)(o + 2048 + 4 * j) = vb; *(f32x4*)(o + 3072 + 4 * j) = vkk;
            }
            bonus = quad_sum(bonus);
            if (c >= 16 && cq == 0 && half == 0) BON[(size_t)(seqrow0 + t) * 12 + h] = bonus;
        } else {
#pragma unroll
            for (int j = 0; j < 4; ++j) {
                asm volatile("" ::: "memory");
                const f32x4 w0 = *(const f32x4*)(cw + 16 * cq + 4 * j), mr = *(const f32x4*)(mur + 4 * j);
                const f32x4 pre = *(const f32x4*)(prep_ + 4 * j);
                f32x4 vw, vr, vv;
#pragma unroll
                for (int e = 0; e < 4; ++e) {
                    const int ix = 4 * j + e, jj = ix >> 3, ee = (ix & 7) >> 1; const bool hi = ix & 1;
                    const float r1 = hi ? hi16(rr_[1][jj][ee]) : lo16(rr_[1][jj][ee]), r0 = hi ? hi16(rr_[0][jj][ee]) : lo16(rr_[0][jj][ee]), r2 = hi ? hi16(rr_[2][jj][ee]) : lo16(rr_[2][jj][ee]);
                    vr[e] = r1 + (0.5f * (r0 + r2) - r1) * mr[e];
                    const float xs = -(w0[e] + pre[e]); const float sp = fmaxf(xs, 0.f) + 0.6931471805599453f * __builtin_amdgcn_logf(1.0f + __builtin_amdgcn_exp2f(-1.4426950408889634f * fabsf(xs)));
                    vw[e] = __builtin_amdgcn_exp2f(-1.4426950408889634f * __builtin_amdgcn_exp2f(-1.4426950408889634f * (sp + 0.5f))); vv[e] = xm[ix];
                }
                *(f32x4*)(o + 4 * j) = vw; *(f32x4*)(o + 4096 + 4 * j) = vr; *(f32x4*)(o + 5120 + 4 * j) = vv;
            }
        }
    };
    auto flush_y = [&](int c) __attribute__((always_inline)) {
        int seqrow0, len, t0; chunk_info(c, seqrow0, len, t0);
        const int p = tid - 128, tok = p >> 3, rl = (p & 7) * 4, rg = 32 * half + rl;
        const f32x4 a = *(const f32x4*)(ybuf + (c & 1) * 512 + tok * 32 + rl);
        u32x2 w; w.x = pk2(a.x, a.y); w.y = pk2(a.z, a.w);
        *(u32x2*)(Yd + (size_t)(seqrow0 + t0 + tok) * 768 + 64 * h + rg) = w;
    };
    struct SV { f32x4 kk[2], bv[2], kd[2], w[2], rr[2]; float v0, v1; };
#define SLOAD(S, TK) { const float* base_ = bb + (TK) * 64 + 8 * q8; \
        S.kk[0] = *(const f32x4*)(base_ + 3072); S.kk[1] = *(const f32x4*)(base_ + 3076); \
        S.bv[0] = *(const f32x4*)(base_ + 2048); S.bv[1] = *(const f32x4*)(base_ + 2052); S.kd[0] = *(const f32x4*)(base_ + 1024); S.kd[1] = *(const f32x4*)(base_ + 1028); \
        S.w[0] = *(const f32x4*)(base_); S.w[1] = *(const f32x4*)(base_ + 4); S.rr[0] = *(const f32x4*)(base_ + 4096); S.rr[1] = *(const f32x4*)(base_ + 4100); \
        S.v0 = bb[5 * 1024 + (TK) * 64 + r0]; S.v1 = bb[5 * 1024 + (TK) * 64 + r1]; }
#define SSTEP(S, TK) { \
        f32x2 a0 = {0.f, 0.f}, a1 = {0.f, 0.f}; \
        _Pragma("unroll") for (int j = 0; j < 4; ++j) { const f32x2 kj = {S.kk[j >> 1][2 * (j & 1)], S.kk[j >> 1][2 * (j & 1) + 1]}; a0 += S0[j] * kj; a1 += S1[j] * kj; } \
        const float sa0 = -oct_sum(a0.x + a0.y), sa1 = -oct_sum(a1.x + a1.y); \
        f32x2 y0 = {0.f, 0.f}, y1 = {0.f, 0.f}; \
        _Pragma("unroll") for (int j = 0; j < 4; ++j) { const int jj = j >> 1, e = 2 * (j & 1); \
            const f32x2 wj = {S.w[jj][e], S.w[jj][e + 1]}, bj = {S.bv[jj][e], S.bv[jj][e + 1]}, kj = {S.kd[jj][e], S.kd[jj][e + 1]}, rj = {S.rr[jj][e], S.rr[jj][e + 1]}; \
            S0[j] = S0[j] * wj + (bj * sa0 + kj * S.v0); S1[j] = S1[j] * wj + (bj * sa1 + kj * S.v1); \
            y0 += S0[j] * rj; y1 += S1[j] * rj; } \
        const float yy0 = oct_sum(y0.x + y0.y), yy1 = oct_sum(y1.x + y1.y); \
        if (q8 == 0) { yb[(TK) * 32 + (r0 & 31)] = yy0; yb[(TK) * 32 + (r1 & 31)] = yy1; } }
    auto scan_chunk = [&](int c) __attribute__((always_inline)) {
        const float* bb = buf + (c & 1) * 6144; float* yb = ybuf + (c & 1) * 512;
        const int t0s = dir ? 15 : 0, dt = dir ? -1 : 1;
        SV A, B;
        SLOAD(A, t0s)
        for (int ii = 0; ii < 16; ii += 2) {
            const int ta = t0s + dt * ii, tb = ta + dt, tc = tb + dt;
            SLOAD(B, tb)
            SSTEP(A, ta)
            if (ii + 2 < 16) SLOAD(A, tc)
            SSTEP(B, tb)
        }
    };
    if (__builtin_amdgcn_readfirstlane(wave) < 2) __builtin_amdgcn_s_setprio(2);
    if (wave >= 2) { issue_loads(0); produce(0); issue_loads(1); }
    __syncthreads();
    for (int c = 0; c < NCH; ++c) {
        if (wave < 2) { if (MODE != 1) scan_chunk(c); }
        else if (MODE != 2) {
            if (c >= 17) flush_y(c - 1);
            if (c + 1 < NCH) produce(c + 1);
            if (c + 2 < NCH) issue_loads(c + 2);
        }
        __syncthreads();
    }
    if (wave >= 2) flush_y(NCH - 1);
    __builtin_amdgcn_s_setprio(0);
    __syncthreads();
}

DI void pool_units(const Params& P, int first, int stride, unsigned char* lds) {
    const bf16_t* PL = (const bf16_t*)(P.ws + OFF_PL1); bf16_t* Y = (bf16_t*)(P.ws + OFF_H); bf16_t* AG = (bf16_t*)(P.ws + OFF_AG);
    float* pl = (float*)lds;
    const int tid = otid(), g = tid >> 6, i = tid & 63;
    float pw[64];
#pragma unroll
    for (int ii = 0; ii < 64; ++ii) pw[ii] = P.cd_pool_w[(size_t)(g * 64 + ii) * 64 + i];
    const float scale = P.cd_pool_scale[tid];
    const int wl = 1 << g, wr = 1 << g;
    float mug[8];
#pragma unroll
    for (int j = 0; j < 8; ++j) mug[j] = P.cd_mu[2560 + 8 * (tid & 15) + j];
    for (int u = first; u < NLAT / 32; u += stride) {
        const int row0 = u * 32, b = row0 >> 13, t0 = row0 & 8191;
        const bf16_t* col = PL + (size_t)(b * SEQ) * CDIN + 2688 + tid;
        __syncthreads();
        {
            int lo = t0 - wl < 0 ? 0 : t0 - wl, hi = t0 + wr > SEQ ? SEQ : t0 + wr;
            float sum = 0.f;
            for (int s = lo; s < hi; ++s) sum += bf2f(col[(size_t)s * CDIN]);
            for (int tok = 0; tok < 32; ++tok) {
                const int t = t0 + tok;
                lo = t - wl < 0 ? 0 : t - wl; hi = t + wr > SEQ ? SEQ : t + wr;
                pl[tok * 256 + tid] = sum / (float)(hi - lo) - bf2f(col[(size_t)t * CDIN]);
                if (t + wr < SEQ) sum += bf2f(col[(size_t)(t + wr) * CDIN]);
                if (t - wl >= 0) sum -= bf2f(col[(size_t)(t - wl) * CDIN]);
            }
        }
        __syncthreads();
        for (int tok = 0; tok < 32; ++tok) {
            const float* pp = pl + tok * 256 + g * 64; float acc = 0.f;
#pragma unroll
            for (int ii = 0; ii < 16; ++ii) { const f32x4 v = *(const f32x4*)(pp + 4 * ii); acc += v.x * pw[4 * ii] + v.y * pw[4 * ii + 1] + v.z * pw[4 * ii + 2] + v.w * pw[4 * ii + 3]; }
            Y[(size_t)(row0 + tok) * DM + 768 + tid] = f2bf(acc * scale);
        }
#pragma unroll
        for (int hh = 0; hh < 2; ++hh) {
            const int tok = (tid >> 4) + 16 * hh, t = t0 + tok;
            float xv[8]; mix8(PL + (size_t)(row0 + tok) * CDIN + 2560 + 8 * (tid & 15), t > 0, t + 1 < SEQ, mug, xv);
            u32x4 w; w.x = pk2(sigmoidf_(xv[0]), sigmoidf_(xv[1])); w.y = pk2(sigmoidf_(xv[2]), sigmoidf_(xv[3])); w.z = pk2(sigmoidf_(xv[4]), sigmoidf_(xv[5])); w.w = pk2(sigmoidf_(xv[6]), sigmoidf_(xv[7]));
            *(u32x4*)(AG + (size_t)(row0 + tok) * 128 + 8 * (tid & 15)) = w;
        }
    }
    __syncthreads();
}
DI void scan_phase(const Params& P, unsigned char* lds) {
    const int G = gridDim.x;
#ifndef SCAN_REP
#define SCAN_REP 1
#endif
#ifdef SCAN_PROBE
    for (int c = blockIdx.x; c < 384; c += G) scan_chain<SCAN_PROBE>(P, c, lds);
#endif
    for (int c = blockIdx.x; c < 384; c += G) scan_chain<0>(P, c, lds);
    if (G > 384) { if ((int)blockIdx.x >= 384) pool_units(P, blockIdx.x - 384, G - 384, lds); }
    else pool_units(P, blockIdx.x, G, lds);
}
DI void zpass_phase(const Params& P) {
    const bf16_t* PL = (const bf16_t*)(P.ws + OFF_PL1); const bf16_t* YF = (const bf16_t*)(P.ws + OFF_YF); const bf16_t* YB = (const bf16_t*)(P.ws + OFF_YB);
    const float* BON = (const float*)(P.ws + OFF_BONUS); bf16_t* Y = (bf16_t*)(P.ws + OFF_H);
    const int tid = otid(), hw = tid >> 5, i = tid & 31;
    const int stride = gridDim.x * 8;
    for (int task0 = blockIdx.x * 8 + hw; task0 < NLAT * 12; task0 += 4 * stride) {
        unsigned ya[4], yb[4]; float bon[4]; unsigned short vr[4][6];
#pragma unroll
        for (int u = 0; u < 4; ++u) {
            const int task = task0 + u * stride; const bool ok = task < NLAT * 12;
            const int row = ok ? task / 12 : 0, h = ok ? task - row * 12 : 0, t = row & 8191, c = 64 * h + 2 * i;
            ya[u] = *(const unsigned*)(YF + (size_t)row * 768 + c); yb[u] = *(const unsigned*)(YB + (size_t)row * 768 + c);
            bon[u] = BON[(size_t)row * 12 + h] + BON[(size_t)NLAT * 12 + (size_t)row * 12 + h];
            const bf16_t* pv = PL + (size_t)row * CDIN + 1536 + c;
            const unsigned cur = *(const unsigned*)pv, prv = t > 0 ? *(const unsigned*)(pv - CDIN) : 0u, nxt = t + 1 < SEQ ? *(const unsigned*)(pv + CDIN) : 0u;
            vr[u][0] = (unsigned short)(cur & 0xffff); vr[u][1] = (unsigned short)(cur >> 16); vr[u][2] = (unsigned short)(prv & 0xffff); vr[u][3] = (unsigned short)(prv >> 16);
            vr[u][4] = (unsigned short)(nxt & 0xffff); vr[u][5] = (unsigned short)(nxt >> 16);
        }
#pragma unroll
        for (int u = 0; u < 4; ++u) {
            const int task = task0 + u * stride; const bool ok = task < NLAT * 12;
            const int row = ok ? task / 12 : 0, h = ok ? task - row * 12 : 0, c = 64 * h + 2 * i;
            const float y0 = lo16(ya[u]) + lo16(yb[u]), y1 = hi16(ya[u]) + hi16(yb[u]);
            float sm = y0 + y1;
#pragma unroll
            for (int o = 16; o > 0; o >>= 1) sm += __shfl_xor(sm, o);
            const float mean = sm * (1.0f / 64.0f); const float d0 = y0 - mean, d1 = y1 - mean;
            float vs = d0 * d0 + d1 * d1;
#pragma unroll
            for (int o = 16; o > 0; o >>= 1) vs += __shfl_xor(vs, o);
            const float rs = rsqrtf(vs * (1.0f / 64.0f) + LNX_EPS);
            const float x0 = bf2f(vr[u][0]), x1 = bf2f(vr[u][1]);
            const float v0 = x0 + (0.5f * (bf2f(vr[u][2]) + bf2f(vr[u][4])) - x0) * P.cd_mu[1536 + c], v1 = x1 + (0.5f * (bf2f(vr[u][3]) + bf2f(vr[u][5])) - x1) * P.cd_mu[1536 + c + 1];
            const float z0 = d0 * rs * P.cd_lnx_w[c] + P.cd_lnx_b[c] + bon[u] * v0, z1 = d1 * rs * P.cd_lnx_w[c + 1] + P.cd_lnx_b[c + 1] + bon[u] * v1;
            if (ok) *(unsigned*)(Y + (size_t)row * DM + c) = pk2(z0, z1);
        }
    }
}


constexpr size_t OFF_BAR = OFF_ROPE + 512 * 1024;
#define XB_TMO      128
#define XB_XCNT(j)  (256  + 64 * (j))
#define XB_XSUB(j)  (1280 + 64 * (j))
#define XB_XGEN(j)  (2304 + 64 * (j))
#define XB_TOP      3328
#define XB_TOPGEN   3392
#define XCD_BAR_WORDS 3456
#define XB_SPIN_CAP (1u << 22)
DI unsigned xb_ld(unsigned* p)              { return __hip_atomic_load(p, __ATOMIC_RELAXED, __HIP_MEMORY_SCOPE_AGENT); }
DI unsigned xb_add(unsigned* p, unsigned v) { return __hip_atomic_fetch_add(p, v, __ATOMIC_RELAXED, __HIP_MEMORY_SCOPE_AGENT); }
DI unsigned xb_xcc_id() { return (unsigned)__builtin_amdgcn_s_getreg((3 << 11) | 20) & 0xFu; }
#define XB_SPIN(cond, bar) do { unsigned _sp = 0; while (cond) { __builtin_amdgcn_s_sleep(1); \
    if ((++_sp & 255u) == 0u) { if (xb_ld(&(bar)[XB_TMO])) break; if (_sp > XB_SPIN_CAP) { atomicAdd(&(bar)[XB_TMO], 1u); break; } } } } while (0)
struct XcdBar { unsigned* bar; unsigned x, nloc, nx; };
DI void xcd_barrier(const XcdBar& b) {
    asm volatile("s_waitcnt vmcnt(0)" ::: "memory");
    __syncthreads();
    if (threadIdx.x == 0) {
        unsigned* bar = b.bar;
        __builtin_amdgcn_s_waitcnt(0);
        const unsigned nloc = b.nloc, nx = b.nx;
        const unsigned old = xb_add(&bar[XB_XSUB(b.x)], 1u);
        const unsigned gen = old / nloc;
        if (old + 1u == (gen + 1u) * nloc) {
            __builtin_amdgcn_fence(__ATOMIC_RELEASE, "agent");
            asm volatile("s_waitcnt vmcnt(0)" ::: "memory");
            const unsigned og = xb_add(&bar[XB_TOP], 1u);
            const unsigned tg = og / nx;
            if (og + 1u == (tg + 1u) * nx) xb_add(&bar[XB_TOPGEN], 1u);
            else XB_SPIN(xb_ld(&bar[XB_TOPGEN]) == tg, bar);
            __builtin_amdgcn_fence(__ATOMIC_ACQUIRE, "agent");
            xb_add(&bar[XB_XGEN(b.x)], 1u);
            asm volatile("s_waitcnt vmcnt(0)" ::: "memory");
        } else {
            XB_SPIN(xb_ld(&bar[XB_XGEN(b.x)]) == gen, bar);
            __builtin_amdgcn_fence(__ATOMIC_ACQUIRE, "agent");
            asm volatile("s_waitcnt vmcnt(0)" ::: "memory");
        }
    }
    __syncthreads();
}

#ifndef PHASE_MASK
#define PHASE_MASK 0xffff
#endif
#ifndef PHASE_LIMIT
#define PHASE_LIMIT 100
#endif
#ifndef REP_IDX
#define REP_IDX -1
#endif
#ifndef REP_N
#define REP_N 2
#endif
#define PH(n, idx) if ((((PHASE_MASK) >> (n)) & 1) && ((idx) < (PHASE_LIMIT) || (n) == 8))
__global__ void __launch_bounds__(256, 2) fwd_megakernel(Params P) {
    __shared__ __attribute__((aligned(16))) unsigned char lds[65536];
    cg::grid_group grid = cg::this_grid();
    XcdBar xb; xb.bar = (unsigned*)(P.ws + OFF_BAR); xb.x = xb_xcc_id();
    if (threadIdx.x == 0) (void)xb_add(&xb.bar[XB_XCNT(xb.x)], 1u);
    unsigned char* ws = P.ws;
    const float* MOD = (const float*)(ws + OFF_MOD);
    bf16_t* H = (bf16_t*)(ws + OFF_H);
    float* XLC = (float*)(ws + OFF_XLC);
    PH(0, 0) prep_phase(P, lds);
    grid.sync();
    {
        unsigned mine = 0u, cnt = 0u;
#pragma unroll
        for (unsigned j = 0; j < 16; ++j) { const unsigned c = xb_ld(&xb.bar[XB_XCNT(j)]); cnt += (c > 0u) ? 1u : 0u; mine = (j == xb.x) ? c : mine; }
        xb.nloc = __builtin_amdgcn_readfirstlane(mine > 0u ? mine : 1u); xb.nx = __builtin_amdgcn_readfirstlane(cnt > 0u ? cnt : 1u);
    }
    PH(1, 1) modfinal_phase(P);
    xcd_barrier(xb);
    PH(2, 2) rownorm_phase(P.x, P.ctx, NTOK, P.norm_gain, MOD, 0, 1, H);
    xcd_barrier(xb);
    PH(3, 3) gemm256_phase((const bf16_t*)H, DM, (const bf16_t*)(ws + OFF_WAB_IN), DM, NTOK, 1536, DM, EpiInprojL0{(bf16_t*)(ws + OFF_PL0), P.ab_q_gain, (const float*)(ws + OFF_ROPE), (const float*)(ws + OFF_ROPE) + 2048}, lds);
    xcd_barrier(xb);
    PH(4, 4) qkprep_phase(P);
    xcd_barrier(xb);
    PH(5, 5) attn_phase(P, lds);
#if REP_IDX == 5
    { xcd_barrier(xb); attn_phase(P, lds); }
#endif
    xcd_barrier(xb);
    PH(3, 6) gemm256_phase((const bf16_t*)H, DM, (const bf16_t*)(ws + OFF_WAB_OUT), DM, NTOK, DM, DM, EpiResidual{P.x, P.ctx, P.out, XLC, MOD, 2}, lds);
    xcd_barrier(xb);
    PH(2, 7) rownorm_phase(P.out, XLC, NTOK, P.norm_gain + 1024, MOD, 3, 4, H);
    xcd_barrier(xb);
    PH(3, 8) gemm256_phase((const bf16_t*)H, DM, (const bf16_t*)(ws + OFF_WFFN_IN), DM, NTOK, 5632, DM, EpiSwiglu{(bf16_t*)(ws + OFF_HID)}, lds);
#if REP_IDX == 8
    { xcd_barrier(xb); gemm256_phase((const bf16_t*)H, DM, (const bf16_t*)(ws + OFF_WFFN_IN), DM, NTOK, 5632, DM, EpiSwiglu{(bf16_t*)(ws + OFF_HID)}, lds); }
#endif
    xcd_barrier(xb);
    PH(3, 9) gemm256_phase((const bf16_t*)(ws + OFF_HID), FFH, (const bf16_t*)(ws + OFF_WFFN_OUT), FFH, NTOK, DM, FFH, EpiResidual{P.out, XLC, P.out, XLC, MOD, 5}, lds);
    xcd_barrier(xb);
    const float* MOD1 = MOD + 9 * 6144;
    PH(2, 10) rownorm_phase(P.out, XLC, NTOK, P.norm_gain + 2048, MOD1, 0, 1, H);
    xcd_barrier(xb);
    PH(3, 11) gemm256_phase((const bf16_t*)H, DM, (const bf16_t*)(ws + OFF_WCD_IN), DM, NTOK, 3072, DM, EpiStoreBf16{(bf16_t*)(ws + OFF_PL1), CDIN}, lds);
    xcd_barrier(xb);
    PH(6, 12) scan_phase(P, lds);
#if REP_IDX == 12
    { xcd_barrier(xb); scan_phase(P, lds); }
#endif
    xcd_barrier(xb);
    PH(7, 13) zpass_phase(P);
    xcd_barrier(xb);
    PH(3, 14) gemm256_phase((const bf16_t*)(ws + OFF_AG), 128, (const bf16_t*)(ws + OFF_WG2), 128, NLAT, 768, 128, EpiGateMul{H}, lds);
    xcd_barrier(xb);
    PH(3, 15) gemm256_phase((const bf16_t*)H, DM, (const bf16_t*)(ws + OFF_WCD_OUT), DM, NLAT, DM, DM, EpiResidual{P.out, XLC, P.out, XLC, MOD1, 2}, lds);
    xcd_barrier(xb);
    PH(2, 16) rownorm_phase(P.out, XLC, NLAT, P.norm_gain + 3072, MOD1, 3, 4, H);
    xcd_barrier(xb);
    PH(3, 17) gemm256_phase((const bf16_t*)H, DM, (const bf16_t*)(ws + OFF_WFFN_IN + WFFN_IN_SZ), DM, NLAT, 5632, DM, EpiSwiglu{(bf16_t*)(ws + OFF_HID)}, lds);
    xcd_barrier(xb);
    PH(3, 18) gemm256_phase((const bf16_t*)(ws + OFF_HID), FFH, (const bf16_t*)(ws + OFF_WFFN_OUT + WFFN_OUT_SZ), FFH, NLAT, DM, FFH, EpiResidual{P.out, XLC, P.out, XLC, MOD1, 5}, lds);
    xcd_barrier(xb);
    PH(8, 19) finalnorm_phase(P);
}

extern "C" void kernel_launch(void* const* d_in, const int* in_sizes, int n_in, void* d_out, int out_size, void* d_ws, size_t ws_size, hipStream_t stream) {
    static int grid_blocks = 0;
    if (!grid_blocks) {
        int dev = 0, cus = 0, per_cu = 0;
        hipGetDevice(&dev);
        hipDeviceGetAttribute(&cus, hipDeviceAttributeMultiprocessorCount, dev);
        hipOccupancyMaxActiveBlocksPerMultiprocessor(&per_cu, (const void*)fwd_megakernel, 256, 0);
        if (per_cu < 1) per_cu = 1;
        if (per_cu > 2) per_cu = 2;
        grid_blocks = cus * per_cu;
    }
    Params p{};
    const float** pp = (const float**)&p;
    for (int i = 0; i < 30; ++i) pp[i] = (const float*)d_in[i];
    p.out = (float*)d_out; p.ws = (unsigned char*)d_ws;
    (void)hipMemsetAsync((unsigned char*)d_ws + OFF_BAR, 0, XCD_BAR_WORDS * 4, stream);
    void* args[] = {&p};
    hipError_t e = hipLaunchCooperativeKernel((const void*)fwd_megakernel, dim3(grid_blocks), dim3(256), args, 0, stream);
    if (e != hipSuccess) fprintf(stderr, "cooperative launch failed: %s (grid %d)\n", hipGetErrorString(e), grid_blocks);
}
```

```cpp
#include <hip/hip_runtime.h>
#include <hip/hip_cooperative_groups.h>
#include <cstdio>
#include <cstdint>
namespace cg = cooperative_groups;

typedef unsigned short bf16_t;
typedef short bf16x8 __attribute__((ext_vector_type(8)));
typedef float f32x4 __attribute__((ext_vector_type(4)));
typedef float f32x16 __attribute__((ext_vector_type(16)));
typedef float f32x2 __attribute__((ext_vector_type(2)));
typedef unsigned u32x4 __attribute__((ext_vector_type(4)));
typedef unsigned u32x2 __attribute__((ext_vector_type(2)));
#define DI __device__ __forceinline__

constexpr int NLAT = 65536, NCTX = 2048, NTOK = NLAT + NCTX, DM = 1024, SEQ = 8192, CTXL = 256;
constexpr int FFH = 2816, CDIN = 2944, KVLEN = SEQ + CTXL;
constexpr float EPS = 1e-6f, LNX_EPS = 64e-5f;
constexpr float QSCALE = 0.125f * 1.4426950408889634f, LOG2E = 1.4426950408889634f;

constexpr size_t MB = 1u << 20;
constexpr size_t OFF_WAB_IN = 0, OFF_WAB_OUT = 3 * MB, OFF_WCD_IN = 5 * MB, OFF_WCD_OUT = 11 * MB, OFF_WFFN_IN = 13 * MB, OFF_WFFN_OUT = 35 * MB,
                 OFF_WG2 = 46 * MB, OFF_MOD = 47 * MB, OFF_MODP = 48 * MB, OFF_ROPE = 52 * MB, OFF_XLC = 53 * MB, OFF_H = 61 * MB, OFF_BIG = 193 * MB;
constexpr size_t OFF_PL0 = OFF_BIG, OFF_KB = OFF_BIG + 198 * MB, OFF_VT = OFF_BIG + 231 * MB;
constexpr size_t OFF_HID = OFF_BIG;
constexpr size_t OFF_PL1 = OFF_BIG, OFF_YF = OFF_BIG + 380 * MB, OFF_YB = OFF_BIG + 476 * MB, OFF_AG = OFF_BIG + 572 * MB, OFF_BONUS = OFF_BIG + 588 * MB;
constexpr size_t WFFN_IN_SZ = 11 * MB, WFFN_OUT_SZ = (size_t)1024 * 2816 * 2;

struct Params {
    const float *x, *c, *ctx, *c_ctx, *norm_gain, *ada_w, *ada_b, *ffn_w_in, *ffn_w_out, *final_gain, *ab_w_in, *ab_q_gain, *ab_k_gain, *ab_sink, *ab_w_out,
        *cd_w_in, *cd_mu, *cd_w0, *cd_w2, *cd_a0, *cd_a2, *cd_g2, *cd_k_k, *cd_k_a, *cd_r_k, *cd_lnx_w, *cd_lnx_b, *cd_pool_w, *cd_pool_scale, *cd_w_out;
    float* out; unsigned char* ws;
};

DI float bf2f(bf16_t b) { return __uint_as_float(((unsigned)b) << 16); }
typedef __bf16 bf16x2v __attribute__((ext_vector_type(2)));
DI unsigned pk2(float lo, float hi) { const f32x2 v = {lo, hi}; return __builtin_bit_cast(unsigned, __builtin_convertvector(v, bf16x2v)); }
DI bf16_t f2bf(float f) { return __builtin_bit_cast(bf16_t, (__bf16)f); }
DI float lo16(unsigned u) { return __uint_as_float(u << 16); }
DI float hi16(unsigned u) { return __uint_as_float(u & 0xffff0000u); }
DI float sigmoidf_(float x) { return __builtin_amdgcn_rcpf(1.0f + __builtin_amdgcn_exp2f(-1.4426950408889634f * x)); }
DI float quad_sum(float x) {
    x += __int_as_float(__builtin_amdgcn_mov_dpp(__float_as_int(x), 0xB1, 0xf, 0xf, true));
    x += __int_as_float(__builtin_amdgcn_mov_dpp(__float_as_int(x), 0x4E, 0xf, 0xf, true));
    return x;
}
DI float oct_sum(float x) { x = quad_sum(x); x += __int_as_float(__builtin_amdgcn_mov_dpp(__float_as_int(x), 0x141, 0xf, 0xf, true)); return x; }
DI int otid() { int t = threadIdx.x; asm volatile("" : "+v"(t)); return t; }
DI unsigned swz(int row, int chunk) { return (unsigned)row * 128u + (unsigned)((chunk ^ ((row >> 1) & 7)) << 4); }
#define MFMA32(a, b, c) __builtin_amdgcn_mfma_f32_32x32x16_bf16((a), (b), (c), 0, 0, 0)
#define MFMA16(a, b, c) __builtin_amdgcn_mfma_f32_16x16x32_bf16((a), (b), (c), 0, 0, 0)
DI int crow(int r, int hi) { return (r & 3) + 8 * (r >> 2) + 4 * hi; }

template <class Epi>
DI void gemm_phase(const bf16_t* __restrict__ A, int lda, const bf16_t* __restrict__ Bt, int ldb, int M, int N, int K, const Epi& epi, unsigned char* lds) {
    const int tid = otid(), lane = tid & 63, wave = tid >> 6, wm = wave >> 1, wn = wave & 1;
    const int nNt = N / 128, nk = K / 64;
    const int lr = tid >> 3, lc = tid & 7, l31 = lane & 31, lh = lane >> 5;
    const int G8 = gridDim.x >> 3, xcd = blockIdx.x & 7, lb = blockIdx.x >> 3, mper = (M / 128) >> 3, per = mper * nNt;
    for (int lt = lb; lt < per; lt += G8) {
        const int grp = lt / (8 * nNt), q = lt - grp * 8 * nNt, gs = (mper - grp * 8) < 8 ? (mper - grp * 8) : 8;
        const int tn = q / gs, tm = xcd * mper + grp * 8 + (q - tn * gs);
        const bf16_t* Ag = A + (size_t)(tm * 128 + lr) * lda + lc * 8;
        const bf16_t* Bg = Bt + (size_t)(tn * 128 + lr) * ldb + lc * 8;
        f32x16 acc[2][2];
#pragma unroll
        for (int i = 0; i < 2; ++i)
#pragma unroll
            for (int j = 0; j < 2; ++j)
#pragma unroll
                for (int r = 0; r < 16; ++r) acc[i][j][r] = 0.f;
        u32x4 ra0[4], rb0[4], ra1[4], rb1[4];
#define G_LOAD(RA, RB, KT) { _Pragma("unroll") for (int i = 0; i < 4; ++i) { RA[i] = *(const u32x4*)(Ag + (size_t)(32 * i) * lda + (KT) * 64); RB[i] = *(const u32x4*)(Bg + (size_t)(32 * i) * ldb + (KT) * 64); } }
#define G_STORE(RA, RB, BUF) { _Pragma("unroll") for (int i = 0; i < 4; ++i) { *(u32x4*)((BUF) + swz(lr + 32 * i, lc)) = RA[i]; *(u32x4*)((BUF) + 16384 + swz(lr + 32 * i, lc)) = RB[i]; } }
#define G_COMPUTE(BUF) { _Pragma("unroll") for (int ks = 0; ks < 4; ++ks) { bf16x8 af[2], bfr[2]; \
            _Pragma("unroll") for (int i = 0; i < 2; ++i) { af[i] = *(const bf16x8*)((BUF) + swz(wm * 64 + i * 32 + l31, 2 * ks + lh)); bfr[i] = *(const bf16x8*)((BUF) + 16384 + swz(wn * 64 + i * 32 + l31, 2 * ks + lh)); } \
            _Pragma("unroll") for (int i = 0; i < 2; ++i) _Pragma("unroll") for (int j = 0; j < 2; ++j) acc[i][j] = MFMA32(af[i], bfr[j], acc[i][j]); } }
        G_LOAD(ra0, rb0, 0)
        if (nk > 1) G_LOAD(ra1, rb1, 1)
        G_STORE(ra0, rb0, lds)
        __syncthreads();
        for (int kt = 0; kt < nk; kt += 2) {
            if (kt + 2 < nk) G_LOAD(ra0, rb0, kt + 2)
            G_COMPUTE(lds)
            if (kt + 1 < nk) G_STORE(ra1, rb1, lds + 32768)
            __syncthreads();
            if (kt + 1 < nk) {
                if (kt + 3 < nk) G_LOAD(ra1, rb1, kt + 3)
                G_COMPUTE(lds + 32768)
                if (kt + 2 < nk) G_STORE(ra0, rb0, lds)
                __syncthreads();
            }
        }
#undef G_LOAD
#undef G_STORE
#undef G_COMPUTE
        int lane_e = lane; asm volatile("" : "+v"(lane_e));
        epi.template operator()<2>(acc, tm * 128 + wm * 64, tn * 128 + wn * 64, lane_e);
    }
}

template <class Epi>
DI void gemm256_phase(const bf16_t* __restrict__ A, int lda, const bf16_t* __restrict__ Bt, int ldb, int M, int N, int K, const Epi& epi, unsigned char* lds) {
    const int tid = otid(), lane = tid & 63, wave = tid >> 6, wm = wave >> 1, wn = wave & 1;
    const int nNt = N / 256, nk = K / 64;
    const int lr = tid >> 3, lc = tid & 7, l31 = lane & 31, lh = lane >> 5;
    const int G8 = gridDim.x >> 3, xcd = blockIdx.x & 7, lb = blockIdx.x >> 3, mper = (M / 128) >> 3, per = mper * nNt;
    const unsigned c0 = (unsigned)(lh ^ ((l31 >> 1) & 7)), roA = (unsigned)(wm * 8192 + l31 * 128), roB = (unsigned)(16384 + wn * 16384 + l31 * 128);
    for (int lt = lb; lt < per; lt += G8) {
        const int grp = lt / (8 * nNt), q = lt - grp * 8 * nNt, gs = (mper - grp * 8) < 8 ? (mper - grp * 8) : 8;
        const int tn = q / gs, tm = xcd * mper + grp * 8 + (q - tn * gs);
        const bf16_t* Au = A + (size_t)(tm * 128) * lda;
        const bf16_t* Bu = Bt + (size_t)(tn * 256) * ldb;
        const unsigned voA = (unsigned)(lr * lda + lc * 8), voB = (unsigned)(lr * ldb + lc * 8);
        f32x16 acc[2][4];
#pragma unroll
        for (int i = 0; i < 2; ++i)
#pragma unroll
            for (int j = 0; j < 4; ++j)
#pragma unroll
                for (int r = 0; r < 16; ++r) acc[i][j][r] = 0.f;
        u32x4 ra[4], rb[8];
#pragma unroll
        for (int i = 0; i < 4; ++i) ra[i] = *(const u32x4*)((Au + (size_t)(32 * i) * lda) + voA);
#pragma unroll
        for (int i = 0; i < 8; ++i) rb[i] = *(const u32x4*)((Bu + (size_t)(32 * i) * ldb) + voB);
        for (int kt = 0; kt < nk; ++kt) {
#pragma unroll
            for (int i = 0; i < 4; ++i) *(u32x4*)(lds + swz(lr + 32 * i, lc)) = ra[i];
#pragma unroll
            for (int i = 0; i < 8; ++i) *(u32x4*)(lds + 16384 + swz(lr + 32 * i, lc)) = rb[i];
            __syncthreads();
            if (kt + 1 < nk) {
#pragma unroll
                for (int i = 0; i < 4; ++i) ra[i] = *(const u32x4*)((Au + (size_t)(32 * i) * lda + (kt + 1) * 64) + voA);
#pragma unroll
                for (int i = 0; i < 8; ++i) rb[i] = *(const u32x4*)((Bu + (size_t)(32 * i) * ldb + (kt + 1) * 64) + voB);
            }
            __builtin_amdgcn_s_setprio(1);
#pragma unroll 2
            for (int ks = 0; ks < 4; ++ks) {
                bf16x8 af[2], bfr[4];
                const unsigned xo = (c0 ^ (unsigned)(2 * ks)) << 4;
#pragma unroll
                for (int i = 0; i < 2; ++i) af[i] = *(const bf16x8*)(lds + (roA + xo) + i * 4096);
#pragma unroll
                for (int j = 0; j < 4; ++j) bfr[j] = *(const bf16x8*)(lds + (roB + xo) + j * 4096);
#pragma unroll
                for (int i = 0; i < 2; ++i)
#pragma unroll
                    for (int j = 0; j < 4; ++j) acc[i][j] = MFMA32(af[i], bfr[j], acc[i][j]);
            }
            __builtin_amdgcn_s_setprio(0);
            __syncthreads();
        }
        int lane_e = lane; asm volatile("" : "+v"(lane_e));
        epi.template operator()<4>(acc, tm * 128 + wm * 64, tn * 256 + wn * 128, lane_e);
    }
}

DI int cu(int r) { return (r & 3) + 8 * (r >> 2); }
struct EpiStoreBf16 {
    bf16_t* C; int ldc;
    template <int NI> DI void operator()(const f32x16 (&acc)[2][NI], int row0, int col0, int lane) const {
        if (col0 >= ldc) return;
        const unsigned lo = (unsigned)(4 * (lane >> 5) * ldc + (lane & 31));
        bf16_t* base = C + (size_t)row0 * ldc + col0;
#pragma unroll
        for (int mi = 0; mi < 2; ++mi)
#pragma unroll
            for (int ni = 0; ni < NI; ++ni)
#pragma unroll
                for (int r = 0; r < 16; ++r) (base + (size_t)(32 * mi + cu(r)) * ldc + 32 * ni)[lo] = f2bf(acc[mi][ni][r]);
    }
};
struct EpiResidual {
    const float* srcL; const float* srcC; float* dstL; float* dstC; const float* mod; int gate_idx;
    template <int NI> DI void operator()(const f32x16 (&acc)[2][NI], int row0, int col0, int lane) const {
        const bool lat = row0 < NLAT;
        const float* src = (lat ? srcL + (size_t)row0 * DM : srcC + (size_t)(row0 - NLAT) * DM) + col0;
        float* dst = (lat ? dstL + (size_t)row0 * DM : dstC + (size_t)(row0 - NLAT) * DM) + col0;
        const float* g = mod + ((lat ? (row0 >> 13) : 8) * 6 + gate_idx) * 1024 + col0;
        const unsigned l31 = lane & 31, lo = (unsigned)(4 * (lane >> 5) * DM) + l31;
#pragma unroll
        for (int ni = 0; ni < NI; ++ni) {
            const float gv = (g + 32 * ni)[l31];
            float sv[32];
#pragma unroll
            for (int q = 0; q < 32; ++q) sv[q] = (src + (32 * (q >> 4) + cu(q & 15)) * DM + 32 * ni)[lo];
#pragma unroll
            for (int q = 0; q < 32; ++q) (dst + (32 * (q >> 4) + cu(q & 15)) * DM + 32 * ni)[lo] = sv[q] + gv * acc[q >> 4][ni][q & 15];
            asm volatile("" ::: "memory");
        }
    }
};
struct EpiInprojL0 {
    bf16_t* C; const float* qgain; const float* ct; const float* st; const float* kgain; bf16_t* KB; bf16_t* VT;
    template <int NI> DI void operator()(const f32x16 (&acc)[2][NI], int row0, int col0, int lane) const {
        const int l31 = lane & 31, lh = lane >> 5;
        const unsigned lo = (unsigned)(4 * lh * 1536 + l31);
        bf16_t* base = C + (size_t)row0 * 1536 + col0;
        const bool lat = row0 < NLAT;
        const int tlane = (row0 & 8191) + 4 * lh;
        if (col0 >= 1024) {
            const int j = (col0 - 1024) >> 7;
            const int bb = lat ? (row0 >> 13) : ((row0 - NLAT) >> 8), pos0 = lat ? (row0 & 8191) : SEQ + ((row0 - NLAT) & 255);
            if (j & 1) {
#pragma unroll
                for (int hp = 0; hp < NI / 2; ++hp) {
                    bf16_t* vb = VT + ((size_t)(bb * 4 + 2 * (j >> 1) + hp) * 64) * KVLEN + pos0;
                    const unsigned vlo = (unsigned)(l31 * KVLEN + 8 * lh);
#pragma unroll
                    for (int mi = 0; mi < 2; ++mi)
#pragma unroll
                        for (int g = 0; g < 4; ++g) {
                            bf16_t* p = vb + 16 * (2 * mi + (g >> 1)) + 4 * (g & 1);
                            u32x2 w1, w2;
                            w1.x = pk2(acc[mi][2 * hp][4 * g], acc[mi][2 * hp][4 * g + 1]); w1.y = pk2(acc[mi][2 * hp][4 * g + 2], acc[mi][2 * hp][4 * g + 3]);
                            w2.x = pk2(acc[mi][2 * hp + 1][4 * g], acc[mi][2 * hp + 1][4 * g + 1]); w2.y = pk2(acc[mi][2 * hp + 1][4 * g + 2], acc[mi][2 * hp + 1][4 * g + 3]);
                            *(u32x2*)(p + vlo) = w1; *(u32x2*)(p + (size_t)32 * KVLEN + vlo) = w2;
                        }
                }
                return;
            }
            const bool isBk = j == 2;
            const float kg1 = kgain[l31], kg2 = kgain[l31 + 32];
            const unsigned klo = (unsigned)(4 * lh * 64 + l31);
#pragma unroll
            for (int mi = 0; mi < 2; ++mi)
#pragma unroll
                for (int r = 0; r < 16; ++r) {
                    float c = 1.f, sn = 0.f;
                    if (lat) { const int t = tlane + 32 * mi + cu(r); const int pos = l31 < 16 ? (t >> 6) : (t & 63); c = ct[pos * 16 + (l31 & 15)]; sn = st[pos * 16 + (l31 & 15)]; }
#pragma unroll
                    for (int hp = 0; hp < NI / 2; ++hp) {
                        float x1 = acc[mi][2 * hp][r], x2 = acc[mi][2 * hp + 1][r];
                        if (isBk) {
                            float ss = x1 * x1 + x2 * x2;
#pragma unroll
                            for (int o = 16; o > 0; o >>= 1) ss += __shfl_xor(ss, o);
                            const float rs = rsqrtf(ss * (1.0f / 64.0f) + EPS);
                            x1 = x1 * rs * kg1; x2 = x2 * rs * kg2;
                        }
                        const float o1 = x1 * c - x2 * sn, o2 = x2 * c + x1 * sn;
                        bf16_t* p = KB + ((size_t)(bb * 4 + 2 * (j >> 1) + hp) * KVLEN + pos0 + 32 * mi + cu(r)) * 64;
                        p[klo] = f2bf(o1); (p + 32)[klo] = f2bf(o2);
                    }
                }
            return;
        }
        const bool isB = col0 >= 512;
        const float g1 = qgain[l31], g2 = qgain[l31 + 32];
#pragma unroll
        for (int mi = 0; mi < 2; ++mi)
#pragma unroll
            for (int r = 0; r < 16; ++r) {
                float c = 1.f, sn = 0.f;
                if (lat) { const int t = tlane + 32 * mi + cu(r); const int pos = l31 < 16 ? (t >> 6) : (t & 63); c = ct[pos * 16 + (l31 & 15)]; sn = st[pos * 16 + (l31 & 15)]; }
#pragma unroll
                for (int hp = 0; hp < NI / 2; ++hp) {
                    float x1 = acc[mi][2 * hp][r], x2 = acc[mi][2 * hp + 1][r];
                    if (isB) {
                        float ss = x1 * x1 + x2 * x2;
#pragma unroll
                        for (int o = 16; o > 0; o >>= 1) ss += __shfl_xor(ss, o);
                        const float rs = rsqrtf(ss * (1.0f / 64.0f) + EPS);
                        x1 = x1 * rs * g1; x2 = x2 * rs * g2;
                    }
                    const float o1 = x1 * c - x2 * sn, o2 = x2 * c + x1 * sn;
                    bf16_t* p = base + (size_t)(32 * mi + cu(r)) * 1536 + 64 * hp;
                    p[lo] = f2bf(o1 * QSCALE); (p + 32)[lo] = f2bf(o2 * QSCALE);
                }
            }
    }
};
struct EpiSwiglu {
    bf16_t* Hd;
    template <int NI> DI void operator()(const f32x16 (&acc)[2][NI], int row0, int col0, int lane) const {
        const unsigned lo = (unsigned)(4 * (lane >> 5) * FFH + (lane & 31));
        bf16_t* base = Hd + (size_t)row0 * FFH + (col0 >> 1);
#pragma unroll
        for (int pr = 0; pr < NI / 2; ++pr)
#pragma unroll
            for (int mi = 0; mi < 2; ++mi)
#pragma unroll
                for (int r = 0; r < 16; ++r) { const float g = acc[mi][2 * pr][r], u = acc[mi][2 * pr + 1][r]; (base + (32 * mi + cu(r)) * FFH + 32 * pr)[lo] = f2bf(g * sigmoidf_(g) * u); }
    }
};
struct EpiGateMul {
    bf16_t* Y;
    template <int NI> DI void operator()(const f32x16 (&acc)[2][NI], int row0, int col0, int lane) const {
        const unsigned lo = (unsigned)(4 * (lane >> 5) * DM + (lane & 31));
        bf16_t* base = Y + (size_t)row0 * DM + col0;
#pragma unroll
        for (int mi = 0; mi < 2; ++mi)
#pragma unroll
            for (int ni = 0; ni < NI; ++ni)
#pragma unroll
                for (int r = 0; r < 16; ++r) { bf16_t* p = base + (32 * mi + cu(r)) * DM + 32 * ni; p[lo] = f2bf(bf2f(p[lo]) * acc[mi][ni][r]); }
    }
};

DI void transpose_tile(const float* __restrict__ W, int ldw, int K, bf16_t* __restrict__ Wt, int k0, int n0, int ffn_map, float* t  ) {
    const int tid = otid();
    {
        const int n = tid & 63; int src = n0 + n;
        if (ffn_map) { const int np = n0 + n; const int j32 = np >> 6, s = (np >> 5) & 1, i = np & 31; src = s * FFH + j32 * 32 + i; }
#pragma unroll
        for (int i = 0; i < 16; ++i) { const int k = i * 4 + (tid >> 6); t[k * 65 + n] = W[(size_t)(k0 + k) * ldw + src]; }
    }
    __syncthreads();
#pragma unroll
    for (int i = 0; i < 2; ++i) {
        const int n = (tid >> 3) + 32 * i, kc = tid & 7;
        u32x4 v;
        v.x = pk2(t[(kc * 8 + 0) * 65 + n], t[(kc * 8 + 1) * 65 + n]); v.y = pk2(t[(kc * 8 + 2) * 65 + n], t[(kc * 8 + 3) * 65 + n]);
        v.z = pk2(t[(kc * 8 + 4) * 65 + n], t[(kc * 8 + 5) * 65 + n]); v.w = pk2(t[(kc * 8 + 6) * 65 + n], t[(kc * 8 + 7) * 65 + n]);
        *(u32x4*)(Wt + (size_t)(n0 + n) * K + k0 + kc * 8) = v;
    }
    __syncthreads();
}
DI void prep_phase(const Params& P, unsigned char* lds) {
    float* t = (float*)lds;
    unsigned char* ws = P.ws;
    for (int j = blockIdx.x; j < 5880; j += gridDim.x) {
        const float* W; int ldw, K, Nout, map = 0, jj = j; bf16_t* Wt;
        if (jj < 384) { W = P.ab_w_in; ldw = 1536; K = 1024; Nout = 1536; Wt = (bf16_t*)(ws + OFF_WAB_IN); }
        else if ((jj -= 384) < 256) { W = P.ab_w_out; ldw = 1024; K = 1024; Nout = 1024; Wt = (bf16_t*)(ws + OFF_WAB_OUT); }
        else if ((jj -= 256) < 736) { W = P.cd_w_in; ldw = CDIN; K = 1024; Nout = CDIN; Wt = (bf16_t*)(ws + OFF_WCD_IN); }
        else if ((jj -= 736) < 256) { W = P.cd_w_out; ldw = 1024; K = 1024; Nout = 1024; Wt = (bf16_t*)(ws + OFF_WCD_OUT); }
        else if ((jj -= 256) < 2816) { const int l = jj / 1408; jj -= l * 1408; W = P.ffn_w_in + (size_t)l * 1024 * 5632; ldw = 5632; K = 1024; Nout = 5632; map = 1; Wt = (bf16_t*)(ws + OFF_WFFN_IN + l * WFFN_IN_SZ); }
        else if ((jj -= 2816) < 1408) { const int l = jj / 704; jj -= l * 704; W = P.ffn_w_out + (size_t)l * FFH * 1024; ldw = 1024; K = FFH; Nout = 1024; Wt = (bf16_t*)(ws + OFF_WFFN_OUT + l * WFFN_OUT_SZ); }
        else { jj -= 1408; W = P.cd_g2; ldw = 768; K = 128; Nout = 768; Wt = (bf16_t*)(ws + OFF_WG2); }
        const int nNt = Nout / 64; const int kt = jj / nNt, nt = jj - kt * nNt;
        transpose_tile(W, ldw, K, Wt, kt * 64, nt * 64, map, t);
    }
    float* MODP = (float*)(ws + OFF_MODP);
    for (int j = blockIdx.x; j < 384; j += gridDim.x) {
        const int l = j / 192, r2 = j % 192, ks = r2 / 24, cb = r2 % 24;
        const int tid = otid();
        __syncthreads();
        for (int e = tid; e < 9 * 128; e += 256) { const int r = e >> 7, kk = e & 127; const float v = r < 8 ? P.c[r * 1024 + ks * 128 + kk] : P.c_ctx[ks * 128 + kk]; t[e] = v * sigmoidf_(v); }
        __syncthreads();
        const int col = cb * 256 + tid;
        const float* w = P.ada_w + ((size_t)l * 1024 + ks * 128) * 6144 + col;
        float a[9];
#pragma unroll
        for (int r = 0; r < 9; ++r) a[r] = 0.f;
#pragma unroll 4
        for (int kk = 0; kk < 128; ++kk) { const float wv = w[(size_t)kk * 6144];
#pragma unroll
            for (int r = 0; r < 9; ++r) a[r] += t[r * 128 + kk] * wv; }
#pragma unroll
        for (int r = 0; r < 9; ++r) MODP[((size_t)(ks * 2 + l) * 9 + r) * 6144 + col] = a[r];
    }
    if (blockIdx.x == 0) {
        float* ct = (float*)(ws + OFF_ROPE); float* st = ct + 2048;
        for (int e = otid(); e < 2048; e += 256) {
            const int pos = e >> 4, j = e & 15;
            const float inv = exp2f(-(float)j * (13.287712379549449f / 16.0f));
            const float ang = (float)pos * inv;
            double rev = (double)ang * 0.15915494309189535; rev -= floor(rev);
            const float rv = (float)rev;
            ct[e] = __builtin_amdgcn_cosf(rv); st[e] = __builtin_amdgcn_sinf(rv);
        }
    }
}
DI void modfinal_phase(const Params& P) {
    const float* MODP = (const float*)(P.ws + OFF_MODP); float* MOD = (float*)(P.ws + OFF_MOD);
    for (int e = blockIdx.x * 256 + otid(); e < 2 * 9 * 6144; e += gridDim.x * 256) {
        const int l = e / (9 * 6144), col = e % 6144;
        float s = P.ada_b[l * 6144 + col];
#pragma unroll
        for (int ks = 0; ks < 8; ++ks) s += MODP[(size_t)ks * (2 * 9 * 6144) + e];
        MOD[e] = s;
    }
}

DI void rownorm_phase(const float* srcL, const float* srcC, int M, const float* __restrict__ gain, const float* __restrict__ mod, int shift_idx, int scale_idx, bf16_t* __restrict__ H) {
    const int lane = otid() & 63, wave = otid() >> 6;
    for (int row = blockIdx.x * 4 + wave; row < M; row += gridDim.x * 4) {
        const bool lat = row < NLAT;
        const float* src = lat ? srcL + (size_t)row * DM : srcC + (size_t)(row - NLAT) * DM;
        const float* mrow = mod + (lat ? (row >> 13) : 8) * 6144;
        f32x4 v[4]; float ss = 0.f;
#pragma unroll
        for (int i = 0; i < 4; ++i) { v[i] = *(const f32x4*)(src + (i * 64 + lane) * 4); ss += v[i].x * v[i].x + v[i].y * v[i].y + v[i].z * v[i].z + v[i].w * v[i].w; }
#pragma unroll
        for (int o = 32; o > 0; o >>= 1) ss += __shfl_xor(ss, o);
        const float rs = rsqrtf(ss * (1.0f / 1024.0f) + EPS);
#pragma unroll
        for (int i = 0; i < 4; ++i) {
            const int col = (i * 64 + lane) * 4;
            const f32x4 g = *(const f32x4*)(gain + col), sc = *(const f32x4*)(mrow + scale_idx * 1024 + col), sh = *(const f32x4*)(mrow + shift_idx * 1024 + col);
            const f32x4 y = (v[i] * rs * g) * (sc + 1.0f) + sh;
            u32x2 o; o.x = pk2(y.x, y.y); o.y = pk2(y.z, y.w);
            *(u32x2*)(H + (size_t)row * DM + col) = o;
        }
    }
}
DI void finalnorm_phase(const Params& P) {
    const int lane = otid() & 63, wave = otid() >> 6;
    for (int row = blockIdx.x * 4 + wave; row < NLAT; row += gridDim.x * 4) {
        float* src = P.out + (size_t)row * DM;
        f32x4 v[4]; float ss = 0.f;
#pragma unroll
        for (int i = 0; i < 4; ++i) { v[i] = *(const f32x4*)(src + (i * 64 + lane) * 4); ss += v[i].x * v[i].x + v[i].y * v[i].y + v[i].z * v[i].z + v[i].w * v[i].w; }
#pragma unroll
        for (int o = 32; o > 0; o >>= 1) ss += __shfl_xor(ss, o);
        const float rs = rsqrtf(ss * (1.0f / 1024.0f) + EPS);
#pragma unroll
        for (int i = 0; i < 4; ++i) { const int col = (i * 64 + lane) * 4; *(f32x4*)(src + col) = v[i] * rs * *(const f32x4*)(P.final_gain + col); }
    }
}

DI void qkprep_phase(const Params& P) {
    bf16_t* PL = (bf16_t*)(P.ws + OFF_PL0); bf16_t* KB = (bf16_t*)(P.ws + OFF_KB); bf16_t* VT = (bf16_t*)(P.ws + OFF_VT);
    const float* ct = (const float*)(P.ws + OFF_ROPE); const float* st = ct + 2048;
    const int tid = otid(), hw = tid >> 5, i = tid & 31;
    for (int unit = blockIdx.x; unit < NTOK / 64; unit += gridDim.x) {
        const int row0 = unit * 64; const bool lat = row0 < NLAT;
        const int b = lat ? (row0 >> 13) : ((row0 - NLAT) >> 8);
        const int pos0 = lat ? (row0 & 8191) : SEQ + ((row0 - NLAT) & 255);
        for (int it = 0; it < 8; ++it) {
            float xa[4], xb[4];
#pragma unroll
            for (int u = 0; u < 4; ++u) {
                const int task = hw + 8 * (4 * it + u); const int tok = task >> 2, slot = 16 + (task & 3);
                const int col = slot < 16 ? slot * 64 : (slot < 18 ? 1024 + (slot - 16) * 64 : 1280 + (slot - 18) * 64);
                const bf16_t* p = PL + (size_t)(row0 + tok) * 1536 + col;
                xa[u] = bf2f(p[i]); xb[u] = bf2f(p[i + 32]);
            }
#pragma unroll
            for (int u = 0; u < 4; ++u) {
                const int task = hw + 8 * (4 * it + u); const int tok = task >> 2, slot = 16 + (task & 3);
                const int col = slot < 16 ? slot * 64 : (slot < 18 ? 1024 + (slot - 16) * 64 : 1280 + (slot - 18) * 64);
                bf16_t* p = PL + (size_t)(row0 + tok) * 1536 + col;
                float x1 = xa[u], x2 = xb[u];
                const bool isB = (slot >= 8 && slot < 16) || slot >= 18;
                if (isB) {
                    float ss = x1 * x1 + x2 * x2;
#pragma unroll
                    for (int o = 16; o > 0; o >>= 1) ss += __shfl_xor(ss, o);
                    const float rs = rsqrtf(ss * (1.0f / 64.0f) + EPS);
                    const float* g = slot < 16 ? P.ab_q_gain : P.ab_k_gain;
                    x1 = x1 * rs * g[i]; x2 = x2 * rs * g[i + 32];
                }
                if (lat) {
                    const int t = pos0 + tok; const int pos = i < 16 ? (t >> 6) : (t & 63);
                    const float c = ct[pos * 16 + (i & 15)], sn = st[pos * 16 + (i & 15)];
                    const float o1 = x1 * c - x2 * sn, o2 = x2 * c + x1 * sn; x1 = o1; x2 = o2;
                }
                if (slot < 16) { p[i] = f2bf(x1 * QSCALE); p[i + 32] = f2bf(x2 * QSCALE); }
                else { bf16_t* kp = KB + ((size_t)(b * 4 + (slot - 16)) * KVLEN + pos0 + tok) * 64; kp[i] = f2bf(x1); kp[i + 32] = f2bf(x2); }
            }
        }
        const int d = tid & 63, tg = tid >> 6;
#pragma unroll
        for (int vs = 0; vs < 4; ++vs) {
            const int col = 1024 + (vs < 2 ? 128 + vs * 64 : 384 + (vs - 2) * 64);
            const bf16_t* src = PL + (size_t)(row0 + 16 * tg) * 1536 + col + d;
            unsigned v[16];
#pragma unroll
            for (int j = 0; j < 16; ++j) v[j] = src[(size_t)j * 1536];
            u32x4 a, bq;
            a.x = v[0] | (v[1] << 16); a.y = v[2] | (v[3] << 16); a.z = v[8] | (v[9] << 16); a.w = v[10] | (v[11] << 16);
            bq.x = v[4] | (v[5] << 16); bq.y = v[6] | (v[7] << 16); bq.z = v[12] | (v[13] << 16); bq.w = v[14] | (v[15] << 16);
            bf16_t* dst = VT + ((size_t)(b * 4 + vs) * 64 + d) * KVLEN + pos0 + 16 * tg;
            *(u32x4*)dst = a; *(u32x4*)(dst + 8) = bq;
        }
    }
}

DI void attn_phase(const Params& P, unsigned char* lds) {
    const bf16_t* PL = (const bf16_t*)(P.ws + OFF_PL0); const bf16_t* KB = (const bf16_t*)(P.ws + OFF_KB); const bf16_t* VT = (const bf16_t*)(P.ws + OFF_VT);
    bf16_t* Y = (bf16_t*)(P.ws + OFF_H);
    const int tid = otid(), lane = tid & 63, wave = tid >> 6, l31 = lane & 31, lh = lane >> 5;
    const int lr = tid >> 3, lc = tid & 7;
    for (int unit = blockIdx.x; unit < 8448; unit += gridDim.x) {
        int b, hq, kvh, qrow0, nW, wlo, qpos0 = 0; bool masked = false, has_sink;
        if (unit < 8192) {
            const int u = unit & 4095; b = u >> 9; const int r = u & 511, kvl = r >> 8, hl = (r >> 6) & 3, qb = r & 63;
            qrow0 = b * SEQ + qb * 128; qpos0 = qb * 128;
            if (unit < 4096) { hq = 8 + kvl * 4 + hl; kvh = 2 + kvl; nW = 132; wlo = 0; has_sink = false; }
            else { hq = kvl * 4 + hl; kvh = kvl; masked = true; has_sink = true;
                   const int s0 = qpos0 - 128 < 0 ? 0 : qpos0 - 128, s1 = qpos0 + 256 > SEQ ? SEQ : qpos0 + 256; wlo = s0 >> 6; nW = (s1 >> 6) - wlo; }
        } else { const int u = unit - 8192; b = u >> 5; hq = (u >> 1) & 15; const int qb = u & 1; kvh = hq < 8 ? (hq >> 2) : 2 + ((hq - 8) >> 2);
                 qrow0 = NLAT + b * CTXL + qb * 128; nW = 0; wlo = 0; has_sink = hq < 8; }
        const int nt = masked ? nW + 4 : (nW ? nW : 4);
        const int qrow = qrow0 + 32 * wave + l31;
        const int qpos = qpos0 + 32 * wave + l31;
        bf16x8 qf[4];
        { const bf16_t* qp = PL + (size_t)qrow * 1536 + hq * 64 + 8 * lh;
#pragma unroll
          for (int ks = 0; ks < 4; ++ks) qf[ks] = *(const bf16x8*)(qp + 16 * ks); }
        f32x16 o[2];
#pragma unroll
        for (int r = 0; r < 16; ++r) { o[0][r] = 0.f; o[1][r] = 0.f; }
        float m = -1e30f, l = 0.f;
        const bf16_t* kbase = KB + (size_t)(b * 4 + kvh) * KVLEN * 64;
        const bf16_t* vbase = VT + (size_t)(b * 4 + kvh) * 64 * KVLEN;
        u32x4 rk[2], rv[2];
        auto tile_of = [&](int i) __attribute__((always_inline)) { return (masked && i >= nW) ? 128 + (i - nW) : wlo + i + ((!masked && nW == 0) ? 128 : 0); };
        {
            const int p0 = tile_of(0) * 64;
#pragma unroll
            for (int j = 0; j < 2; ++j) { rk[j] = *(const u32x4*)(kbase + (size_t)(p0 + lr + 32 * j) * 64 + lc * 8); rv[j] = *(const u32x4*)(vbase + (size_t)(lr + 32 * j) * KVLEN + p0 + lc * 8); }
#pragma unroll
            for (int j = 0; j < 2; ++j) { *(u32x4*)(lds + swz(lr + 32 * j, lc)) = rk[j]; *(u32x4*)(lds + 8192 + swz(lr + 32 * j, lc)) = rv[j]; }
        }
        __syncthreads();
        for (int i = 0; i < nt; ++i) {
            unsigned char* cur = lds + (i & 1) * 16384; unsigned char* nxt = lds + ((i + 1) & 1) * 16384;
            const int p0 = tile_of(i) * 64; const bool more = i + 1 < nt;
            if (more) { const int p1 = tile_of(i + 1) * 64;
#pragma unroll
                for (int j = 0; j < 2; ++j) { rk[j] = *(const u32x4*)(kbase + (size_t)(p1 + lr + 32 * j) * 64 + lc * 8); rv[j] = *(const u32x4*)(vbase + (size_t)(lr + 32 * j) * KVLEN + p1 + lc * 8); } }
            const bool wtile = masked && i < nW;
            bool active = true;
            if (wtile) { const int qmin = qpos0 + 32 * wave; active = (p0 <= qmin + 31 + 128) && (p0 + 63 >= qmin - 128); }
            if (active) {
                f32x16 s[2];
                __builtin_amdgcn_s_setprio(1);
#pragma unroll
                for (int kt = 0; kt < 2; ++kt) {
#pragma unroll
                    for (int r = 0; r < 16; ++r) s[kt][r] = 0.f;
#pragma unroll
                    for (int ks = 0; ks < 4; ++ks) { const bf16x8 kf = *(const bf16x8*)(cur + swz(32 * kt + l31, 2 * ks + lh)); s[kt] = MFMA32(kf, qf[ks], s[kt]); }
                }
                __builtin_amdgcn_s_setprio(0);
                if (wtile) {
#pragma unroll
                    for (int kt = 0; kt < 2; ++kt)
#pragma unroll
                        for (int r = 0; r < 16; ++r) { const int kp = p0 + 32 * kt + crow(r, lh); const int dlt = qpos - kp; if (dlt > 128 || dlt < -128) s[kt][r] = -INFINITY; }
                }
                float mx = s[0][0];
#pragma unroll
                for (int kt = 0; kt < 2; ++kt)
#pragma unroll
                    for (int r = 0; r < 16; ++r) mx = fmaxf(mx, s[kt][r]);
                mx = fmaxf(mx, __shfl_xor(mx, 32));
                const float mn = (mx > m + 8.0f) ? mx : m;
                if (__builtin_amdgcn_ballot_w64(mn != m) != 0ull) {
                    const float alpha = __builtin_amdgcn_exp2f(m - mn);
                    l *= alpha;
#pragma unroll
                    for (int r = 0; r < 16; ++r) { o[0][r] *= alpha; o[1][r] *= alpha; }
                    m = mn;
                }
                float ps = 0.f;
#pragma unroll
                for (int kt = 0; kt < 2; ++kt)
#pragma unroll
                    for (int r = 0; r < 16; ++r) { const float pv = __builtin_amdgcn_exp2f(s[kt][r] - mn); s[kt][r] = pv; ps += pv; }
                l += ps;
                __builtin_amdgcn_s_setprio(1);
#pragma unroll
                for (int kt = 0; kt < 2; ++kt)
#pragma unroll
                    for (int sx = 0; sx < 2; ++sx) {
                        union { u32x4 u; bf16x8 h; } pf;
                        pf.u.x = pk2(s[kt][8 * sx + 0], s[kt][8 * sx + 1]); pf.u.y = pk2(s[kt][8 * sx + 2], s[kt][8 * sx + 3]);
                        pf.u.z = pk2(s[kt][8 * sx + 4], s[kt][8 * sx + 5]); pf.u.w = pk2(s[kt][8 * sx + 6], s[kt][8 * sx + 7]);
#pragma unroll
                        for (int dt = 0; dt < 2; ++dt) { const bf16x8 vf = *(const bf16x8*)(cur + 8192 + swz(32 * dt + l31, 2 * (2 * kt + sx) + lh)); o[dt] = MFMA32(vf, pf.h, o[dt]); }
                    }
                __builtin_amdgcn_s_setprio(0);
            }
            if (more) {
#pragma unroll
                for (int j = 0; j < 2; ++j) { *(u32x4*)(nxt + swz(lr + 32 * j, lc)) = rk[j]; *(u32x4*)(nxt + 8192 + swz(lr + 32 * j, lc)) = rv[j]; }
            }
            __syncthreads();
        }
        l += __shfl_xor(l, 32);
        if (has_sink) l += __builtin_amdgcn_exp2f(P.ab_sink[hq] * LOG2E - m);
        const float inv = 1.0f / l;
        bf16_t* yp = Y + (size_t)qrow * DM + hq * 64 + 4 * lh;
#pragma unroll
        for (int dt = 0; dt < 2; ++dt)
#pragma unroll
            for (int g = 0; g < 4; ++g) { u32x2 w; w.x = pk2(o[dt][4 * g] * inv, o[dt][4 * g + 1] * inv); w.y = pk2(o[dt][4 * g + 2] * inv, o[dt][4 * g + 3] * inv); *(u32x2*)(yp + 32 * dt + 8 * g) = w; }
    }
}

DI float mix1(const bf16_t* p, bool hp, bool hn, float mu) {
    const float x = bf2f(p[0]); const float xp = hp ? bf2f(*(p - CDIN)) : 0.f; const float xn = hn ? bf2f(*(p + CDIN)) : 0.f;
    return x + (0.5f * (xp + xn) - x) * mu;
}
DI void mix8(const bf16_t* p, bool hp, bool hn, const float (&mu)[8], float (&o)[8]) {
    const u32x4 z = {0u, 0u, 0u, 0u};
    const u32x4 x = *(const u32x4*)p; const u32x4 xp = hp ? *(const u32x4*)(p - CDIN) : z; const u32x4 xn = hn ? *(const u32x4*)(p + CDIN) : z;
#pragma unroll
    for (int i = 0; i < 4; ++i) {
        const float a0 = lo16(x[i]), a1 = hi16(x[i]);
        o[2 * i] = a0 + (0.5f * (lo16(xp[i]) + lo16(xn[i])) - a0) * mu[2 * i];
        o[2 * i + 1] = a1 + (0.5f * (hi16(xp[i]) + hi16(xn[i])) - a1) * mu[2 * i + 1];
    }
}
template <int MODE>
DI void scan_chain(const Params& P, int chain, unsigned char* lds) {
    const int otid_ = otid(); const int lane = otid_ & 63, wave = (otid_ >> 6) ^ (((((int)blockIdx.x >> 8) ^ (int)blockIdx.x) & 1) ? 2 : 0), tid = wave * 64 + lane;
    const int half = chain & 1, chn = chain >> 1;
    const int b = chn / 24, rem = chn % 24, h = rem >> 1, dir = rem & 1;
    const bf16_t* PL = (const bf16_t*)(P.ws + OFF_PL1);
    bf16_t* Yd = (bf16_t*)(P.ws + (dir ? OFF_YB : OFF_YF));
    float* BON = (float*)(P.ws + OFF_BONUS) + (size_t)dir * NLAT * 12;
    float* buf = (float*)lds;
    float* ybuf = buf + 2 * 6144;
    const int NCH = 528;
    f32x2 S0[4], S1[4];
#pragma unroll
    for (int j = 0; j < 4; ++j) { S0[j] = (f32x2){0.f, 0.f}; S1[j] = (f32x2){0.f, 0.f}; }
    const int q8 = lane & 7, r0 = 32 * half + 16 * (wave & 1) + (lane >> 3), r1 = r0 + 8;
    const int kg = lane >> 4, n16 = lane & 15;
    bf16x8 lf[4][2];
    if (wave >= 2) {
        const float* l2 = (wave == 2 ? P.cd_a2 : P.cd_w2) + (size_t)dir * 64 * 768;
#pragma unroll
        for (int nt = 0; nt < 4; ++nt)
#pragma unroll
            for (int ks = 0; ks < 2; ++ks) {
                union { u32x4 u; bf16x8 hh; } f; const float* s = l2 + (size_t)(32 * ks + 8 * kg) * 768 + 64 * h + 16 * nt + n16;
                f.u.x = pk2(s[0], s[768]); f.u.y = pk2(s[2 * 768], s[3 * 768]); f.u.z = pk2(s[4 * 768], s[5 * 768]); f.u.w = pk2(s[6 * 768], s[7 * 768]);
                lf[nt][ks] = f.hh;
            }
    }
    float* cw = buf + 13312 + (wave & 1) * 384;
    if (wave >= 2) {
        const int ch = lane;
        if (wave == 2) { cw[ch] = P.cd_a0[dir * 768 + 64 * h + ch]; cw[64 + ch] = P.cd_k_k[64 * h + ch]; cw[128 + ch] = P.cd_k_a[64 * h + ch]; cw[192 + ch] = P.cd_r_k[64 * h + ch];
                         cw[256 + ch] = P.cd_mu[768 + 64 * h + ch]; cw[320 + ch] = P.cd_mu[64 * h + ch]; }
        else { cw[ch] = P.cd_w0[dir * 768 + 64 * h + ch]; cw[256 + ch] = P.cd_mu[1536 + 64 * h + ch]; cw[320 + ch] = P.cd_mu[64 * h + ch]; }
        buf[13312 + 768 + (wave - 2) * 64 + ch] = P.cd_mu[(wave == 2 ? 2432 : 2304) + 64 * dir + ch];
        asm volatile("s_waitcnt lgkmcnt(0)" ::: "memory");
    }
    auto chunk_info = [&](int c, int& seqrow0, int& len, int& t0) __attribute__((always_inline)) {
        if (c < 16) { seqrow0 = NLAT + b * CTXL; len = CTXL; t0 = dir ? 240 - 16 * c : 16 * c; }
        else { const int cc = c - 16; seqrow0 = b * SEQ; len = SEQ; t0 = dir ? SEQ - 16 - 16 * cc : 16 * cc; }
    };
    u32x4 xr[3][2], ar[3][2];
    auto issue_loads = [&](int c) __attribute__((always_inline)) {
        int seqrow0, len, t0; chunk_info(c, seqrow0, len, t0);
        const u32x4 z4 = {0u, 0u, 0u, 0u};
        { const int tok = lane >> 2, cq = lane & 3, t = t0 + tok; const bool hp = t > 0, hn = t + 1 < len;
          const bf16_t* prow = PL + (size_t)(seqrow0 + t) * CDIN + 64 * h + 16 * cq + (wave == 2 ? 768 : 1536);
#pragma unroll
          for (int j = 0; j < 2; ++j) { xr[1][j] = *(const u32x4*)(prow + 8 * j); xr[0][j] = hp ? *(const u32x4*)(prow - CDIN + 8 * j) : z4; xr[2][j] = hn ? *(const u32x4*)(prow + CDIN + 8 * j) : z4; } }
        { const int ta = t0 + n16; const bool hpa = ta > 0, hna = ta + 1 < len;
          const bf16_t* p = PL + (size_t)(seqrow0 + ta) * CDIN + (wave == 2 ? 2432 : 2304) + 64 * dir + 8 * kg;
#pragma unroll
          for (int ks = 0; ks < 2; ++ks) { ar[1][ks] = *(const u32x4*)(p + 32 * ks); ar[0][ks] = hpa ? *(const u32x4*)(p - CDIN + 32 * ks) : z4; ar[2][ks] = hna ? *(const u32x4*)(p + CDIN + 32 * ks) : z4; } }
    };
    auto produce = [&](int c) __attribute__((always_inline)) {
        int seqrow0, len, t0; chunk_info(c, seqrow0, len, t0);
        float* bb = buf + (c & 1) * 6144;
        float* scr = buf + 14336 + (wave - 2) * 1024;
        const int tok = lane >> 2, cq = lane & 3, t = t0 + tok; const bool hp = t > 0, hn = t + 1 < len;
        const bf16_t* prow = PL + (size_t)(seqrow0 + t) * CDIN + 64 * h + 16 * cq;
        const int cb = 64 * h + 16 * cq;
        const int xcol = wave == 2 ? 768 : 1536;
        const u32x4 z4 = {0u, 0u, 0u, 0u};
        u32x4 rr_[3][2];
#pragma unroll
        for (int j = 0; j < 2; ++j) { rr_[1][j] = *(const u32x4*)(prow + 8 * j); rr_[0][j] = hp ? *(const u32x4*)(prow - CDIN + 8 * j) : z4; rr_[2][j] = hn ? *(const u32x4*)(prow + CDIN + 8 * j) : z4; }
        bf16x8 af[2];
        {
            const float* mulp = buf + 13312 + 768 + (wave - 2) * 64 + 8 * kg;
#pragma unroll
            for (int ks = 0; ks < 2; ++ks) {
                const f32x4 m0 = *(const f32x4*)(mulp + 32 * ks), m1 = *(const f32x4*)(mulp + 32 * ks + 4);
                float xv[8];
#pragma unroll
                for (int e = 0; e < 4; ++e) {
                    const float a0 = lo16(ar[1][ks][e]), a1 = hi16(ar[1][ks][e]);
                    const float mu0 = e < 2 ? m0[2 * e] : m1[2 * e - 4], mu1 = e < 2 ? m0[2 * e + 1] : m1[2 * e - 3];
                    xv[2 * e] = a0 + (0.5f * (lo16(ar[0][ks][e]) + lo16(ar[2][ks][e])) - a0) * mu0;
                    xv[2 * e + 1] = a1 + (0.5f * (hi16(ar[0][ks][e]) + hi16(ar[2][ks][e])) - a1) * mu1;
                }
                if (wave == 3) {
#pragma unroll
                    for (int j = 0; j < 8; ++j) xv[j] = 1.0f - 2.0f * __builtin_amdgcn_rcpf(1.0f + __builtin_amdgcn_exp2f(2.8853900817779268f * xv[j]));
                }
                union { u32x4 u; bf16x8 hh; } f; f.u.x = pk2(xv[0], xv[1]); f.u.y = pk2(xv[2], xv[3]); f.u.z = pk2(xv[4], xv[5]); f.u.w = pk2(xv[6], xv[7]);
                af[ks] = f.hh;
            }
        }
        f32x4 acc[4];
#pragma unroll
        for (int nt = 0; nt < 4; ++nt) { acc[nt] = (f32x4){0.f, 0.f, 0.f, 0.f};
#pragma unroll
            for (int ks = 0; ks < 2; ++ks) acc[nt] = MFMA16(af[ks], lf[nt][ks], acc[nt]); }
#pragma unroll
        for (int nt = 0; nt < 4; ++nt)
#pragma unroll
            for (int rg = 0; rg < 4; ++rg) scr[(4 * kg + rg) * 64 + 16 * nt + n16] = acc[nt][rg];
        asm volatile("s_waitcnt lgkmcnt(0)" ::: "memory");
        const float* prep_ = scr + tok * 64 + 16 * cq;
        float xm[16];
        {
            const float* mux = cw + 256 + 16 * cq;
#pragma unroll
            for (int j = 0; j < 2; ++j)
#pragma unroll
                for (int e = 0; e < 4; ++e) {
                    const f32x2 mx2 = *(const f32x2*)(mux + 8 * j + 2 * e);
                    const float a0 = lo16(xr[1][j][e]), a1 = hi16(xr[1][j][e]);
                    xm[8 * j + 2 * e] = a0 + (0.5f * (lo16(xr[0][j][e]) + lo16(xr[2][j][e])) - a0) * mx2.x;
                    xm[8 * j + 2 * e + 1] = a1 + (0.5f * (hi16(xr[0][j][e]) + hi16(xr[2][j][e])) - a1) * mx2.y;
                }
        }
        float* o = bb + tok * 64 + 16 * cq;
        const float* mur = cw + 320 + 16 * cq;
        if (wave == 2) {
            float ss = 0.f, bonus = 0.f;
#pragma unroll
            for (int j = 0; j < 4; ++j) { const f32x4 kkc = *(const f32x4*)(cw + 64 + 16 * cq + 4 * j);
#pragma unroll
                for (int e = 0; e < 4; ++e) { const float kr = xm[4 * j + e] * kkc[e]; ss += kr * kr; } }
            ss = quad_sum(ss);
            const float inv = __builtin_amdgcn_rcpf(fmaxf(__builtin_amdgcn_sqrtf(ss), 1e-12f));
#pragma unroll
            for (int j = 0; j < 4; ++j) {
                asm volatile("" ::: "memory");
                const f32x4 a0 = *(const f32x4*)(cw + 16 * cq + 4 * j), kkc = *(const f32x4*)(cw + 64 + 16 * cq + 4 * j),
                            kac = *(const f32x4*)(cw + 128 + 16 * cq + 4 * j), rkc = *(const f32x4*)(cw + 192 + 16 * cq + 4 * j), mr = *(const f32x4*)(mur + 4 * j);
                const f32x4 pre = *(const f32x4*)(prep_ + 4 * j);
                f32x4 vkd, vb, vkk;
#pragma unroll
                for (int e = 0; e < 4; ++e) {
                    const int ix = 4 * j + e, jj = ix >> 3, ee = (ix & 7) >> 1; const bool hi = ix & 1;
                    const float r1 = hi ? hi16(rr_[1][jj][ee]) : lo16(rr_[1][jj][ee]), r0 = hi ? hi16(rr_[0][jj][ee]) : lo16(rr_[0][jj][ee]), r2 = hi ? hi16(rr_[2][jj][ee]) : lo16(rr_[2][jj][ee]);
                    const float r = r1 + (0.5f * (r0 + r2) - r1) * mr[e];
                    const float a = sigmoidf_(a0[e] + pre[e]);
                    const float kk = xm[ix] * kkc[e] * inv, kd = xm[ix] * (1.0f + (a - 1.0f) * kac[e]);
                    bonus += r * kd * rkc[e]; vkd[e] = kd; vb[e] = kk * a; vkk[e] = kk;
                }
                *(f32x4*)(o + 1024 + 4 * j) = vkd; *(f32x4*)(o + 2048 + 4 * j) = vb; *(f32x4*)(o + 3072 + 4 * j) = vkk;
            }
            bonus = quad_sum(bonus);
            if (c >= 16 && cq == 0 && half == 0) BON[(size_t)(seqrow0 + t) * 12 + h] = bonus;
        } else {
#pragma unroll
            for (int j = 0; j < 4; ++j) {
                asm volatile("" ::: "memory");
                const f32x4 w0 = *(const f32x4*)(cw + 16 * cq + 4 * j), mr = *(const f32x4*)(mur + 4 * j);
                const f32x4 pre = *(const f32x4*)(prep_ + 4 * j);
                f32x4 vw, vr, vv;
#pragma unroll
                for (int e = 0; e < 4; ++e) {
                    const int ix = 4 * j + e, jj = ix >> 3, ee = (ix & 7) >> 1; const bool hi = ix & 1;
                    const float r1 = hi ? hi16(rr_[1][jj][ee]) : lo16(rr_[1][jj][ee]), r0 = hi ? hi16(rr_[0][jj][ee]) : lo16(rr_[0][jj][ee]), r2 = hi ? hi16(rr_[2][jj][ee]) : lo16(rr_[2][jj][ee]);
                    vr[e] = r1 + (0.5f * (r0 + r2) - r1) * mr[e];
                    const float xs = -(w0[e] + pre[e]); const float sp = fmaxf(xs, 0.f) + 0.6931471805599453f * __builtin_amdgcn_logf(1.0f + __builtin_amdgcn_exp2f(-1.4426950408889634f * fabsf(xs)));
                    vw[e] = __builtin_amdgcn_exp2f(-1.4426950408889634f * __builtin_amdgcn_exp2f(-1.4426950408889634f * (sp + 0.5f))); vv[e] = xm[ix];
                }
                *(f32x4*)(o + 4 * j) = vw; *(f32x4*)(o + 4096 + 4 * j) = vr; *(f32x4*)(o + 5120 + 4 * j) = vv;
            }
        }
    };
    auto flush_y = [&](int c) __attribute__((always_inline)) {
        int seqrow0, len, t0; chunk_info(c, seqrow0, len, t0);
        const int p = tid - 128, tok = p >> 3, rl = (p & 7) * 4, rg = 32 * half + rl;
        const f32x4 a = *(const f32x4*)(ybuf + (c & 1) * 512 + tok * 32 + rl);
        u32x2 w; w.x = pk2(a.x, a.y); w.y = pk2(a.z, a.w);
        *(u32x2*)(Yd + (size_t)(seqrow0 + t0 + tok) * 768 + 64 * h + rg) = w;
    };
    struct SV { f32x4 kk[2], bv[2], kd[2], w[2], rr[2]; float v0, v1; };
#define SLOAD(S, TK) { const float* base_ = bb + (TK) * 64 + 8 * q8; \
        S.kk[0] = *(const f32x4*)(base_ + 3072); S.kk[1] = *(const f32x4*)(base_ + 3076); \
        S.bv[0] = *(const f32x4*)(base_ + 2048); S.bv[1] = *(const f32x4*)(base_ + 2052); S.kd[0] = *(const f32x4*)(base_ + 1024); S.kd[1] = *(const f32x4*)(base_ + 1028); \
        S.w[0] = *(const f32x4*)(base_); S.w[1] = *(const f32x4*)(base_ + 4); S.rr[0] = *(const f32x4*)(base_ + 4096); S.rr[1] = *(const f32x4*)(base_ + 4100); \
        S.v0 = bb[5 * 1024 + (TK) * 64 + r0]; S.v1 = bb[5 * 1024 + (TK) * 64 + r1]; }
#define SSTEP(S, TK) { \
        f32x2 a0 = {0.f, 0.f}, a1 = {0.f, 0.f}; \
        _Pragma("unroll") for (int j = 0; j < 4; ++j) { const f32x2 kj = {S.kk[j >> 1][2 * (j & 1)], S.kk[j >> 1][2 * (j & 1) + 1]}; a0 += S0[j] * kj; a1 += S1[j] * kj; } \
        const float sa0 = -oct_sum(a0.x + a0.y), sa1 = -oct_sum(a1.x + a1.y); \
        f32x2 y0 = {0.f, 0.f}, y1 = {0.f, 0.f}; \
        _Pragma("unroll") for (int j = 0; j < 4; ++j) { const int jj = j >> 1, e = 2 * (j & 1); \
            const f32x2 wj = {S.w[jj][e], S.w[jj][e + 1]}, bj = {S.bv[jj][e], S.bv[jj][e + 1]}, kj = {S.kd[jj][e], S.kd[jj][e + 1]}, rj = {S.rr[jj][e], S.rr[jj][e + 1]}; \
            S0[j] = S0[j] * wj + (bj * sa0 + kj * S.v0); S1[j] = S1[j] * wj + (bj * sa1 + kj * S.v1); \
            y0 += S0[j] * rj; y1 += S1[j] * rj; } \
        const float yy0 = oct_sum(y0.x + y0.y), yy1 = oct_sum(y1.x + y1.y); \
        if (q8 == 0) { yb[(TK) * 32 + (r0 & 31)] = yy0; yb[(TK) * 32 + (r1 & 31)] = yy1; } }
    auto scan_chunk = [&](int c) __attribute__((always_inline)) {
        const float* bb = buf + (c & 1) * 6144; float* yb = ybuf + (c & 1) * 512;
        const int t0s = dir ? 15 : 0, dt = dir ? -1 : 1;
        SV A, B;
        SLOAD(A, t0s)
        for (int ii = 0; ii < 16; ii += 2) {
            const int ta = t0s + dt * ii, tb = ta + dt, tc = tb + dt;
            SLOAD(B, tb)
            SSTEP(A, ta)
            if (ii + 2 < 16) SLOAD(A, tc)
            SSTEP(B, tb)
        }
    };
    if (__builtin_amdgcn_readfirstlane(wave) < 2) __builtin_amdgcn_s_setprio(2); else __builtin_amdgcn_s_setprio(1);
    if (wave >= 2) { issue_loads(0); produce(0); issue_loads(1); }
    __syncthreads();
    for (int c = 0; c < NCH; ++c) {
        if (wave < 2) { if (MODE != 1) scan_chunk(c); }
        else if (MODE != 2) {
            if (c >= 17) flush_y(c - 1);
            if (c + 1 < NCH) produce(c + 1);
            if (c + 2 < NCH) issue_loads(c + 2);
        }
        __syncthreads();
    }
    if (wave >= 2) flush_y(NCH - 1);
    __builtin_amdgcn_s_setprio(0);
    __syncthreads();
}

DI void pool_units(const Params& P, int first, int stride, unsigned char* lds) {
    const bf16_t* PL = (const bf16_t*)(P.ws + OFF_PL1); bf16_t* Y = (bf16_t*)(P.ws + OFF_H); bf16_t* AG = (bf16_t*)(P.ws + OFF_AG);
    float* pl = (float*)lds;
    const int tid = otid(), g = tid >> 6, i = tid & 63;
    float pw[64];
#pragma unroll
    for (int ii = 0; ii < 64; ++ii) pw[ii] = P.cd_pool_w[(size_t)(g * 64 + ii) * 64 + i];
    const float scale = P.cd_pool_scale[tid];
    const int wl = 1 << g, wr = 1 << g;
    float mug[8];
#pragma unroll
    for (int j = 0; j < 8; ++j) mug[j] = P.cd_mu[2560 + 8 * (tid & 15) + j];
    for (int u = first; u < NLAT / 32; u += stride) {
        const int row0 = u * 32, b = row0 >> 13, t0 = row0 & 8191;
        const bf16_t* col = PL + (size_t)(b * SEQ) * CDIN + 2688 + tid;
        __syncthreads();
        {
            int lo = t0 - wl < 0 ? 0 : t0 - wl, hi = t0 + wr > SEQ ? SEQ : t0 + wr;
            float sum = 0.f;
            for (int s = lo; s < hi; ++s) sum += bf2f(col[(size_t)s * CDIN]);
            for (int tok = 0; tok < 32; ++tok) {
                const int t = t0 + tok;
                lo = t - wl < 0 ? 0 : t - wl; hi = t + wr > SEQ ? SEQ : t + wr;
                pl[tok * 256 + tid] = sum / (float)(hi - lo) - bf2f(col[(size_t)t * CDIN]);
                if (t + wr < SEQ) sum += bf2f(col[(size_t)(t + wr) * CDIN]);
                if (t - wl >= 0) sum -= bf2f(col[(size_t)(t - wl) * CDIN]);
            }
        }
        __syncthreads();
        for (int tok = 0; tok < 32; ++tok) {
            const float* pp = pl + tok * 256 + g * 64; float acc = 0.f;
#pragma unroll
            for (int ii = 0; ii < 16; ++ii) { const f32x4 v = *(const f32x4*)(pp + 4 * ii); acc += v.x * pw[4 * ii] + v.y * pw[4 * ii + 1] + v.z * pw[4 * ii + 2] + v.w * pw[4 * ii + 3]; }
            Y[(size_t)(row0 + tok) * DM + 768 + tid] = f2bf(acc * scale);
        }
#pragma unroll
        for (int hh = 0; hh < 2; ++hh) {
            const int tok = (tid >> 4) + 16 * hh, t = t0 + tok;
            float xv[8]; mix8(PL + (size_t)(row0 + tok) * CDIN + 2560 + 8 * (tid & 15), t > 0, t + 1 < SEQ, mug, xv);
            u32x4 w; w.x = pk2(sigmoidf_(xv[0]), sigmoidf_(xv[1])); w.y = pk2(sigmoidf_(xv[2]), sigmoidf_(xv[3])); w.z = pk2(sigmoidf_(xv[4]), sigmoidf_(xv[5])); w.w = pk2(sigmoidf_(xv[6]), sigmoidf_(xv[7]));
            *(u32x4*)(AG + (size_t)(row0 + tok) * 128 + 8 * (tid & 15)) = w;
        }
    }
    __syncthreads();
}
DI void scan_phase(const Params& P, unsigned char* lds) {
    const int G = gridDim.x;
#ifndef SCAN_REP
#define SCAN_REP 1
#endif
#ifdef SCAN_PROBE
    for (int c = blockIdx.x; c < 384; c += G) scan_chain<SCAN_PROBE>(P, c, lds);
#endif
    for (int c = blockIdx.x; c < 384; c += G) scan_chain<0>(P, c, lds);
    if (G > 384) { if ((int)blockIdx.x >= 384) pool_units(P, blockIdx.x - 384, G - 384, lds); }
    else pool_units(P, blockIdx.x, G, lds);
}
DI void zpass_phase(const Params& P) {
    const bf16_t* PL = (const bf16_t*)(P.ws + OFF_PL1); const bf16_t* YF = (const bf16_t*)(P.ws + OFF_YF); const bf16_t* YB = (const bf16_t*)(P.ws + OFF_YB);
    const float* BON = (const float*)(P.ws + OFF_BONUS); bf16_t* Y = (bf16_t*)(P.ws + OFF_H);
    const int tid = otid(), hw = tid >> 5, i = tid & 31;
    const int stride = gridDim.x * 8;
    for (int task0 = blockIdx.x * 8 + hw; task0 < NLAT * 12; task0 += 4 * stride) {
        unsigned ya[4], yb[4]; float bon[4]; unsigned short vr[4][6];
#pragma unroll
        for (int u = 0; u < 4; ++u) {
            const int task = task0 + u * stride; const bool ok = task < NLAT * 12;
            const int row = ok ? task / 12 : 0, h = ok ? task - row * 12 : 0, t = row & 8191, c = 64 * h + 2 * i;
            ya[u] = *(const unsigned*)(YF + (size_t)row * 768 + c); yb[u] = *(const unsigned*)(YB + (size_t)row * 768 + c);
            bon[u] = BON[(size_t)row * 12 + h] + BON[(size_t)NLAT * 12 + (size_t)row * 12 + h];
            const bf16_t* pv = PL + (size_t)row * CDIN + 1536 + c;
            const unsigned cur = *(const unsigned*)pv, prv = t > 0 ? *(const unsigned*)(pv - CDIN) : 0u, nxt = t + 1 < SEQ ? *(const unsigned*)(pv + CDIN) : 0u;
            vr[u][0] = (unsigned short)(cur & 0xffff); vr[u][1] = (unsigned short)(cur >> 16); vr[u][2] = (unsigned short)(prv & 0xffff); vr[u][3] = (unsigned short)(prv >> 16);
            vr[u][4] = (unsigned short)(nxt & 0xffff); vr[u][5] = (unsigned short)(nxt >> 16);
        }
#pragma unroll
        for (int u = 0; u < 4; ++u) {
            const int task = task0 + u * stride; const bool ok = task < NLAT * 12;
            const int row = ok ? task / 12 : 0, h = ok ? task - row * 12 : 0, c = 64 * h + 2 * i;
            const float y0 = lo16(ya[u]) + lo16(yb[u]), y1 = hi16(ya[u]) + hi16(yb[u]);
            float sm = y0 + y1;
#pragma unroll
            for (int o = 16; o > 0; o >>= 1) sm += __shfl_xor(sm, o);
            const float mean = sm * (1.0f / 64.0f); const float d0 = y0 - mean, d1 = y1 - mean;
            float vs = d0 * d0 + d1 * d1;
#pragma unroll
            for (int o = 16; o > 0; o >>= 1) vs += __shfl_xor(vs, o);
            const float rs = rsqrtf(vs * (1.0f / 64.0f) + LNX_EPS);
            const float x0 = bf2f(vr[u][0]), x1 = bf2f(vr[u][1]);
            const float v0 = x0 + (0.5f * (bf2f(vr[u][2]) + bf2f(vr[u][4])) - x0) * P.cd_mu[1536 + c], v1 = x1 + (0.5f * (bf2f(vr[u][3]) + bf2f(vr[u][5])) - x1) * P.cd_mu[1536 + c + 1];
            const float z0 = d0 * rs * P.cd_lnx_w[c] + P.cd_lnx_b[c] + bon[u] * v0, z1 = d1 * rs * P.cd_lnx_w[c + 1] + P.cd_lnx_b[c + 1] + bon[u] * v1;
            if (ok) *(unsigned*)(Y + (size_t)row * DM + c) = pk2(z0, z1);
        }
    }
}


constexpr size_t OFF_BAR = OFF_ROPE + 512 * 1024;
#define XB_TMO      128
#define XB_XCNT(j)  (256  + 64 * (j))
#define XB_XSUB(j)  (1280 + 64 * (j))
#define XB_XGEN(j)  (2304 + 64 * (j))
#define XB_TOP      3328
#define XB_TOPGEN   3392
#define XCD_BAR_WORDS 3456
#define XB_SPIN_CAP (1u << 22)
DI unsigned xb_ld(unsigned* p)              { return __hip_atomic_load(p, __ATOMIC_RELAXED, __HIP_MEMORY_SCOPE_AGENT); }
DI unsigned xb_add(unsigned* p, unsigned v) { return __hip_atomic_fetch_add(p, v, __ATOMIC_RELAXED, __HIP_MEMORY_SCOPE_AGENT); }
DI unsigned xb_xcc_id() { return (unsigned)__builtin_amdgcn_s_getreg((3 << 11) | 20) & 0xFu; }
#define XB_SPIN(cond, bar) do { unsigned _sp = 0; while (cond) { __builtin_amdgcn_s_sleep(1); \
    if ((++_sp & 255u) == 0u) { if (xb_ld(&(bar)[XB_TMO])) break; if (_sp > XB_SPIN_CAP) { atomicAdd(&(bar)[XB_TMO], 1u); break; } } } } while (0)
struct XcdBar { unsigned* bar; unsigned x, nloc, nx; };
DI void xcd_barrier(const XcdBar& b) {
    asm volatile("s_waitcnt vmcnt(0)" ::: "memory");
    __syncthreads();
    if (threadIdx.x == 0) {
        unsigned* bar = b.bar;
        __builtin_amdgcn_s_waitcnt(0);
        const unsigned nloc = b.nloc, nx = b.nx;
        const unsigned old = xb_add(&bar[XB_XSUB(b.x)], 1u);
        const unsigned gen = old / nloc;
        if (old + 1u == (gen + 1u) * nloc) {
            __builtin_amdgcn_fence(__ATOMIC_RELEASE, "agent");
            asm volatile("s_waitcnt vmcnt(0)" ::: "memory");
            const unsigned og = xb_add(&bar[XB_TOP], 1u);
            const unsigned tg = og / nx;
            if (og + 1u == (tg + 1u) * nx) xb_add(&bar[XB_TOPGEN], 1u);
            else XB_SPIN(xb_ld(&bar[XB_TOPGEN]) == tg, bar);
            __builtin_amdgcn_fence(__ATOMIC_ACQUIRE, "agent");
            xb_add(&bar[XB_XGEN(b.x)], 1u);
            asm volatile("s_waitcnt vmcnt(0)" ::: "memory");
        } else {
            XB_SPIN(xb_ld(&bar[XB_XGEN(b.x)]) == gen, bar);
            __builtin_amdgcn_fence(__ATOMIC_ACQUIRE, "agent");
            asm volatile("s_waitcnt vmcnt(0)" ::: "memory");
        }
    }
    __syncthreads();
}

#ifndef PHASE_MASK
#define PHASE_MASK 0xffff
#endif
#ifndef PHASE_LIMIT
#define PHASE_LIMIT 100
#endif
#ifndef REP_IDX
#define REP_IDX -1
#endif
#ifndef REP_N
#define REP_N 2
#endif
#define PH(n, idx) if ((((PHASE_MASK) >> (n)) & 1) && ((idx) < (PHASE_LIMIT) || (n) == 8))
__global__ void __launch_bounds__(256, 2) fwd_megakernel(Params P) {
    __shared__ __attribute__((aligned(16))) unsigned char lds[65536];
    cg::grid_group grid = cg::this_grid();
    XcdBar xb; xb.bar = (unsigned*)(P.ws + OFF_BAR); xb.x = xb_xcc_id();
    if (threadIdx.x == 0) (void)xb_add(&xb.bar[XB_XCNT(xb.x)], 1u);
    unsigned char* ws = P.ws;
    const float* MOD = (const float*)(ws + OFF_MOD);
    bf16_t* H = (bf16_t*)(ws + OFF_H);
    float* XLC = (float*)(ws + OFF_XLC);
    PH(0, 0) prep_phase(P, lds);
    grid.sync();
    {
        unsigned mine = 0u, cnt = 0u;
#pragma unroll
        for (unsigned j = 0; j < 16; ++j) { const unsigned c = xb_ld(&xb.bar[XB_XCNT(j)]); cnt += (c > 0u) ? 1u : 0u; mine = (j == xb.x) ? c : mine; }
        xb.nloc = __builtin_amdgcn_readfirstlane(mine > 0u ? mine : 1u); xb.nx = __builtin_amdgcn_readfirstlane(cnt > 0u ? cnt : 1u);
    }
    PH(1, 1) modfinal_phase(P);
    xcd_barrier(xb);
    PH(2, 2) rownorm_phase(P.x, P.ctx, NTOK, P.norm_gain, MOD, 0, 1, H);
    xcd_barrier(xb);
    PH(3, 3) gemm256_phase((const bf16_t*)H, DM, (const bf16_t*)(ws + OFF_WAB_IN), DM, NTOK, 1536, DM, EpiInprojL0{(bf16_t*)(ws + OFF_PL0), P.ab_q_gain, (const float*)(ws + OFF_ROPE), (const float*)(ws + OFF_ROPE) + 2048, P.ab_k_gain, (bf16_t*)(ws + OFF_KB), (bf16_t*)(ws + OFF_VT)}, lds);
    xcd_barrier(xb);
    PH(5, 5) attn_phase(P, lds);
#if REP_IDX == 5
    { xcd_barrier(xb); attn_phase(P, lds); }
#endif
    xcd_barrier(xb);
    PH(3, 6) gemm256_phase((const bf16_t*)H, DM, (const bf16_t*)(ws + OFF_WAB_OUT), DM, NTOK, DM, DM, EpiResidual{P.x, P.ctx, P.out, XLC, MOD, 2}, lds);
    xcd_barrier(xb);
    PH(2, 7) rownorm_phase(P.out, XLC, NTOK, P.norm_gain + 1024, MOD, 3, 4, H);
    xcd_barrier(xb);
    PH(3, 8) gemm256_phase((const bf16_t*)H, DM, (const bf16_t*)(ws + OFF_WFFN_IN), DM, NTOK, 5632, DM, EpiSwiglu{(bf16_t*)(ws + OFF_HID)}, lds);
#if REP_IDX == 8
    { xcd_barrier(xb); gemm256_phase((const bf16_t*)H, DM, (const bf16_t*)(ws + OFF_WFFN_IN), DM, NTOK, 5632, DM, EpiSwiglu{(bf16_t*)(ws + OFF_HID)}, lds); }
#endif
    xcd_barrier(xb);
    PH(3, 9) gemm256_phase((const bf16_t*)(ws + OFF_HID), FFH, (const bf16_t*)(ws + OFF_WFFN_OUT), FFH, NTOK, DM, FFH, EpiResidual{P.out, XLC, P.out, XLC, MOD, 5}, lds);
    xcd_barrier(xb);
    const float* MOD1 = MOD + 9 * 6144;
    PH(2, 10) rownorm_phase(P.out, XLC, NTOK, P.norm_gain + 2048, MOD1, 0, 1, H);
    xcd_barrier(xb);
    PH(3, 11) gemm256_phase((const bf16_t*)H, DM, (const bf16_t*)(ws + OFF_WCD_IN), DM, NTOK, 3072, DM, EpiStoreBf16{(bf16_t*)(ws + OFF_PL1), CDIN}, lds);
    xcd_barrier(xb);
    PH(6, 12) scan_phase(P, lds);
#if REP_IDX == 12
    { xcd_barrier(xb); scan_phase(P, lds); }
#endif
    xcd_barrier(xb);
    PH(7, 13) zpass_phase(P);
    xcd_barrier(xb);
    PH(3, 14) gemm256_phase((const bf16_t*)(ws + OFF_AG), 128, (const bf16_t*)(ws + OFF_WG2), 128, NLAT, 768, 128, EpiGateMul{H}, lds);
    xcd_barrier(xb);
    PH(3, 15) gemm256_phase((const bf16_t*)H, DM, (const bf16_t*)(ws + OFF_WCD_OUT), DM, NLAT, DM, DM, EpiResidual{P.out, XLC, P.out, XLC, MOD1, 2}, lds);
    xcd_barrier(xb);
    PH(2, 16) rownorm_phase(P.out, XLC, NLAT, P.norm_gain + 3072, MOD1, 3, 4, H);
    xcd_barrier(xb);
    PH(3, 17) gemm256_phase((const bf16_t*)H, DM, (const bf16_t*)(ws + OFF_WFFN_IN + WFFN_IN_SZ), DM, NLAT, 5632, DM, EpiSwiglu{(bf16_t*)(ws + OFF_HID)}, lds);
    xcd_barrier(xb);
    PH(3, 18) gemm256_phase((const bf16_t*)(ws + OFF_HID), FFH, (const bf16_t*)(ws + OFF_WFFN_OUT + WFFN_OUT_SZ), FFH, NLAT, DM, FFH, EpiResidual{P.out, XLC, P.out, XLC, MOD1, 5}, lds);
    xcd_barrier(xb);
    PH(8, 19) finalnorm_phase(P);
}

extern "C" void kernel_launch(void* const* d_in, const int* in_sizes, int n_in, void* d_out, int out_size, void* d_ws, size_t ws_size, hipStream_t stream) {
    static int grid_blocks = 0;
    if (!grid_blocks) {
        int dev = 0, cus = 0, per_cu = 0;
        hipGetDevice(&dev);
        hipDeviceGetAttribute(&cus, hipDeviceAttributeMultiprocessorCount, dev);
        hipOccupancyMaxActiveBlocksPerMultiprocessor(&per_cu, (const void*)fwd_megakernel, 256, 0);
        if (per_cu < 1) per_cu = 1;
        if (per_cu > 2) per_cu = 2;
        grid_blocks = cus * per_cu;
    }
    Params p{};
    const float** pp = (const float**)&p;
    for (int i = 0; i < 30; ++i) pp[i] = (const float*)d_in[i];
    p.out = (float*)d_out; p.ws = (unsigned char*)d_ws;
    (void)hipMemsetAsync((unsigned char*)d_ws + OFF_BAR, 0, XCD_BAR_WORDS * 4, stream);
    void* args[] = {&p};
    hipError_t e = hipLaunchCooperativeKernel((const void*)fwd_megakernel, dim3(grid_blocks), dim3(256), args, 0, stream);
    if (e != hipSuccess) fprintf(stderr, "cooperative launch failed: %s (grid %d)\n", hipGetErrorString(e), grid_blocks);
}
```

```cpp
#include <hip/hip_runtime.h>
#include <hip/hip_cooperative_groups.h>
#include <cstdio>
#include <cstdint>
namespace cg = cooperative_groups;

typedef unsigned short bf16_t;
typedef short bf16x8 __attribute__((ext_vector_type(8)));
typedef float f32x4 __attribute__((ext_vector_type(4)));
typedef float f32x16 __attribute__((ext_vector_type(16)));
typedef float f32x2 __attribute__((ext_vector_type(2)));
typedef unsigned u32x4 __attribute__((ext_vector_type(4)));
typedef unsigned u32x2 __attribute__((ext_vector_type(2)));
#define DI __device__ __forceinline__

constexpr int NLAT = 65536, NCTX = 2048, NTOK = NLAT + NCTX, DM = 1024, SEQ = 8192, CTXL = 256;
constexpr int FFH = 2816, CDIN = 2944, KVLEN = SEQ + CTXL;
constexpr float EPS = 1e-6f, LNX_EPS = 64e-5f;
constexpr float QSCALE = 0.125f * 1.4426950408889634f, LOG2E = 1.4426950408889634f;

constexpr size_t MB = 1u << 20;
constexpr size_t OFF_WAB_IN = 0, OFF_WAB_OUT = 3 * MB, OFF_WCD_IN = 5 * MB, OFF_WCD_OUT = 11 * MB, OFF_WFFN_IN = 13 * MB, OFF_WFFN_OUT = 35 * MB,
                 OFF_WG2 = 46 * MB, OFF_MOD = 47 * MB, OFF_MODP = 48 * MB, OFF_ROPE = 52 * MB, OFF_XLC = 53 * MB, OFF_H = 61 * MB, OFF_BIG = 193 * MB;
constexpr size_t OFF_PL0 = OFF_BIG, OFF_KB = OFF_BIG + 198 * MB, OFF_VT = OFF_BIG + 231 * MB;
constexpr size_t OFF_HID = OFF_BIG;
constexpr size_t OFF_PL1 = OFF_BIG, OFF_YF = OFF_BIG + 380 * MB, OFF_YB = OFF_BIG + 476 * MB, OFF_AG = OFF_BIG + 572 * MB, OFF_BONUS = OFF_BIG + 588 * MB;
constexpr size_t OFF_G = OFF_BIG + 600 * MB;
constexpr size_t WFFN_IN_SZ = 11 * MB, WFFN_OUT_SZ = (size_t)1024 * 2816 * 2;

struct Params {
    const float *x, *c, *ctx, *c_ctx, *norm_gain, *ada_w, *ada_b, *ffn_w_in, *ffn_w_out, *final_gain, *ab_w_in, *ab_q_gain, *ab_k_gain, *ab_sink, *ab_w_out,
        *cd_w_in, *cd_mu, *cd_w0, *cd_w2, *cd_a0, *cd_a2, *cd_g2, *cd_k_k, *cd_k_a, *cd_r_k, *cd_lnx_w, *cd_lnx_b, *cd_pool_w, *cd_pool_scale, *cd_w_out;
    float* out; unsigned char* ws;
};

DI float bf2f(bf16_t b) { return __uint_as_float(((unsigned)b) << 16); }
typedef __bf16 bf16x2v __attribute__((ext_vector_type(2)));
DI unsigned pk2(float lo, float hi) { const f32x2 v = {lo, hi}; return __builtin_bit_cast(unsigned, __builtin_convertvector(v, bf16x2v)); }
DI bf16_t f2bf(float f) { return __builtin_bit_cast(bf16_t, (__bf16)f); }
DI float lo16(unsigned u) { return __uint_as_float(u << 16); }
DI float hi16(unsigned u) { return __uint_as_float(u & 0xffff0000u); }
DI float sigmoidf_(float x) { return __builtin_amdgcn_rcpf(1.0f + __builtin_amdgcn_exp2f(-1.4426950408889634f * x)); }
DI float quad_sum(float x) {
    x += __int_as_float(__builtin_amdgcn_mov_dpp(__float_as_int(x), 0xB1, 0xf, 0xf, true));
    x += __int_as_float(__builtin_amdgcn_mov_dpp(__float_as_int(x), 0x4E, 0xf, 0xf, true));
    return x;
}
DI float oct_sum(float x) { x = quad_sum(x); x += __int_as_float(__builtin_amdgcn_mov_dpp(__float_as_int(x), 0x141, 0xf, 0xf, true)); return x; }
DI int otid() { int t = threadIdx.x; asm volatile("" : "+v"(t)); return t; }
DI unsigned swz(int row, int chunk) { return (unsigned)row * 128u + (unsigned)((chunk ^ ((row >> 1) & 7)) << 4); }
#define MFMA32(a, b, c) __builtin_amdgcn_mfma_f32_32x32x16_bf16((a), (b), (c), 0, 0, 0)
#define MFMA16(a, b, c) __builtin_amdgcn_mfma_f32_16x16x32_bf16((a), (b), (c), 0, 0, 0)
DI int crow(int r, int hi) { return (r & 3) + 8 * (r >> 2) + 4 * hi; }

template <class Epi>
DI void gemm_phase(const bf16_t* __restrict__ A, int lda, const bf16_t* __restrict__ Bt, int ldb, int M, int N, int K, const Epi& epi, unsigned char* lds) {
    const int tid = otid(), lane = tid & 63, wave = tid >> 6, wm = wave >> 1, wn = wave & 1;
    const int nNt = N / 128, nk = K / 64;
    const int lr = tid >> 3, lc = tid & 7, l31 = lane & 31, lh = lane >> 5;
    const int G8 = gridDim.x >> 3, xcd = blockIdx.x & 7, lb = blockIdx.x >> 3, mper = (M / 128) >> 3, per = mper * nNt;
    for (int lt = lb; lt < per; lt += G8) {
        const int grp = lt / (8 * nNt), q = lt - grp * 8 * nNt, gs = (mper - grp * 8) < 8 ? (mper - grp * 8) : 8;
        const int tn = q / gs, tm = xcd * mper + grp * 8 + (q - tn * gs);
        const bf16_t* Ag = A + (size_t)(tm * 128 + lr) * lda + lc * 8;
        const bf16_t* Bg = Bt + (size_t)(tn * 128 + lr) * ldb + lc * 8;
        f32x16 acc[2][2];
#pragma unroll
        for (int i = 0; i < 2; ++i)
#pragma unroll
            for (int j = 0; j < 2; ++j)
#pragma unroll
                for (int r = 0; r < 16; ++r) acc[i][j][r] = 0.f;
        u32x4 ra0[4], rb0[4], ra1[4], rb1[4];
#define G_LOAD(RA, RB, KT) { _Pragma("unroll") for (int i = 0; i < 4; ++i) { RA[i] = *(const u32x4*)(Ag + (size_t)(32 * i) * lda + (KT) * 64); RB[i] = *(const u32x4*)(Bg + (size_t)(32 * i) * ldb + (KT) * 64); } }
#define G_STORE(RA, RB, BUF) { _Pragma("unroll") for (int i = 0; i < 4; ++i) { *(u32x4*)((BUF) + swz(lr + 32 * i, lc)) = RA[i]; *(u32x4*)((BUF) + 16384 + swz(lr + 32 * i, lc)) = RB[i]; } }
#define G_COMPUTE(BUF) { _Pragma("unroll") for (int ks = 0; ks < 4; ++ks) { bf16x8 af[2], bfr[2]; \
            _Pragma("unroll") for (int i = 0; i < 2; ++i) { af[i] = *(const bf16x8*)((BUF) + swz(wm * 64 + i * 32 + l31, 2 * ks + lh)); bfr[i] = *(const bf16x8*)((BUF) + 16384 + swz(wn * 64 + i * 32 + l31, 2 * ks + lh)); } \
            _Pragma("unroll") for (int i = 0; i < 2; ++i) _Pragma("unroll") for (int j = 0; j < 2; ++j) acc[i][j] = MFMA32(af[i], bfr[j], acc[i][j]); } }
        G_LOAD(ra0, rb0, 0)
        if (nk > 1) G_LOAD(ra1, rb1, 1)
        G_STORE(ra0, rb0, lds)
        __syncthreads();
        for (int kt = 0; kt < nk; kt += 2) {
            if (kt + 2 < nk) G_LOAD(ra0, rb0, kt + 2)
            G_COMPUTE(lds)
            if (kt + 1 < nk) G_STORE(ra1, rb1, lds + 32768)
            __syncthreads();
            if (kt + 1 < nk) {
                if (kt + 3 < nk) G_LOAD(ra1, rb1, kt + 3)
                G_COMPUTE(lds + 32768)
                if (kt + 2 < nk) G_STORE(ra0, rb0, lds)
                __syncthreads();
            }
        }
#undef G_LOAD
#undef G_STORE
#undef G_COMPUTE
        int lane_e = lane; asm volatile("" : "+v"(lane_e));
        epi.template operator()<2>(acc, tm * 128 + wm * 64, tn * 128 + wn * 64, lane_e);
    }
}

template <class Epi>
DI void gemm256_phase(const bf16_t* __restrict__ A, int lda, const bf16_t* __restrict__ Bt, int ldb, int M, int N, int K, const Epi& epi, unsigned char* lds, int vb = -1, int vn = 0) {
    const int tid = otid(), lane = tid & 63, wave = tid >> 6, wm = wave >> 1, wn = wave & 1;
    const int nNt = N / 256, nk = K / 64;
    const int lr = tid >> 3, lc = tid & 7, l31 = lane & 31, lh = lane >> 5;
    const int bix = vb >= 0 ? vb : (int)blockIdx.x, nbl = vb >= 0 ? vn : (int)gridDim.x;
    const int G8 = nbl >> 3, xcd = bix & 7, lb = bix >> 3, mper = (M / 128) >> 3, per = mper * nNt;
    const unsigned c0 = (unsigned)(lh ^ ((l31 >> 1) & 7)), roA = (unsigned)(wm * 8192 + l31 * 128), roB = (unsigned)(16384 + wn * 16384 + l31 * 128);
    for (int lt = lb; lt < per; lt += G8) {
        const int grp = lt / (8 * nNt), q = lt - grp * 8 * nNt, gs = (mper - grp * 8) < 8 ? (mper - grp * 8) : 8;
        const int tn = q / gs, tm = xcd * mper + grp * 8 + (q - tn * gs);
        const bf16_t* Au = A + (size_t)(tm * 128) * lda;
        const bf16_t* Bu = Bt + (size_t)(tn * 256) * ldb;
        const unsigned voA = (unsigned)(lr * lda + lc * 8), voB = (unsigned)(lr * ldb + lc * 8);
        f32x16 acc[2][4];
#pragma unroll
        for (int i = 0; i < 2; ++i)
#pragma unroll
            for (int j = 0; j < 4; ++j)
#pragma unroll
                for (int r = 0; r < 16; ++r) acc[i][j][r] = 0.f;
        u32x4 ra[4], rb[8];
#pragma unroll
        for (int i = 0; i < 4; ++i) ra[i] = *(const u32x4*)((Au + (size_t)(32 * i) * lda) + voA);
#pragma unroll
        for (int i = 0; i < 8; ++i) rb[i] = *(const u32x4*)((Bu + (size_t)(32 * i) * ldb) + voB);
        for (int kt = 0; kt < nk; ++kt) {
#pragma unroll
            for (int i = 0; i < 4; ++i) *(u32x4*)(lds + swz(lr + 32 * i, lc)) = ra[i];
#pragma unroll
            for (int i = 0; i < 8; ++i) *(u32x4*)(lds + 16384 + swz(lr + 32 * i, lc)) = rb[i];
            __syncthreads();
            if (kt + 1 < nk) {
#pragma unroll
                for (int i = 0; i < 4; ++i) ra[i] = *(const u32x4*)((Au + (size_t)(32 * i) * lda + (kt + 1) * 64) + voA);
#pragma unroll
                for (int i = 0; i < 8; ++i) rb[i] = *(const u32x4*)((Bu + (size_t)(32 * i) * ldb + (kt + 1) * 64) + voB);
            }
            __builtin_amdgcn_s_setprio(1);
#pragma unroll 2
            for (int ks = 0; ks < 4; ++ks) {
                bf16x8 af[2], bfr[4];
                const unsigned xo = (c0 ^ (unsigned)(2 * ks)) << 4;
#pragma unroll
                for (int i = 0; i < 2; ++i) af[i] = *(const bf16x8*)(lds + (roA + xo) + i * 4096);
#pragma unroll
                for (int j = 0; j < 4; ++j) bfr[j] = *(const bf16x8*)(lds + (roB + xo) + j * 4096);
#pragma unroll
                for (int i = 0; i < 2; ++i)
#pragma unroll
                    for (int j = 0; j < 4; ++j) acc[i][j] = MFMA32(af[i], bfr[j], acc[i][j]);
            }
            __builtin_amdgcn_s_setprio(0);
            __syncthreads();
        }
        int lane_e = lane; asm volatile("" : "+v"(lane_e));
        epi.template operator()<4>(acc, tm * 128 + wm * 64, tn * 256 + wn * 128, lane_e);
    }
}

DI int cu(int r) { return (r & 3) + 8 * (r >> 2); }
struct EpiStoreBf16 {
    bf16_t* C; int ldc;
    template <int NI> DI void operator()(const f32x16 (&acc)[2][NI], int row0, int col0, int lane) const {
        if (col0 >= ldc) return;
        const unsigned lo = (unsigned)(4 * (lane >> 5) * ldc + (lane & 31));
        bf16_t* base = C + (size_t)row0 * ldc + col0;
#pragma unroll
        for (int mi = 0; mi < 2; ++mi)
#pragma unroll
            for (int ni = 0; ni < NI; ++ni)
#pragma unroll
                for (int r = 0; r < 16; ++r) (base + (size_t)(32 * mi + cu(r)) * ldc + 32 * ni)[lo] = f2bf(acc[mi][ni][r]);
    }
};
struct EpiResidual {
    const float* srcL; const float* srcC; float* dstL; float* dstC; const float* mod; int gate_idx;
    template <int NI> DI void operator()(const f32x16 (&acc)[2][NI], int row0, int col0, int lane) const {
        const bool lat = row0 < NLAT;
        const float* src = (lat ? srcL + (size_t)row0 * DM : srcC + (size_t)(row0 - NLAT) * DM) + col0;
        float* dst = (lat ? dstL + (size_t)row0 * DM : dstC + (size_t)(row0 - NLAT) * DM) + col0;
        const float* g = mod + ((lat ? (row0 >> 13) : 8) * 6 + gate_idx) * 1024 + col0;
        const unsigned l31 = lane & 31, lo = (unsigned)(4 * (lane >> 5) * DM) + l31;
#pragma unroll
        for (int ni = 0; ni < NI; ++ni) {
            const float gv = (g + 32 * ni)[l31];
            float sv[32];
#pragma unroll
            for (int q = 0; q < 32; ++q) sv[q] = (src + (32 * (q >> 4) + cu(q & 15)) * DM + 32 * ni)[lo];
#pragma unroll
            for (int q = 0; q < 32; ++q) (dst + (32 * (q >> 4) + cu(q & 15)) * DM + 32 * ni)[lo] = sv[q] + gv * acc[q >> 4][ni][q & 15];
            asm volatile("" ::: "memory");
        }
    }
};
struct EpiInprojL0 {
    bf16_t* C; const float* qgain; const float* ct; const float* st; const float* kgain; bf16_t* KB; bf16_t* VT;
    template <int NI> DI void operator()(const f32x16 (&acc)[2][NI], int row0, int col0, int lane) const {
        const int l31 = lane & 31, lh = lane >> 5;
        const unsigned lo = (unsigned)(4 * lh * 1536 + l31);
        bf16_t* base = C + (size_t)row0 * 1536 + col0;
        const bool lat = row0 < NLAT;
        const int tlane = (row0 & 8191) + 4 * lh;
        if (col0 >= 1024) {
            const int j = (col0 - 1024) >> 7;
            const int bb = lat ? (row0 >> 13) : ((row0 - NLAT) >> 8), pos0 = lat ? (row0 & 8191) : SEQ + ((row0 - NLAT) & 255);
            if (j & 1) {
#pragma unroll
                for (int hp = 0; hp < NI / 2; ++hp) {
                    bf16_t* vb = VT + ((size_t)(bb * 4 + 2 * (j >> 1) + hp) * 64) * KVLEN + pos0;
                    const unsigned vlo = (unsigned)(l31 * KVLEN + 8 * lh);
#pragma unroll
                    for (int mi = 0; mi < 2; ++mi)
#pragma unroll
                        for (int g = 0; g < 4; ++g) {
                            bf16_t* p = vb + 16 * (2 * mi + (g >> 1)) + 4 * (g & 1);
                            u32x2 w1, w2;
                            w1.x = pk2(acc[mi][2 * hp][4 * g], acc[mi][2 * hp][4 * g + 1]); w1.y = pk2(acc[mi][2 * hp][4 * g + 2], acc[mi][2 * hp][4 * g + 3]);
                            w2.x = pk2(acc[mi][2 * hp + 1][4 * g], acc[mi][2 * hp + 1][4 * g + 1]); w2.y = pk2(acc[mi][2 * hp + 1][4 * g + 2], acc[mi][2 * hp + 1][4 * g + 3]);
                            *(u32x2*)(p + vlo) = w1; *(u32x2*)(p + (size_t)32 * KVLEN + vlo) = w2;
                        }
                }
                return;
            }
            const bool isBk = j == 2;
            const float kg1 = kgain[l31], kg2 = kgain[l31 + 32];
            const unsigned klo = (unsigned)(4 * lh * 64 + l31);
#pragma unroll
            for (int mi = 0; mi < 2; ++mi)
#pragma unroll
                for (int r = 0; r < 16; ++r) {
                    float c = 1.f, sn = 0.f;
                    if (lat) { const int t = tlane + 32 * mi + cu(r); const int pos = l31 < 16 ? (t >> 6) : (t & 63); c = ct[pos * 16 + (l31 & 15)]; sn = st[pos * 16 + (l31 & 15)]; }
#pragma unroll
                    for (int hp = 0; hp < NI / 2; ++hp) {
                        float x1 = acc[mi][2 * hp][r], x2 = acc[mi][2 * hp + 1][r];
                        if (isBk) {
                            float ss = x1 * x1 + x2 * x2;
#pragma unroll
                            for (int o = 16; o > 0; o >>= 1) ss += __shfl_xor(ss, o);
                            const float rs = rsqrtf(ss * (1.0f / 64.0f) + EPS);
                            x1 = x1 * rs * kg1; x2 = x2 * rs * kg2;
                        }
                        const float o1 = x1 * c - x2 * sn, o2 = x2 * c + x1 * sn;
                        bf16_t* p = KB + ((size_t)(bb * 4 + 2 * (j >> 1) + hp) * KVLEN + pos0 + 32 * mi + cu(r)) * 64;
                        p[klo] = f2bf(o1); (p + 32)[klo] = f2bf(o2);
                    }
                }
            return;
        }
        const bool isB = col0 >= 512;
        const float g1 = qgain[l31], g2 = qgain[l31 + 32];
#pragma unroll
        for (int mi = 0; mi < 2; ++mi)
#pragma unroll
            for (int r = 0; r < 16; ++r) {
                float c = 1.f, sn = 0.f;
                if (lat) { const int t = tlane + 32 * mi + cu(r); const int pos = l31 < 16 ? (t >> 6) : (t & 63); c = ct[pos * 16 + (l31 & 15)]; sn = st[pos * 16 + (l31 & 15)]; }
#pragma unroll
                for (int hp = 0; hp < NI / 2; ++hp) {
                    float x1 = acc[mi][2 * hp][r], x2 = acc[mi][2 * hp + 1][r];
                    if (isB) {
                        float ss = x1 * x1 + x2 * x2;
#pragma unroll
                        for (int o = 16; o > 0; o >>= 1) ss += __shfl_xor(ss, o);
                        const float rs = rsqrtf(ss * (1.0f / 64.0f) + EPS);
                        x1 = x1 * rs * g1; x2 = x2 * rs * g2;
                    }
                    const float o1 = x1 * c - x2 * sn, o2 = x2 * c + x1 * sn;
                    bf16_t* p = base + (size_t)(32 * mi + cu(r)) * 1536 + 64 * hp;
                    p[lo] = f2bf(o1 * QSCALE); (p + 32)[lo] = f2bf(o2 * QSCALE);
                }
            }
    }
};
struct EpiSwiglu {
    bf16_t* Hd;
    template <int NI> DI void operator()(const f32x16 (&acc)[2][NI], int row0, int col0, int lane) const {
        const unsigned lo = (unsigned)(4 * (lane >> 5) * FFH + (lane & 31));
        bf16_t* base = Hd + (size_t)row0 * FFH + (col0 >> 1);
#pragma unroll
        for (int pr = 0; pr < NI / 2; ++pr)
#pragma unroll
            for (int mi = 0; mi < 2; ++mi)
#pragma unroll
                for (int r = 0; r < 16; ++r) { const float g = acc[mi][2 * pr][r], u = acc[mi][2 * pr + 1][r]; (base + (32 * mi + cu(r)) * FFH + 32 * pr)[lo] = f2bf(g * sigmoidf_(g) * u); }
    }
};
struct EpiGateMul {
    bf16_t* Y;
    template <int NI> DI void operator()(const f32x16 (&acc)[2][NI], int row0, int col0, int lane) const {
        const unsigned lo = (unsigned)(4 * (lane >> 5) * DM + (lane & 31));
        bf16_t* base = Y + (size_t)row0 * DM + col0;
#pragma unroll
        for (int mi = 0; mi < 2; ++mi)
#pragma unroll
            for (int ni = 0; ni < NI; ++ni)
#pragma unroll
                for (int r = 0; r < 16; ++r) { bf16_t* p = base + (32 * mi + cu(r)) * DM + 32 * ni; p[lo] = f2bf(bf2f(p[lo]) * acc[mi][ni][r]); }
    }
};

DI void transpose_tile(const float* __restrict__ W, int ldw, int K, bf16_t* __restrict__ Wt, int k0, int n0, int ffn_map, float* t  ) {
    const int tid = otid();
    {
        const int n = tid & 63; int src = n0 + n;
        if (ffn_map) { const int np = n0 + n; const int j32 = np >> 6, s = (np >> 5) & 1, i = np & 31; src = s * FFH + j32 * 32 + i; }
#pragma unroll
        for (int i = 0; i < 16; ++i) { const int k = i * 4 + (tid >> 6); t[k * 65 + n] = W[(size_t)(k0 + k) * ldw + src]; }
    }
    __syncthreads();
#pragma unroll
    for (int i = 0; i < 2; ++i) {
        const int n = (tid >> 3) + 32 * i, kc = tid & 7;
        u32x4 v;
        v.x = pk2(t[(kc * 8 + 0) * 65 + n], t[(kc * 8 + 1) * 65 + n]); v.y = pk2(t[(kc * 8 + 2) * 65 + n], t[(kc * 8 + 3) * 65 + n]);
        v.z = pk2(t[(kc * 8 + 4) * 65 + n], t[(kc * 8 + 5) * 65 + n]); v.w = pk2(t[(kc * 8 + 6) * 65 + n], t[(kc * 8 + 7) * 65 + n]);
        *(u32x4*)(Wt + (size_t)(n0 + n) * K + k0 + kc * 8) = v;
    }
    __syncthreads();
}
DI void prep_phase(const Params& P, unsigned char* lds) {
    float* t = (float*)lds;
    unsigned char* ws = P.ws;
    for (int j = blockIdx.x; j < 5880; j += gridDim.x) {
        const float* W; int ldw, K, Nout, map = 0, jj = j; bf16_t* Wt;
        if (jj < 384) { W = P.ab_w_in; ldw = 1536; K = 1024; Nout = 1536; Wt = (bf16_t*)(ws + OFF_WAB_IN); }
        else if ((jj -= 384) < 256) { W = P.ab_w_out; ldw = 1024; K = 1024; Nout = 1024; Wt = (bf16_t*)(ws + OFF_WAB_OUT); }
        else if ((jj -= 256) < 736) { W = P.cd_w_in; ldw = CDIN; K = 1024; Nout = CDIN; Wt = (bf16_t*)(ws + OFF_WCD_IN); }
        else if ((jj -= 736) < 256) { W = P.cd_w_out; ldw = 1024; K = 1024; Nout = 1024; Wt = (bf16_t*)(ws + OFF_WCD_OUT); }
        else if ((jj -= 256) < 2816) { const int l = jj / 1408; jj -= l * 1408; W = P.ffn_w_in + (size_t)l * 1024 * 5632; ldw = 5632; K = 1024; Nout = 5632; map = 1; Wt = (bf16_t*)(ws + OFF_WFFN_IN + l * WFFN_IN_SZ); }
        else if ((jj -= 2816) < 1408) { const int l = jj / 704; jj -= l * 704; W = P.ffn_w_out + (size_t)l * FFH * 1024; ldw = 1024; K = FFH; Nout = 1024; Wt = (bf16_t*)(ws + OFF_WFFN_OUT + l * WFFN_OUT_SZ); }
        else { jj -= 1408; W = P.cd_g2; ldw = 768; K = 128; Nout = 768; Wt = (bf16_t*)(ws + OFF_WG2); }
        const int nNt = Nout / 64; const int kt = jj / nNt, nt = jj - kt * nNt;
        transpose_tile(W, ldw, K, Wt, kt * 64, nt * 64, map, t);
    }
    float* MODP = (float*)(ws + OFF_MODP);
    for (int j = blockIdx.x; j < 384; j += gridDim.x) {
        const int l = j / 192, r2 = j % 192, ks = r2 / 24, cb = r2 % 24;
        const int tid = otid();
        __syncthreads();
        for (int e = tid; e < 9 * 128; e += 256) { const int r = e >> 7, kk = e & 127; const float v = r < 8 ? P.c[r * 1024 + ks * 128 + kk] : P.c_ctx[ks * 128 + kk]; t[e] = v * sigmoidf_(v); }
        __syncthreads();
        const int col = cb * 256 + tid;
        const float* w = P.ada_w + ((size_t)l * 1024 + ks * 128) * 6144 + col;
        float a[9];
#pragma unroll
        for (int r = 0; r < 9; ++r) a[r] = 0.f;
#pragma unroll 4
        for (int kk = 0; kk < 128; ++kk) { const float wv = w[(size_t)kk * 6144];
#pragma unroll
            for (int r = 0; r < 9; ++r) a[r] += t[r * 128 + kk] * wv; }
#pragma unroll
        for (int r = 0; r < 9; ++r) MODP[((size_t)(ks * 2 + l) * 9 + r) * 6144 + col] = a[r];
    }
    if (blockIdx.x == 0) {
        float* ct = (float*)(ws + OFF_ROPE); float* st = ct + 2048;
        for (int e = otid(); e < 2048; e += 256) {
            const int pos = e >> 4, j = e & 15;
            const float inv = exp2f(-(float)j * (13.287712379549449f / 16.0f));
            const float ang = (float)pos * inv;
            double rev = (double)ang * 0.15915494309189535; rev -= floor(rev);
            const float rv = (float)rev;
            ct[e] = __builtin_amdgcn_cosf(rv); st[e] = __builtin_amdgcn_sinf(rv);
        }
    }
}
DI void modfinal_phase(const Params& P) {
    const float* MODP = (const float*)(P.ws + OFF_MODP); float* MOD = (float*)(P.ws + OFF_MOD);
    for (int e = blockIdx.x * 256 + otid(); e < 2 * 9 * 6144; e += gridDim.x * 256) {
        const int l = e / (9 * 6144), col = e % 6144;
        float s = P.ada_b[l * 6144 + col];
#pragma unroll
        for (int ks = 0; ks < 8; ++ks) s += MODP[(size_t)ks * (2 * 9 * 6144) + e];
        MOD[e] = s;
    }
}

DI void rownorm_phase(const float* srcL, const float* srcC, int M, const float* __restrict__ gain, const float* __restrict__ mod, int shift_idx, int scale_idx, bf16_t* __restrict__ H) {
    const int lane = otid() & 63, wave = otid() >> 6;
    for (int row = blockIdx.x * 4 + wave; row < M; row += gridDim.x * 4) {
        const bool lat = row < NLAT;
        const float* src = lat ? srcL + (size_t)row * DM : srcC + (size_t)(row - NLAT) * DM;
        const float* mrow = mod + (lat ? (row >> 13) : 8) * 6144;
        f32x4 v[4]; float ss = 0.f;
#pragma unroll
        for (int i = 0; i < 4; ++i) { v[i] = *(const f32x4*)(src + (i * 64 + lane) * 4); ss += v[i].x * v[i].x + v[i].y * v[i].y + v[i].z * v[i].z + v[i].w * v[i].w; }
#pragma unroll
        for (int o = 32; o > 0; o >>= 1) ss += __shfl_xor(ss, o);
        const float rs = rsqrtf(ss * (1.0f / 1024.0f) + EPS);
#pragma unroll
        for (int i = 0; i < 4; ++i) {
            const int col = (i * 64 + lane) * 4;
            const f32x4 g = *(const f32x4*)(gain + col), sc = *(const f32x4*)(mrow + scale_idx * 1024 + col), sh = *(const f32x4*)(mrow + shift_idx * 1024 + col);
            const f32x4 y = (v[i] * rs * g) * (sc + 1.0f) + sh;
            u32x2 o; o.x = pk2(y.x, y.y); o.y = pk2(y.z, y.w);
            *(u32x2*)(H + (size_t)row * DM + col) = o;
        }
    }
}
DI void finalnorm_phase(const Params& P) {
    const int lane = otid() & 63, wave = otid() >> 6;
    for (int row = blockIdx.x * 4 + wave; row < NLAT; row += gridDim.x * 4) {
        float* src = P.out + (size_t)row * DM;
        f32x4 v[4]; float ss = 0.f;
#pragma unroll
        for (int i = 0; i < 4; ++i) { v[i] = *(const f32x4*)(src + (i * 64 + lane) * 4); ss += v[i].x * v[i].x + v[i].y * v[i].y + v[i].z * v[i].z + v[i].w * v[i].w; }
#pragma unroll
        for (int o = 32; o > 0; o >>= 1) ss += __shfl_xor(ss, o);
        const float rs = rsqrtf(ss * (1.0f / 1024.0f) + EPS);
#pragma unroll
        for (int i = 0; i < 4; ++i) { const int col = (i * 64 + lane) * 4; *(f32x4*)(src + col) = v[i] * rs * *(const f32x4*)(P.final_gain + col); }
    }
}

DI void qkprep_phase(const Params& P) {
    bf16_t* PL = (bf16_t*)(P.ws + OFF_PL0); bf16_t* KB = (bf16_t*)(P.ws + OFF_KB); bf16_t* VT = (bf16_t*)(P.ws + OFF_VT);
    const float* ct = (const float*)(P.ws + OFF_ROPE); const float* st = ct + 2048;
    const int tid = otid(), hw = tid >> 5, i = tid & 31;
    for (int unit = blockIdx.x; unit < NTOK / 64; unit += gridDim.x) {
        const int row0 = unit * 64; const bool lat = row0 < NLAT;
        const int b = lat ? (row0 >> 13) : ((row0 - NLAT) >> 8);
        const int pos0 = lat ? (row0 & 8191) : SEQ + ((row0 - NLAT) & 255);
        for (int it = 0; it < 8; ++it) {
            float xa[4], xb[4];
#pragma unroll
            for (int u = 0; u < 4; ++u) {
                const int task = hw + 8 * (4 * it + u); const int tok = task >> 2, slot = 16 + (task & 3);
                const int col = slot < 16 ? slot * 64 : (slot < 18 ? 1024 + (slot - 16) * 64 : 1280 + (slot - 18) * 64);
                const bf16_t* p = PL + (size_t)(row0 + tok) * 1536 + col;
                xa[u] = bf2f(p[i]); xb[u] = bf2f(p[i + 32]);
            }
#pragma unroll
            for (int u = 0; u < 4; ++u) {
                const int task = hw + 8 * (4 * it + u); const int tok = task >> 2, slot = 16 + (task & 3);
                const int col = slot < 16 ? slot * 64 : (slot < 18 ? 1024 + (slot - 16) * 64 : 1280 + (slot - 18) * 64);
                bf16_t* p = PL + (size_t)(row0 + tok) * 1536 + col;
                float x1 = xa[u], x2 = xb[u];
                const bool isB = (slot >= 8 && slot < 16) || slot >= 18;
                if (isB) {
                    float ss = x1 * x1 + x2 * x2;
#pragma unroll
                    for (int o = 16; o > 0; o >>= 1) ss += __shfl_xor(ss, o);
                    const float rs = rsqrtf(ss * (1.0f / 64.0f) + EPS);
                    const float* g = slot < 16 ? P.ab_q_gain : P.ab_k_gain;
                    x1 = x1 * rs * g[i]; x2 = x2 * rs * g[i + 32];
                }
                if (lat) {
                    const int t = pos0 + tok; const int pos = i < 16 ? (t >> 6) : (t & 63);
                    const float c = ct[pos * 16 + (i & 15)], sn = st[pos * 16 + (i & 15)];
                    const float o1 = x1 * c - x2 * sn, o2 = x2 * c + x1 * sn; x1 = o1; x2 = o2;
                }
                if (slot < 16) { p[i] = f2bf(x1 * QSCALE); p[i + 32] = f2bf(x2 * QSCALE); }
                else { bf16_t* kp = KB + ((size_t)(b * 4 + (slot - 16)) * KVLEN + pos0 + tok) * 64; kp[i] = f2bf(x1); kp[i + 32] = f2bf(x2); }
            }
        }
        const int d = tid & 63, tg = tid >> 6;
#pragma unroll
        for (int vs = 0; vs < 4; ++vs) {
            const int col = 1024 + (vs < 2 ? 128 + vs * 64 : 384 + (vs - 2) * 64);
            const bf16_t* src = PL + (size_t)(row0 + 16 * tg) * 1536 + col + d;
            unsigned v[16];
#pragma unroll
            for (int j = 0; j < 16; ++j) v[j] = src[(size_t)j * 1536];
            u32x4 a, bq;
            a.x = v[0] | (v[1] << 16); a.y = v[2] | (v[3] << 16); a.z = v[8] | (v[9] << 16); a.w = v[10] | (v[11] << 16);
            bq.x = v[4] | (v[5] << 16); bq.y = v[6] | (v[7] << 16); bq.z = v[12] | (v[13] << 16); bq.w = v[14] | (v[15] << 16);
            bf16_t* dst = VT + ((size_t)(b * 4 + vs) * 64 + d) * KVLEN + pos0 + 16 * tg;
            *(u32x4*)dst = a; *(u32x4*)(dst + 8) = bq;
        }
    }
}

DI void attn_phase(const Params& P, unsigned char* lds) {
    const bf16_t* PL = (const bf16_t*)(P.ws + OFF_PL0); const bf16_t* KB = (const bf16_t*)(P.ws + OFF_KB); const bf16_t* VT = (const bf16_t*)(P.ws + OFF_VT);
    bf16_t* Y = (bf16_t*)(P.ws + OFF_H);
    const int tid = otid(), lane = tid & 63, wave = tid >> 6, l31 = lane & 31, lh = lane >> 5;
    const int lr = tid >> 3, lc = tid & 7;
    for (int unit = blockIdx.x; unit < 8448; unit += gridDim.x) {
        int b, hq, kvh, qrow0, nW, wlo, qpos0 = 0; bool masked = false, has_sink;
        if (unit < 8192) {
            const int u = unit & 4095; b = u >> 9; const int r = u & 511, kvl = r >> 8, hl = (r >> 6) & 3, qb = r & 63;
            qrow0 = b * SEQ + qb * 128; qpos0 = qb * 128;
            if (unit < 4096) { hq = 8 + kvl * 4 + hl; kvh = 2 + kvl; nW = 132; wlo = 0; has_sink = false; }
            else { hq = kvl * 4 + hl; kvh = kvl; masked = true; has_sink = true;
                   const int s0 = qpos0 - 128 < 0 ? 0 : qpos0 - 128, s1 = qpos0 + 256 > SEQ ? SEQ : qpos0 + 256; wlo = s0 >> 6; nW = (s1 >> 6) - wlo; }
        } else { const int u = unit - 8192; b = u >> 5; hq = (u >> 1) & 15; const int qb = u & 1; kvh = hq < 8 ? (hq >> 2) : 2 + ((hq - 8) >> 2);
                 qrow0 = NLAT + b * CTXL + qb * 128; nW = 0; wlo = 0; has_sink = hq < 8; }
        const int nt = masked ? nW + 4 : (nW ? nW : 4);
        const int qrow = qrow0 + 32 * wave + l31;
        const int qpos = qpos0 + 32 * wave + l31;
        bf16x8 qf[4];
        { const bf16_t* qp = PL + (size_t)qrow * 1536 + hq * 64 + 8 * lh;
#pragma unroll
          for (int ks = 0; ks < 4; ++ks) qf[ks] = *(const bf16x8*)(qp + 16 * ks); }
        f32x16 o[2];
#pragma unroll
        for (int r = 0; r < 16; ++r) { o[0][r] = 0.f; o[1][r] = 0.f; }
        float m = -1e30f, l = 0.f;
        const bf16_t* kbase = KB + (size_t)(b * 4 + kvh) * KVLEN * 64;
        const bf16_t* vbase = VT + (size_t)(b * 4 + kvh) * 64 * KVLEN;
        u32x4 rk[2], rv[2];
        auto tile_of = [&](int i) __attribute__((always_inline)) { return (masked && i >= nW) ? 128 + (i - nW) : wlo + i + ((!masked && nW == 0) ? 128 : 0); };
        {
            const int p0 = tile_of(0) * 64;
#pragma unroll
            for (int j = 0; j < 2; ++j) { rk[j] = *(const u32x4*)(kbase + (size_t)(p0 + lr + 32 * j) * 64 + lc * 8); rv[j] = *(const u32x4*)(vbase + (size_t)(lr + 32 * j) * KVLEN + p0 + lc * 8); }
#pragma unroll
            for (int j = 0; j < 2; ++j) { *(u32x4*)(lds + swz(lr + 32 * j, lc)) = rk[j]; *(u32x4*)(lds + 8192 + swz(lr + 32 * j, lc)) = rv[j]; }
        }
        __syncthreads();
        for (int i = 0; i < nt; ++i) {
            unsigned char* cur = lds + (i & 1) * 16384; unsigned char* nxt = lds + ((i + 1) & 1) * 16384;
            const int p0 = tile_of(i) * 64; const bool more = i + 1 < nt;
            if (more) { const int p1 = tile_of(i + 1) * 64;
#pragma unroll
                for (int j = 0; j < 2; ++j) { rk[j] = *(const u32x4*)(kbase + (size_t)(p1 + lr + 32 * j) * 64 + lc * 8); rv[j] = *(const u32x4*)(vbase + (size_t)(lr + 32 * j) * KVLEN + p1 + lc * 8); } }
            const bool wtile = masked && i < nW;
            bool active = true;
            if (wtile) { const int qmin = qpos0 + 32 * wave; active = (p0 <= qmin + 31 + 128) && (p0 + 63 >= qmin - 128); }
            if (active) {
                f32x16 s[2];
                __builtin_amdgcn_s_setprio(1);
#pragma unroll
                for (int kt = 0; kt < 2; ++kt) {
#pragma unroll
                    for (int r = 0; r < 16; ++r) s[kt][r] = 0.f;
#pragma unroll
                    for (int ks = 0; ks < 4; ++ks) { const bf16x8 kf = *(const bf16x8*)(cur + swz(32 * kt + l31, 2 * ks + lh)); s[kt] = MFMA32(kf, qf[ks], s[kt]); }
                }
                __builtin_amdgcn_s_setprio(0);
                if (wtile) {
#pragma unroll
                    for (int kt = 0; kt < 2; ++kt)
#pragma unroll
                        for (int r = 0; r < 16; ++r) { const int kp = p0 + 32 * kt + crow(r, lh); const int dlt = qpos - kp; if (dlt > 128 || dlt < -128) s[kt][r] = -INFINITY; }
                }
                float mx = s[0][0];
#pragma unroll
                for (int kt = 0; kt < 2; ++kt)
#pragma unroll
                    for (int r = 0; r < 16; ++r) mx = fmaxf(mx, s[kt][r]);
                mx = fmaxf(mx, __shfl_xor(mx, 32));
                const float mn = (mx > m + 8.0f) ? mx : m;
                if (__builtin_amdgcn_ballot_w64(mn != m) != 0ull) {
                    const float alpha = __builtin_amdgcn_exp2f(m - mn);
                    l *= alpha;
#pragma unroll
                    for (int r = 0; r < 16; ++r) { o[0][r] *= alpha; o[1][r] *= alpha; }
                    m = mn;
                }
                float ps = 0.f;
#pragma unroll
                for (int kt = 0; kt < 2; ++kt)
#pragma unroll
                    for (int r = 0; r < 16; ++r) { const float pv = __builtin_amdgcn_exp2f(s[kt][r] - mn); s[kt][r] = pv; ps += pv; }
                l += ps;
                __builtin_amdgcn_s_setprio(1);
#pragma unroll
                for (int kt = 0; kt < 2; ++kt)
#pragma unroll
                    for (int sx = 0; sx < 2; ++sx) {
                        union { u32x4 u; bf16x8 h; } pf;
                        pf.u.x = pk2(s[kt][8 * sx + 0], s[kt][8 * sx + 1]); pf.u.y = pk2(s[kt][8 * sx + 2], s[kt][8 * sx + 3]);
                        pf.u.z = pk2(s[kt][8 * sx + 4], s[kt][8 * sx + 5]); pf.u.w = pk2(s[kt][8 * sx + 6], s[kt][8 * sx + 7]);
#pragma unroll
                        for (int dt = 0; dt < 2; ++dt) { const bf16x8 vf = *(const bf16x8*)(cur + 8192 + swz(32 * dt + l31, 2 * (2 * kt + sx) + lh)); o[dt] = MFMA32(vf, pf.h, o[dt]); }
                    }
                __builtin_amdgcn_s_setprio(0);
            }
            if (more) {
#pragma unroll
                for (int j = 0; j < 2; ++j) { *(u32x4*)(nxt + swz(lr + 32 * j, lc)) = rk[j]; *(u32x4*)(nxt + 8192 + swz(lr + 32 * j, lc)) = rv[j]; }
            }
            __syncthreads();
        }
        l += __shfl_xor(l, 32);
        if (has_sink) l += __builtin_amdgcn_exp2f(P.ab_sink[hq] * LOG2E - m);
        const float inv = 1.0f / l;
        bf16_t* yp = Y + (size_t)qrow * DM + hq * 64 + 4 * lh;
#pragma unroll
        for (int dt = 0; dt < 2; ++dt)
#pragma unroll
            for (int g = 0; g < 4; ++g) { u32x2 w; w.x = pk2(o[dt][4 * g] * inv, o[dt][4 * g + 1] * inv); w.y = pk2(o[dt][4 * g + 2] * inv, o[dt][4 * g + 3] * inv); *(u32x2*)(yp + 32 * dt + 8 * g) = w; }
    }
}

DI float mix1(const bf16_t* p, bool hp, bool hn, float mu) {
    const float x = bf2f(p[0]); const float xp = hp ? bf2f(*(p - CDIN)) : 0.f; const float xn = hn ? bf2f(*(p + CDIN)) : 0.f;
    return x + (0.5f * (xp + xn) - x) * mu;
}
DI void mix8(const bf16_t* p, bool hp, bool hn, const float (&mu)[8], float (&o)[8]) {
    const u32x4 z = {0u, 0u, 0u, 0u};
    const u32x4 x = *(const u32x4*)p; const u32x4 xp = hp ? *(const u32x4*)(p - CDIN) : z; const u32x4 xn = hn ? *(const u32x4*)(p + CDIN) : z;
#pragma unroll
    for (int i = 0; i < 4; ++i) {
        const float a0 = lo16(x[i]), a1 = hi16(x[i]);
        o[2 * i] = a0 + (0.5f * (lo16(xp[i]) + lo16(xn[i])) - a0) * mu[2 * i];
        o[2 * i + 1] = a1 + (0.5f * (hi16(xp[i]) + hi16(xn[i])) - a1) * mu[2 * i + 1];
    }
}
template <int MODE>
DI void scan_chain(const Params& P, int chain, unsigned char* lds) {
    const int otid_ = otid(); const int lane = otid_ & 63, wave = (otid_ >> 6) ^ (((((int)blockIdx.x >> 8) ^ (int)blockIdx.x) & 1) ? 2 : 0), tid = wave * 64 + lane;
    const int half = chain & 1, chn = chain >> 1;
    const int b = chn / 24, rem = chn % 24, h = rem >> 1, dir = rem & 1;
    const bf16_t* PL = (const bf16_t*)(P.ws + OFF_PL1);
    bf16_t* Yd = (bf16_t*)(P.ws + (dir ? OFF_YB : OFF_YF));
    float* BON = (float*)(P.ws + OFF_BONUS) + (size_t)dir * NLAT * 12;
    float* buf = (float*)lds;
    float* ybuf = buf + 2 * 6144;
    const int NCH = 528;
    f32x2 S0[4], S1[4];
#pragma unroll
    for (int j = 0; j < 4; ++j) { S0[j] = (f32x2){0.f, 0.f}; S1[j] = (f32x2){0.f, 0.f}; }
    const int q8 = lane & 7, r0 = 32 * half + 16 * (wave & 1) + (lane >> 3), r1 = r0 + 8;
    const int kg = lane >> 4, n16 = lane & 15;
    bf16x8 lf[4][2];
    if (wave >= 2) {
        const float* l2 = (wave == 2 ? P.cd_a2 : P.cd_w2) + (size_t)dir * 64 * 768;
#pragma unroll
        for (int nt = 0; nt < 4; ++nt)
#pragma unroll
            for (int ks = 0; ks < 2; ++ks) {
                union { u32x4 u; bf16x8 hh; } f; const float* s = l2 + (size_t)(32 * ks + 8 * kg) * 768 + 64 * h + 16 * nt + n16;
                f.u.x = pk2(s[0], s[768]); f.u.y = pk2(s[2 * 768], s[3 * 768]); f.u.z = pk2(s[4 * 768], s[5 * 768]); f.u.w = pk2(s[6 * 768], s[7 * 768]);
                lf[nt][ks] = f.hh;
            }
    }
    float* cw = buf + 13312 + (wave & 1) * 384;
    if (wave >= 2) {
        const int ch = lane;
        if (wave == 2) { cw[ch] = P.cd_a0[dir * 768 + 64 * h + ch]; cw[64 + ch] = P.cd_k_k[64 * h + ch]; cw[128 + ch] = P.cd_k_a[64 * h + ch]; cw[192 + ch] = P.cd_r_k[64 * h + ch];
                         cw[256 + ch] = P.cd_mu[768 + 64 * h + ch]; cw[320 + ch] = P.cd_mu[64 * h + ch]; }
        else { cw[ch] = P.cd_w0[dir * 768 + 64 * h + ch]; cw[256 + ch] = P.cd_mu[1536 + 64 * h + ch]; cw[320 + ch] = P.cd_mu[64 * h + ch]; }
        buf[13312 + 768 + (wave - 2) * 64 + ch] = P.cd_mu[(wave == 2 ? 2432 : 2304) + 64 * dir + ch];
        asm volatile("s_waitcnt lgkmcnt(0)" ::: "memory");
    }
    auto chunk_info = [&](int c, int& seqrow0, int& len, int& t0) __attribute__((always_inline)) {
        if (c < 16) { seqrow0 = NLAT + b * CTXL; len = CTXL; t0 = dir ? 240 - 16 * c : 16 * c; }
        else { const int cc = c - 16; seqrow0 = b * SEQ; len = SEQ; t0 = dir ? SEQ - 16 - 16 * cc : 16 * cc; }
    };
    u32x4 xr[3][2], ar[3][2];
    auto issue_loads = [&](int c) __attribute__((always_inline)) {
        int seqrow0, len, t0; chunk_info(c, seqrow0, len, t0);
        const u32x4 z4 = {0u, 0u, 0u, 0u};
        { const int tok = lane >> 2, cq = lane & 3, t = t0 + tok; const bool hp = t > 0, hn = t + 1 < len;
          const bf16_t* prow = PL + (size_t)(seqrow0 + t) * CDIN + 64 * h + 16 * cq + (wave == 2 ? 768 : 1536);
#pragma unroll
          for (int j = 0; j < 2; ++j) { xr[1][j] = *(const u32x4*)(prow + 8 * j); xr[0][j] = hp ? *(const u32x4*)(prow - CDIN + 8 * j) : z4; xr[2][j] = hn ? *(const u32x4*)(prow + CDIN + 8 * j) : z4; } }
        { const int ta = t0 + n16; const bool hpa = ta > 0, hna = ta + 1 < len;
          const bf16_t* p = PL + (size_t)(seqrow0 + ta) * CDIN + (wave == 2 ? 2432 : 2304) + 64 * dir + 8 * kg;
#pragma unroll
          for (int ks = 0; ks < 2; ++ks) { ar[1][ks] = *(const u32x4*)(p + 32 * ks); ar[0][ks] = hpa ? *(const u32x4*)(p - CDIN + 32 * ks) : z4; ar[2][ks] = hna ? *(const u32x4*)(p + CDIN + 32 * ks) : z4; } }
    };
    auto produce = [&](int c) __attribute__((always_inline)) {
        int seqrow0, len, t0; chunk_info(c, seqrow0, len, t0);
        float* bb = buf + (c & 1) * 6144;
        float* scr = buf + 14336 + (wave - 2) * 1024;
        const int tok = lane >> 2, cq = lane & 3, t = t0 + tok; const bool hp = t > 0, hn = t + 1 < len;
        const bf16_t* prow = PL + (size_t)(seqrow0 + t) * CDIN + 64 * h + 16 * cq;
        const int cb = 64 * h + 16 * cq;
        const int xcol = wave == 2 ? 768 : 1536;
        const u32x4 z4 = {0u, 0u, 0u, 0u};
        u32x4 rr_[3][2];
#pragma unroll
        for (int j = 0; j < 2; ++j) { rr_[1][j] = *(const u32x4*)(prow + 8 * j); rr_[0][j] = hp ? *(const u32x4*)(prow - CDIN + 8 * j) : z4; rr_[2][j] = hn ? *(const u32x4*)(prow + CDIN + 8 * j) : z4; }
        bf16x8 af[2];
        {
            const float* mulp = buf + 13312 + 768 + (wave - 2) * 64 + 8 * kg;
#pragma unroll
            for (int ks = 0; ks < 2; ++ks) {
                const f32x4 m0 = *(const f32x4*)(mulp + 32 * ks), m1 = *(const f32x4*)(mulp + 32 * ks + 4);
                float xv[8];
#pragma unroll
                for (int e = 0; e < 4; ++e) {
                    const float a0 = lo16(ar[1][ks][e]), a1 = hi16(ar[1][ks][e]);
                    const float mu0 = e < 2 ? m0[2 * e] : m1[2 * e - 4], mu1 = e < 2 ? m0[2 * e + 1] : m1[2 * e - 3];
                    xv[2 * e] = a0 + (0.5f * (lo16(ar[0][ks][e]) + lo16(ar[2][ks][e])) - a0) * mu0;
                    xv[2 * e + 1] = a1 + (0.5f * (hi16(ar[0][ks][e]) + hi16(ar[2][ks][e])) - a1) * mu1;
                }
                if (wave == 3) {
#pragma unroll
                    for (int j = 0; j < 8; ++j) xv[j] = 1.0f - 2.0f * __builtin_amdgcn_rcpf(1.0f + __builtin_amdgcn_exp2f(2.8853900817779268f * xv[j]));
                }
                union { u32x4 u; bf16x8 hh; } f; f.u.x = pk2(xv[0], xv[1]); f.u.y = pk2(xv[2], xv[3]); f.u.z = pk2(xv[4], xv[5]); f.u.w = pk2(xv[6], xv[7]);
                af[ks] = f.hh;
            }
        }
        f32x4 acc[4];
#pragma unroll
        for (int nt = 0; nt < 4; ++nt) { acc[nt] = (f32x4){0.f, 0.f, 0.f, 0.f};
#pragma unroll
            for (int ks = 0; ks < 2; ++ks) acc[nt] = MFMA16(af[ks], lf[nt][ks], acc[nt]); }
#pragma unroll
        for (int nt = 0; nt < 4; ++nt)
#pragma unroll
            for (int rg = 0; rg < 4; ++rg) scr[(4 * kg + rg) * 64 + 16 * nt + n16] = acc[nt][rg];
        asm volatile("s_waitcnt lgkmcnt(0)" ::: "memory");
        const float* prep_ = scr + tok * 64 + 16 * cq;
        float xm[16];
        {
            const float* mux = cw + 256 + 16 * cq;
#pragma unroll
            for (int j = 0; j < 2; ++j)
#pragma unroll
                for (int e = 0; e < 4; ++e) {
                    const f32x2 mx2 = *(const f32x2*)(mux + 8 * j + 2 * e);
                    const float a0 = lo16(xr[1][j][e]), a1 = hi16(xr[1][j][e]);
                    xm[8 * j + 2 * e] = a0 + (0.5f * (lo16(xr[0][j][e]) + lo16(xr[2][j][e])) - a0) * mx2.x;
                    xm[8 * j + 2 * e + 1] = a1 + (0.5f * (hi16(xr[0][j][e]) + hi16(xr[2][j][e])) - a1) * mx2.y;
                }
        }
        float* o = bb + tok * 64 + 16 * cq;
        const float* mur = cw + 320 + 16 * cq;
        if (wave == 2) {
            float ss = 0.f, bonus = 0.f;
#pragma unroll
            for (int j = 0; j < 4; ++j) { const f32x4 kkc = *(const f32x4*)(cw + 64 + 16 * cq + 4 * j);
#pragma unroll
                for (int e = 0; e < 4; ++e) { const float kr = xm[4 * j + e] * kkc[e]; ss += kr * kr; } }
            ss = quad_sum(ss);
            const float inv = __builtin_amdgcn_rcpf(fmaxf(__builtin_amdgcn_sqrtf(ss), 1e-12f));
#pragma unroll
            for (int j = 0; j < 4; ++j) {
                asm volatile("" ::: "memory");
                const f32x4 a0 = *(const f32x4*)(cw + 16 * cq + 4 * j), kkc = *(const f32x4*)(cw + 64 + 16 * cq + 4 * j),
                            kac = *(const f32x4*)(cw + 128 + 16 * cq + 4 * j), rkc = *(const f32x4*)(cw + 192 + 16 * cq + 4 * j), mr = *(const f32x4*)(mur + 4 * j);
                const f32x4 pre = *(const f32x4*)(prep_ + 4 * j);
                f32x4 vkd, vb, vkk;
#pragma unroll
                for (int e = 0; e < 4; ++e) {
                    const int ix = 4 * j + e, jj = ix >> 3, ee = (ix & 7) >> 1; const bool hi = ix & 1;
                    const float r1 = hi ? hi16(rr_[1][jj][ee]) : lo16(rr_[1][jj][ee]), r0 = hi ? hi16(rr_[0][jj][ee]) : lo16(rr_[0][jj][ee]), r2 = hi ? hi16(rr_[2][jj][ee]) : lo16(rr_[2][jj][ee]);
                    const float r = r1 + (0.5f * (r0 + r2) - r1) * mr[e];
                    const float a = sigmoidf_(a0[e] + pre[e]);
                    const float kk = xm[ix] * kkc[e] * inv, kd = xm[ix] * (1.0f + (a - 1.0f) * kac[e]);
                    bonus += r * kd * rkc[e]; vkd[e] = kd; vb[e] = kk * a; vkk[e] = kk;
                }
                *(f32x4*)(o + 1024 + 4 * j) = vkd; *(f32x4*)(o + 2048 + 4 * j) = vb; *(f32x4*)(o + 3072 + 4 * j) = vkk;
            }
            bonus = quad_sum(bonus);
            if (c >= 16 && cq == 0 && half == 0) BON[(size_t)(seqrow0 + t) * 12 + h] = bonus;
        } else {
#pragma unroll
            for (int j = 0; j < 4; ++j) {
                asm volatile("" ::: "memory");
                const f32x4 w0 = *(const f32x4*)(cw + 16 * cq + 4 * j), mr = *(const f32x4*)(mur + 4 * j);
                const f32x4 pre = *(const f32x4*)(prep_ + 4 * j);
                f32x4 vw, vr, vv;
#pragma unroll
                for (int e = 0; e < 4; ++e) {
                    const int ix = 4 * j + e, jj = ix >> 3, ee = (ix & 7) >> 1; const bool hi = ix & 1;
                    const float r1 = hi ? hi16(rr_[1][jj][ee]) : lo16(rr_[1][jj][ee]), r0 = hi ? hi16(rr_[0][jj][ee]) : lo16(rr_[0][jj][ee]), r2 = hi ? hi16(rr_[2][jj][ee]) : lo16(rr_[2][jj][ee]);
                    vr[e] = r1 + (0.5f * (r0 + r2) - r1) * mr[e];
                    const float xs = -(w0[e] + pre[e]); const float sp = fmaxf(xs, 0.f) + 0.6931471805599453f * __builtin_amdgcn_logf(1.0f + __builtin_amdgcn_exp2f(-1.4426950408889634f * fabsf(xs)));
                    vw[e] = __builtin_amdgcn_exp2f(-1.4426950408889634f * __builtin_amdgcn_exp2f(-1.4426950408889634f * (sp + 0.5f))); vv[e] = xm[ix];
                }
                *(f32x4*)(o + 4 * j) = vw; *(f32x4*)(o + 4096 + 4 * j) = vr; *(f32x4*)(o + 5120 + 4 * j) = vv;
            }
        }
    };
    auto flush_y = [&](int c) __attribute__((always_inline)) {
        int seqrow0, len, t0; chunk_info(c, seqrow0, len, t0);
        const int p = tid - 128, tok = p >> 3, rl = (p & 7) * 4, rg = 32 * half + rl;
        const f32x4 a = *(const f32x4*)(ybuf + (c & 1) * 512 + tok * 32 + rl);
        u32x2 w; w.x = pk2(a.x, a.y); w.y = pk2(a.z, a.w);
        *(u32x2*)(Yd + (size_t)(seqrow0 + t0 + tok) * 768 + 64 * h + rg) = w;
    };
    struct SV { f32x4 kk[2], bv[2], kd[2], w[2], rr[2]; float v0, v1; };
#define SLOAD(S, TK) { const float* base_ = bb + (TK) * 64 + 8 * q8; \
        S.kk[0] = *(const f32x4*)(base_ + 3072); S.kk[1] = *(const f32x4*)(base_ + 3076); \
        S.bv[0] = *(const f32x4*)(base_ + 2048); S.bv[1] = *(const f32x4*)(base_ + 2052); S.kd[0] = *(const f32x4*)(base_ + 1024); S.kd[1] = *(const f32x4*)(base_ + 1028); \
        S.w[0] = *(const f32x4*)(base_); S.w[1] = *(const f32x4*)(base_ + 4); S.rr[0] = *(const f32x4*)(base_ + 4096); S.rr[1] = *(const f32x4*)(base_ + 4100); \
        S.v0 = bb[5 * 1024 + (TK) * 64 + r0]; S.v1 = bb[5 * 1024 + (TK) * 64 + r1]; }
#define SSTEP(S, TK) { \
        f32x2 a0 = {0.f, 0.f}, a1 = {0.f, 0.f}; \
        _Pragma("unroll") for (int j = 0; j < 4; ++j) { const f32x2 kj = {S.kk[j >> 1][2 * (j & 1)], S.kk[j >> 1][2 * (j & 1) + 1]}; a0 += S0[j] * kj; a1 += S1[j] * kj; } \
        const float sa0 = -oct_sum(a0.x + a0.y), sa1 = -oct_sum(a1.x + a1.y); \
        f32x2 y0 = {0.f, 0.f}, y1 = {0.f, 0.f}; \
        _Pragma("unroll") for (int j = 0; j < 4; ++j) { const int jj = j >> 1, e = 2 * (j & 1); \
            const f32x2 wj = {S.w[jj][e], S.w[jj][e + 1]}, bj = {S.bv[jj][e], S.bv[jj][e + 1]}, kj = {S.kd[jj][e], S.kd[jj][e + 1]}, rj = {S.rr[jj][e], S.rr[jj][e + 1]}; \
            S0[j] = S0[j] * wj + (bj * sa0 + kj * S.v0); S1[j] = S1[j] * wj + (bj * sa1 + kj * S.v1); \
            y0 += S0[j] * rj; y1 += S1[j] * rj; } \
        const float yy0 = oct_sum(y0.x + y0.y), yy1 = oct_sum(y1.x + y1.y); \
        if (q8 == 0) { yb[(TK) * 32 + (r0 & 31)] = yy0; yb[(TK) * 32 + (r1 & 31)] = yy1; } }
    auto scan_chunk = [&](int c) __attribute__((always_inline)) {
        const float* bb = buf + (c & 1) * 6144; float* yb = ybuf + (c & 1) * 512;
        const int t0s = dir ? 15 : 0, dt = dir ? -1 : 1;
        SV A, B;
        SLOAD(A, t0s)
        for (int ii = 0; ii < 16; ii += 2) {
            const int ta = t0s + dt * ii, tb = ta + dt, tc = tb + dt;
            SLOAD(B, tb)
            SSTEP(A, ta)
            if (ii + 2 < 16) SLOAD(A, tc)
            SSTEP(B, tb)
        }
    };
    if (__builtin_amdgcn_readfirstlane(wave) < 2) __builtin_amdgcn_s_setprio(2); else __builtin_amdgcn_s_setprio(1);
    if (wave >= 2) { issue_loads(0); produce(0); issue_loads(1); }
    __syncthreads();
    for (int c = 0; c < NCH; ++c) {
        if (wave < 2) { if (MODE != 1) scan_chunk(c); }
        else if (MODE != 2) {
            if (c >= 17) flush_y(c - 1);
            if (c + 1 < NCH) produce(c + 1);
            if (c + 2 < NCH) issue_loads(c + 2);
        }
        __syncthreads();
    }
    if (wave >= 2) flush_y(NCH - 1);
    __builtin_amdgcn_s_setprio(0);
    __syncthreads();
}

DI void pool_units(const Params& P, int first, int stride, unsigned char* lds) {
    const bf16_t* PL = (const bf16_t*)(P.ws + OFF_PL1); bf16_t* Y = (bf16_t*)(P.ws + OFF_H); bf16_t* AG = (bf16_t*)(P.ws + OFF_AG);
    float* pl = (float*)lds;
    const int tid = otid(), g = tid >> 6, i = tid & 63;
    float pw[64];
#pragma unroll
    for (int ii = 0; ii < 64; ++ii) pw[ii] = P.cd_pool_w[(size_t)(g * 64 + ii) * 64 + i];
    const float scale = P.cd_pool_scale[tid];
    const int wl = 1 << g, wr = 1 << g;
    float mug[8];
#pragma unroll
    for (int j = 0; j < 8; ++j) mug[j] = P.cd_mu[2560 + 8 * (tid & 15) + j];
    for (int u = first; u < NLAT / 32; u += stride) {
        const int row0 = u * 32, b = row0 >> 13, t0 = row0 & 8191;
        const bf16_t* col = PL + (size_t)(b * SEQ) * CDIN + 2688 + tid;
        __syncthreads();
        {
            int lo = t0 - wl < 0 ? 0 : t0 - wl, hi = t0 + wr > SEQ ? SEQ : t0 + wr;
            float sum = 0.f;
            for (int s = lo; s < hi; ++s) sum += bf2f(col[(size_t)s * CDIN]);
            for (int tok = 0; tok < 32; ++tok) {
                const int t = t0 + tok;
                lo = t - wl < 0 ? 0 : t - wl; hi = t + wr > SEQ ? SEQ : t + wr;
                pl[tok * 256 + tid] = sum / (float)(hi - lo) - bf2f(col[(size_t)t * CDIN]);
                if (t + wr < SEQ) sum += bf2f(col[(size_t)(t + wr) * CDIN]);
                if (t - wl >= 0) sum -= bf2f(col[(size_t)(t - wl) * CDIN]);
            }
        }
        __syncthreads();
        for (int tok = 0; tok < 32; ++tok) {
            const float* pp = pl + tok * 256 + g * 64; float acc = 0.f;
#pragma unroll
            for (int ii = 0; ii < 16; ++ii) { const f32x4 v = *(const f32x4*)(pp + 4 * ii); acc += v.x * pw[4 * ii] + v.y * pw[4 * ii + 1] + v.z * pw[4 * ii + 2] + v.w * pw[4 * ii + 3]; }
            Y[(size_t)(row0 + tok) * DM + 768 + tid] = f2bf(acc * scale);
        }
#pragma unroll
        for (int hh = 0; hh < 2; ++hh) {
            const int tok = (tid >> 4) + 16 * hh, t = t0 + tok;
            float xv[8]; mix8(PL + (size_t)(row0 + tok) * CDIN + 2560 + 8 * (tid & 15), t > 0, t + 1 < SEQ, mug, xv);
            u32x4 w; w.x = pk2(sigmoidf_(xv[0]), sigmoidf_(xv[1])); w.y = pk2(sigmoidf_(xv[2]), sigmoidf_(xv[3])); w.z = pk2(sigmoidf_(xv[4]), sigmoidf_(xv[5])); w.w = pk2(sigmoidf_(xv[6]), sigmoidf_(xv[7]));
            *(u32x4*)(AG + (size_t)(row0 + tok) * 128 + 8 * (tid & 15)) = w;
        }
    }
    __syncthreads();
}
DI void zpass_phase(const Params& P) {
    const bf16_t* PL = (const bf16_t*)(P.ws + OFF_PL1); const bf16_t* YF = (const bf16_t*)(P.ws + OFF_YF); const bf16_t* YB = (const bf16_t*)(P.ws + OFF_YB);
    const float* BON = (const float*)(P.ws + OFF_BONUS); bf16_t* Y = (bf16_t*)(P.ws + OFF_H); const bf16_t* Gt = (const bf16_t*)(P.ws + OFF_G);
    const int tid = otid(), hw = tid >> 5, i = tid & 31;
    const int stride = gridDim.x * 8;
    for (int task0 = blockIdx.x * 8 + hw; task0 < NLAT * 12; task0 += 4 * stride) {
        unsigned ya[4], yb[4]; float bon[4]; unsigned short vr[4][6];
#pragma unroll
        for (int u = 0; u < 4; ++u) {
            const int task = task0 + u * stride; const bool ok = task < NLAT * 12;
            const int row = ok ? task / 12 : 0, h = ok ? task - row * 12 : 0, t = row & 8191, c = 64 * h + 2 * i;
            ya[u] = *(const unsigned*)(YF + (size_t)row * 768 + c); yb[u] = *(const unsigned*)(YB + (size_t)row * 768 + c);
            bon[u] = BON[(size_t)row * 12 + h] + BON[(size_t)NLAT * 12 + (size_t)row * 12 + h];
            const bf16_t* pv = PL + (size_t)row * CDIN + 1536 + c;
            const unsigned cur = *(const unsigned*)pv, prv = t > 0 ? *(const unsigned*)(pv - CDIN) : 0u, nxt = t + 1 < SEQ ? *(const unsigned*)(pv + CDIN) : 0u;
            vr[u][0] = (unsigned short)(cur & 0xffff); vr[u][1] = (unsigned short)(cur >> 16); vr[u][2] = (unsigned short)(prv & 0xffff); vr[u][3] = (unsigned short)(prv >> 16);
            vr[u][4] = (unsigned short)(nxt & 0xffff); vr[u][5] = (unsigned short)(nxt >> 16);
        }
#pragma unroll
        for (int u = 0; u < 4; ++u) {
            const int task = task0 + u * stride; const bool ok = task < NLAT * 12;
            const int row = ok ? task / 12 : 0, h = ok ? task - row * 12 : 0, c = 64 * h + 2 * i;
            const float y0 = lo16(ya[u]) + lo16(yb[u]), y1 = hi16(ya[u]) + hi16(yb[u]);
            float sm = y0 + y1;
#pragma unroll
            for (int o = 16; o > 0; o >>= 1) sm += __shfl_xor(sm, o);
            const float mean = sm * (1.0f / 64.0f); const float d0 = y0 - mean, d1 = y1 - mean;
            float vs = d0 * d0 + d1 * d1;
#pragma unroll
            for (int o = 16; o > 0; o >>= 1) vs += __shfl_xor(vs, o);
            const float rs = rsqrtf(vs * (1.0f / 64.0f) + LNX_EPS);
            const float x0 = bf2f(vr[u][0]), x1 = bf2f(vr[u][1]);
            const float v0 = x0 + (0.5f * (bf2f(vr[u][2]) + bf2f(vr[u][4])) - x0) * P.cd_mu[1536 + c], v1 = x1 + (0.5f * (bf2f(vr[u][3]) + bf2f(vr[u][5])) - x1) * P.cd_mu[1536 + c + 1];
            const float z0 = d0 * rs * P.cd_lnx_w[c] + P.cd_lnx_b[c] + bon[u] * v0, z1 = d1 * rs * P.cd_lnx_w[c + 1] + P.cd_lnx_b[c + 1] + bon[u] * v1;
            const unsigned gg = *(const unsigned*)(Gt + (size_t)row * 768 + c);
            if (ok) *(unsigned*)(Y + (size_t)row * DM + c) = pk2(z0 * lo16(gg), z1 * hi16(gg));
        }
    }
}


constexpr size_t OFF_BAR = OFF_ROPE + 512 * 1024;
#define XB_TMO      128
#define XB_XCNT(j)  (256  + 64 * (j))
#define XB_XSUB(j)  (1280 + 64 * (j))
#define XB_XGEN(j)  (2304 + 64 * (j))
#define XB_TOP      3328
#define XB_TOPGEN   3392
#define XCD_BAR_WORDS 3456
#define XB_SPIN_CAP (1u << 22)
DI unsigned xb_ld(unsigned* p)              { return __hip_atomic_load(p, __ATOMIC_RELAXED, __HIP_MEMORY_SCOPE_AGENT); }
DI unsigned xb_add(unsigned* p, unsigned v) { return __hip_atomic_fetch_add(p, v, __ATOMIC_RELAXED, __HIP_MEMORY_SCOPE_AGENT); }
DI unsigned xb_xcc_id() { return (unsigned)__builtin_amdgcn_s_getreg((3 << 11) | 20) & 0xFu; }
#define XB_SPIN(cond, bar) do { unsigned _sp = 0; while (cond) { __builtin_amdgcn_s_sleep(1); \
    if ((++_sp & 255u) == 0u) { if (xb_ld(&(bar)[XB_TMO])) break; if (_sp > XB_SPIN_CAP) { atomicAdd(&(bar)[XB_TMO], 1u); break; } } } } while (0)
#define XB_GRP 192
struct XcdBar { unsigned* bar; unsigned x, nloc, nx; };
DI void group_barrier(unsigned* bar, unsigned n) {
    asm volatile("s_waitcnt vmcnt(0)" ::: "memory");
    __syncthreads();
    if (threadIdx.x == 0) {
        __builtin_amdgcn_fence(__ATOMIC_RELEASE, "agent");
        asm volatile("s_waitcnt vmcnt(0)" ::: "memory");
        (void)xb_add(&bar[XB_GRP], 1u);
        XB_SPIN(xb_ld(&bar[XB_GRP]) < n, bar);
        __builtin_amdgcn_fence(__ATOMIC_ACQUIRE, "agent");
        asm volatile("s_waitcnt vmcnt(0)" ::: "memory");
    }
    __syncthreads();
}
DI void xcd_barrier(const XcdBar& b) {
    asm volatile("s_waitcnt vmcnt(0)" ::: "memory");
    __syncthreads();
    if (threadIdx.x == 0) {
        unsigned* bar = b.bar;
        __builtin_amdgcn_s_waitcnt(0);
        const unsigned nloc = b.nloc, nx = b.nx;
        const unsigned old = xb_add(&bar[XB_XSUB(b.x)], 1u);
        const unsigned gen = old / nloc;
        if (old + 1u == (gen + 1u) * nloc) {
            __builtin_amdgcn_fence(__ATOMIC_RELEASE, "agent");
            asm volatile("s_waitcnt vmcnt(0)" ::: "memory");
            const unsigned og = xb_add(&bar[XB_TOP], 1u);
            const unsigned tg = og / nx;
            if (og + 1u == (tg + 1u) * nx) xb_add(&bar[XB_TOPGEN], 1u);
            else XB_SPIN(xb_ld(&bar[XB_TOPGEN]) == tg, bar);
            __builtin_amdgcn_fence(__ATOMIC_ACQUIRE, "agent");
            xb_add(&bar[XB_XGEN(b.x)], 1u);
            asm volatile("s_waitcnt vmcnt(0)" ::: "memory");
        } else {
            XB_SPIN(xb_ld(&bar[XB_XGEN(b.x)]) == gen, bar);
            __builtin_amdgcn_fence(__ATOMIC_ACQUIRE, "agent");
            asm volatile("s_waitcnt vmcnt(0)" ::: "memory");
        }
    }
    __syncthreads();
}

DI void scan_phase(const Params& P, unsigned char* lds, const XcdBar& xb) {
    const int G = gridDim.x;
    for (int c = blockIdx.x; c < 384; c += G) scan_chain<0>(P, c, lds);
    const bf16_t* AG = (const bf16_t*)(P.ws + OFF_AG); const bf16_t* WG2 = (const bf16_t*)(P.ws + OFF_WG2); bf16_t* Gb = (bf16_t*)(P.ws + OFF_G);
    if (G > 384 && ((G - 384) & 7) == 0) {
        if ((int)blockIdx.x >= 384) {
            pool_units(P, blockIdx.x - 384, G - 384, lds);
            group_barrier(xb.bar, (unsigned)(G - 384));
            gemm256_phase(AG, 128, WG2, 128, NLAT, 768, 128, EpiStoreBf16{Gb, 768}, lds, (int)blockIdx.x - 384, G - 384);
        }
    } else {
        pool_units(P, blockIdx.x, G, lds);
        xcd_barrier(xb);
        gemm256_phase(AG, 128, WG2, 128, NLAT, 768, 128, EpiStoreBf16{Gb, 768}, lds);
    }
}

#ifndef PHASE_MASK
#define PHASE_MASK 0xffff
#endif
#ifndef PHASE_LIMIT
#define PHASE_LIMIT 100
#endif
#ifndef REP_IDX
#define REP_IDX -1
#endif
#ifndef REP_N
#define REP_N 2
#endif
#define PH(n, idx) if ((((PHASE_MASK) >> (n)) & 1) && ((idx) < (PHASE_LIMIT) || (n) == 8))
__global__ void __launch_bounds__(256, 2) fwd_megakernel(Params P) {
    __shared__ __attribute__((aligned(16))) unsigned char lds[65536];
    cg::grid_group grid = cg::this_grid();
    XcdBar xb; xb.bar = (unsigned*)(P.ws + OFF_BAR); xb.x = xb_xcc_id();
    if (threadIdx.x == 0) (void)xb_add(&xb.bar[XB_XCNT(xb.x)], 1u);
    unsigned char* ws = P.ws;
    const float* MOD = (const float*)(ws + OFF_MOD);
    bf16_t* H = (bf16_t*)(ws + OFF_H);
    float* XLC = (float*)(ws + OFF_XLC);
    PH(0, 0) prep_phase(P, lds);
    grid.sync();
    {
        unsigned mine = 0u, cnt = 0u;
#pragma unroll
        for (unsigned j = 0; j < 16; ++j) { const unsigned c = xb_ld(&xb.bar[XB_XCNT(j)]); cnt += (c > 0u) ? 1u : 0u; mine = (j == xb.x) ? c : mine; }
        xb.nloc = __builtin_amdgcn_readfirstlane(mine > 0u ? mine : 1u); xb.nx = __builtin_amdgcn_readfirstlane(cnt > 0u ? cnt : 1u);
    }
    PH(1, 1) modfinal_phase(P);
    xcd_barrier(xb);
    PH(2, 2) rownorm_phase(P.x, P.ctx, NTOK, P.norm_gain, MOD, 0, 1, H);
    xcd_barrier(xb);
    PH(3, 3) gemm256_phase((const bf16_t*)H, DM, (const bf16_t*)(ws + OFF_WAB_IN), DM, NTOK, 1536, DM, EpiInprojL0{(bf16_t*)(ws + OFF_PL0), P.ab_q_gain, (const float*)(ws + OFF_ROPE), (const float*)(ws + OFF_ROPE) + 2048, P.ab_k_gain, (bf16_t*)(ws + OFF_KB), (bf16_t*)(ws + OFF_VT)}, lds);
    xcd_barrier(xb);
    PH(5, 5) attn_phase(P, lds);
#if REP_IDX == 5
    { xcd_barrier(xb); attn_phase(P, lds); }
#endif
    xcd_barrier(xb);
    PH(3, 6) gemm256_phase((const bf16_t*)H, DM, (const bf16_t*)(ws + OFF_WAB_OUT), DM, NTOK, DM, DM, EpiResidual{P.x, P.ctx, P.out, XLC, MOD, 2}, lds);
    xcd_barrier(xb);
    PH(2, 7) rownorm_phase(P.out, XLC, NTOK, P.norm_gain + 1024, MOD, 3, 4, H);
    xcd_barrier(xb);
    PH(3, 8) gemm256_phase((const bf16_t*)H, DM, (const bf16_t*)(ws + OFF_WFFN_IN), DM, NTOK, 5632, DM, EpiSwiglu{(bf16_t*)(ws + OFF_HID)}, lds);
#if REP_IDX == 8
    { xcd_barrier(xb); gemm256_phase((const bf16_t*)H, DM, (const bf16_t*)(ws + OFF_WFFN_IN), DM, NTOK, 5632, DM, EpiSwiglu{(bf16_t*)(ws + OFF_HID)}, lds); }
#endif
    xcd_barrier(xb);
    PH(3, 9) gemm256_phase((const bf16_t*)(ws + OFF_HID), FFH, (const bf16_t*)(ws + OFF_WFFN_OUT), FFH, NTOK, DM, FFH, EpiResidual{P.out, XLC, P.out, XLC, MOD, 5}, lds);
    xcd_barrier(xb);
    const float* MOD1 = MOD + 9 * 6144;
    PH(2, 10) rownorm_phase(P.out, XLC, NTOK, P.norm_gain + 2048, MOD1, 0, 1, H);
    xcd_barrier(xb);
    PH(3, 11) gemm256_phase((const bf16_t*)H, DM, (const bf16_t*)(ws + OFF_WCD_IN), DM, NTOK, 3072, DM, EpiStoreBf16{(bf16_t*)(ws + OFF_PL1), CDIN}, lds);
    xcd_barrier(xb);
    PH(6, 12) scan_phase(P, lds, xb);
#if REP_IDX == 12
    { xcd_barrier(xb); scan_phase(P, lds, xb); }
#endif
    xcd_barrier(xb);
    PH(7, 13) zpass_phase(P);
    xcd_barrier(xb);
    PH(3, 15) gemm256_phase((const bf16_t*)H, DM, (const bf16_t*)(ws + OFF_WCD_OUT), DM, NLAT, DM, DM, EpiResidual{P.out, XLC, P.out, XLC, MOD1, 2}, lds);
    xcd_barrier(xb);
    PH(2, 16) rownorm_phase(P.out, XLC, NLAT, P.norm_gain + 3072, MOD1, 3, 4, H);
    xcd_barrier(xb);
    PH(3, 17) gemm256_phase((const bf16_t*)H, DM, (const bf16_t*)(ws + OFF_WFFN_IN + WFFN_IN_SZ), DM, NLAT, 5632, DM, EpiSwiglu{(bf16_t*)(ws + OFF_HID)}, lds);
    xcd_barrier(xb);
    PH(3, 18) gemm256_phase((const bf16_t*)(ws + OFF_HID), FFH, (const bf16_t*)(ws + OFF_WFFN_OUT + WFFN_OUT_SZ), FFH, NLAT, DM, FFH, EpiResidual{P.out, XLC, P.out, XLC, MOD1, 5}, lds);
    xcd_barrier(xb);
    PH(8, 19) finalnorm_phase(P);
}

extern "C" void kernel_launch(void* const* d_in, const int* in_sizes, int n_in, void* d_out, int out_size, void* d_ws, size_t ws_size, hipStream_t stream) {
    static int grid_blocks = 0;
    if (!grid_blocks) {
        int dev = 0, cus = 0, per_cu = 0;
        hipGetDevice(&dev);
        hipDeviceGetAttribute(&cus, hipDeviceAttributeMultiprocessorCount, dev);
        hipOccupancyMaxActiveBlocksPerMultiprocessor(&per_cu, (const void*)fwd_megakernel, 256, 0);
        if (per_cu < 1) per_cu = 1;
        if (per_cu > 2) per_cu = 2;
        grid_blocks = cus * per_cu;
    }
    Params p{};
    const float** pp = (const float**)&p;
    for (int i = 0; i < 30; ++i) pp[i] = (const float*)d_in[i];
    p.out = (float*)d_out; p.ws = (unsigned char*)d_ws;
    (void)hipMemsetAsync((unsigned char*)d_ws + OFF_BAR, 0, XCD_BAR_WORDS * 4, stream);
    void* args[] = {&p};
    hipError_t e = hipLaunchCooperativeKernel((const void*)fwd_megakernel, dim3(grid_blocks), dim3(256), args, 0, stream);
    if (e != hipSuccess) fprintf(stderr, "cooperative launch failed: %s (grid %d)\n", hipGetErrorString(e), grid_blocks);
}
```

```cpp
#include <hip/hip_runtime.h>
#include <hip/hip_cooperative_groups.h>
#include <cstdio>
#include <cstdint>
namespace cg = cooperative_groups;

typedef unsigned short bf16_t;
typedef short bf16x8 __attribute__((ext_vector_type(8)));
typedef float f32x4 __attribute__((ext_vector_type(4)));
typedef float f32x16 __attribute__((ext_vector_type(16)));
typedef float f32x2 __attribute__((ext_vector_type(2)));
typedef unsigned u32x4 __attribute__((ext_vector_type(4)));
typedef unsigned u32x2 __attribute__((ext_vector_type(2)));
#define DI __device__ __forceinline__

constexpr int NLAT = 65536, NCTX = 2048, NTOK = NLAT + NCTX, DM = 1024, SEQ = 8192, CTXL = 256;
constexpr int FFH = 2816, CDIN = 2944, KVLEN = SEQ + CTXL;
constexpr float EPS = 1e-6f, LNX_EPS = 64e-5f;
constexpr float QSCALE = 0.125f * 1.4426950408889634f, LOG2E = 1.4426950408889634f;

constexpr size_t MB = 1u << 20;
constexpr size_t OFF_WAB_IN = 0, OFF_WAB_OUT = 3 * MB, OFF_WCD_IN = 5 * MB, OFF_WCD_OUT = 11 * MB, OFF_WFFN_IN = 13 * MB, OFF_WFFN_OUT = 35 * MB,
                 OFF_WG2 = 46 * MB, OFF_MOD = 47 * MB, OFF_MODP = 48 * MB, OFF_ROPE = 52 * MB, OFF_XLC = 53 * MB, OFF_H = 61 * MB, OFF_BIG = 193 * MB;
constexpr size_t OFF_PL0 = OFF_BIG, OFF_KB = OFF_BIG + 198 * MB, OFF_VT = OFF_BIG + 231 * MB;
constexpr size_t OFF_HID = OFF_BIG;
constexpr size_t OFF_PL1 = OFF_BIG, OFF_YF = OFF_BIG + 380 * MB, OFF_YB = OFF_BIG + 476 * MB, OFF_AG = OFF_BIG + 572 * MB, OFF_BONUS = OFF_BIG + 588 * MB;
constexpr size_t OFF_G = OFF_BIG + 600 * MB;
constexpr size_t WFFN_IN_SZ = 11 * MB, WFFN_OUT_SZ = (size_t)1024 * 2816 * 2;

struct Params {
    const float *x, *c, *ctx, *c_ctx, *norm_gain, *ada_w, *ada_b, *ffn_w_in, *ffn_w_out, *final_gain, *ab_w_in, *ab_q_gain, *ab_k_gain, *ab_sink, *ab_w_out,
        *cd_w_in, *cd_mu, *cd_w0, *cd_w2, *cd_a0, *cd_a2, *cd_g2, *cd_k_k, *cd_k_a, *cd_r_k, *cd_lnx_w, *cd_lnx_b, *cd_pool_w, *cd_pool_scale, *cd_w_out;
    float* out; unsigned char* ws;
};

DI float bf2f(bf16_t b) { return __uint_as_float(((unsigned)b) << 16); }
typedef __bf16 bf16x2v __attribute__((ext_vector_type(2)));
DI unsigned pk2(float lo, float hi) { const f32x2 v = {lo, hi}; return __builtin_bit_cast(unsigned, __builtin_convertvector(v, bf16x2v)); }
DI bf16_t f2bf(float f) { return __builtin_bit_cast(bf16_t, (__bf16)f); }
DI float lo16(unsigned u) { return __uint_as_float(u << 16); }
DI float hi16(unsigned u) { return __uint_as_float(u & 0xffff0000u); }
DI float sigmoidf_(float x) { return __builtin_amdgcn_rcpf(1.0f + __builtin_amdgcn_exp2f(-1.4426950408889634f * x)); }
DI float quad_sum(float x) {
    x += __int_as_float(__builtin_amdgcn_mov_dpp(__float_as_int(x), 0xB1, 0xf, 0xf, true));
    x += __int_as_float(__builtin_amdgcn_mov_dpp(__float_as_int(x), 0x4E, 0xf, 0xf, true));
    return x;
}
DI float oct_sum(float x) { x = quad_sum(x); x += __int_as_float(__builtin_amdgcn_mov_dpp(__float_as_int(x), 0x141, 0xf, 0xf, true)); return x; }
DI int otid() { int t = threadIdx.x; asm volatile("" : "+v"(t)); return t; }
DI unsigned swz(int row, int chunk) { return (unsigned)row * 128u + (unsigned)((chunk ^ ((row >> 1) & 7)) << 4); }
#define MFMA32(a, b, c) __builtin_amdgcn_mfma_f32_32x32x16_bf16((a), (b), (c), 0, 0, 0)
#define MFMA16(a, b, c) __builtin_amdgcn_mfma_f32_16x16x32_bf16((a), (b), (c), 0, 0, 0)
DI int crow(int r, int hi) { return (r & 3) + 8 * (r >> 2) + 4 * hi; }

template <class Epi>
DI void gemm_phase(const bf16_t* __restrict__ A, int lda, const bf16_t* __restrict__ Bt, int ldb, int M, int N, int K, const Epi& epi, unsigned char* lds) {
    const int tid = otid(), lane = tid & 63, wave = tid >> 6, wm = wave >> 1, wn = wave & 1;
    const int nNt = N / 128, nk = K / 64;
    const int lr = tid >> 3, lc = tid & 7, l31 = lane & 31, lh = lane >> 5;
    const int G8 = gridDim.x >> 3, xcd = blockIdx.x & 7, lb = blockIdx.x >> 3, mper = (M / 128) >> 3, per = mper * nNt;
    for (int lt = lb; lt < per; lt += G8) {
        const int grp = lt / (8 * nNt), q = lt - grp * 8 * nNt, gs = (mper - grp * 8) < 8 ? (mper - grp * 8) : 8;
        const int tn = q / gs, tm = xcd * mper + grp * 8 + (q - tn * gs);
        const bf16_t* Ag = A + (size_t)(tm * 128 + lr) * lda + lc * 8;
        const bf16_t* Bg = Bt + (size_t)(tn * 128 + lr) * ldb + lc * 8;
        f32x16 acc[2][2];
#pragma unroll
        for (int i = 0; i < 2; ++i)
#pragma unroll
            for (int j = 0; j < 2; ++j)
#pragma unroll
                for (int r = 0; r < 16; ++r) acc[i][j][r] = 0.f;
        u32x4 ra0[4], rb0[4], ra1[4], rb1[4];
#define G_LOAD(RA, RB, KT) { _Pragma("unroll") for (int i = 0; i < 4; ++i) { RA[i] = *(const u32x4*)(Ag + (size_t)(32 * i) * lda + (KT) * 64); RB[i] = *(const u32x4*)(Bg + (size_t)(32 * i) * ldb + (KT) * 64); } }
#define G_STORE(RA, RB, BUF) { _Pragma("unroll") for (int i = 0; i < 4; ++i) { *(u32x4*)((BUF) + swz(lr + 32 * i, lc)) = RA[i]; *(u32x4*)((BUF) + 16384 + swz(lr + 32 * i, lc)) = RB[i]; } }
#define G_COMPUTE(BUF) { _Pragma("unroll") for (int ks = 0; ks < 4; ++ks) { bf16x8 af[2], bfr[2]; \
            _Pragma("unroll") for (int i = 0; i < 2; ++i) { af[i] = *(const bf16x8*)((BUF) + swz(wm * 64 + i * 32 + l31, 2 * ks + lh)); bfr[i] = *(const bf16x8*)((BUF) + 16384 + swz(wn * 64 + i * 32 + l31, 2 * ks + lh)); } \
            _Pragma("unroll") for (int i = 0; i < 2; ++i) _Pragma("unroll") for (int j = 0; j < 2; ++j) acc[i][j] = MFMA32(af[i], bfr[j], acc[i][j]); } }
        G_LOAD(ra0, rb0, 0)
        if (nk > 1) G_LOAD(ra1, rb1, 1)
        G_STORE(ra0, rb0, lds)
        __syncthreads();
        for (int kt = 0; kt < nk; kt += 2) {
            if (kt + 2 < nk) G_LOAD(ra0, rb0, kt + 2)
            G_COMPUTE(lds)
            if (kt + 1 < nk) G_STORE(ra1, rb1, lds + 32768)
            __syncthreads();
            if (kt + 1 < nk) {
                if (kt + 3 < nk) G_LOAD(ra1, rb1, kt + 3)
                G_COMPUTE(lds + 32768)
                if (kt + 2 < nk) G_STORE(ra0, rb0, lds)
                __syncthreads();
            }
        }
#undef G_LOAD
#undef G_STORE
#undef G_COMPUTE
        int lane_e = lane; asm volatile("" : "+v"(lane_e));
        epi.template operator()<2>(acc, tm * 128 + wm * 64, tn * 128 + wn * 64, lane_e);
    }
}

template <class Epi>
DI void gemm256_phase(const bf16_t* __restrict__ A, int lda, const bf16_t* __restrict__ Bt, int ldb, int M, int N, int K, const Epi& epi, unsigned char* lds, int vb = -1, int vn = 0) {
    const int tid = otid(), lane = tid & 63, wave = tid >> 6, wm = wave >> 1, wn = wave & 1;
    const int nNt = N / 256, nk = K / 64;
    const int lr = tid >> 3, lc = tid & 7, l31 = lane & 31, lh = lane >> 5;
    const int bix = vb >= 0 ? vb : (int)blockIdx.x, nbl = vb >= 0 ? vn : (int)gridDim.x;
    const int G8 = nbl >> 3, xcd = bix & 7, lb = bix >> 3, mper = (M / 128) >> 3, per = mper * nNt;
    const unsigned c0 = (unsigned)(lh ^ ((l31 >> 1) & 7)), roA = (unsigned)(wm * 8192 + l31 * 128), roB = (unsigned)(16384 + wn * 16384 + l31 * 128);
    for (int lt = lb; lt < per; lt += G8) {
        const int grp = lt / (8 * nNt), q = lt - grp * 8 * nNt, gs = (mper - grp * 8) < 8 ? (mper - grp * 8) : 8;
        const int tn = q / gs, tm = xcd * mper + grp * 8 + (q - tn * gs);
        const bf16_t* Au = A + (size_t)(tm * 128) * lda;
        const bf16_t* Bu = Bt + (size_t)(tn * 256) * ldb;
        const unsigned voA = (unsigned)(lr * lda + lc * 8), voB = (unsigned)(lr * ldb + lc * 8);
        f32x16 acc[2][4];
#pragma unroll
        for (int i = 0; i < 2; ++i)
#pragma unroll
            for (int j = 0; j < 4; ++j)
#pragma unroll
                for (int r = 0; r < 16; ++r) acc[i][j][r] = 0.f;
        u32x4 ra[4], rb[8];
#pragma unroll
        for (int i = 0; i < 4; ++i) ra[i] = *(const u32x4*)((Au + (size_t)(32 * i) * lda) + voA);
#pragma unroll
        for (int i = 0; i < 8; ++i) rb[i] = *(const u32x4*)((Bu + (size_t)(32 * i) * ldb) + voB);
        for (int kt = 0; kt < nk; ++kt) {
#pragma unroll
            for (int i = 0; i < 4; ++i) *(u32x4*)(lds + swz(lr + 32 * i, lc)) = ra[i];
#pragma unroll
            for (int i = 0; i < 8; ++i) *(u32x4*)(lds + 16384 + swz(lr + 32 * i, lc)) = rb[i];
            __syncthreads();
            if (kt + 1 < nk) {
#pragma unroll
                for (int i = 0; i < 4; ++i) ra[i] = *(const u32x4*)((Au + (size_t)(32 * i) * lda + (kt + 1) * 64) + voA);
#pragma unroll
                for (int i = 0; i < 8; ++i) rb[i] = *(const u32x4*)((Bu + (size_t)(32 * i) * ldb + (kt + 1) * 64) + voB);
            }
            __builtin_amdgcn_s_setprio(1);
#pragma unroll 2
            for (int ks = 0; ks < 4; ++ks) {
                bf16x8 af[2], bfr[4];
                const unsigned xo = (c0 ^ (unsigned)(2 * ks)) << 4;
#pragma unroll
                for (int i = 0; i < 2; ++i) af[i] = *(const bf16x8*)(lds + (roA + xo) + i * 4096);
#pragma unroll
                for (int j = 0; j < 4; ++j) bfr[j] = *(const bf16x8*)(lds + (roB + xo) + j * 4096);
#pragma unroll
                for (int i = 0; i < 2; ++i)
#pragma unroll
                    for (int j = 0; j < 4; ++j) acc[i][j] = MFMA32(af[i], bfr[j], acc[i][j]);
            }
            __builtin_amdgcn_s_setprio(0);
            __syncthreads();
        }
        int lane_e = lane; asm volatile("" : "+v"(lane_e));
        epi.template operator()<4>(acc, tm * 128 + wm * 64, tn * 256 + wn * 128, lane_e);
    }
}

DI int cu(int r) { return (r & 3) + 8 * (r >> 2); }
struct EpiStoreBf16 {
    bf16_t* C; int ldc;
    template <int NI> DI void operator()(const f32x16 (&acc)[2][NI], int row0, int col0, int lane) const {
        if (col0 >= ldc) return;
        const unsigned lo = (unsigned)(4 * (lane >> 5) * ldc + (lane & 31));
        bf16_t* base = C + (size_t)row0 * ldc + col0;
#pragma unroll
        for (int mi = 0; mi < 2; ++mi)
#pragma unroll
            for (int ni = 0; ni < NI; ++ni)
#pragma unroll
                for (int r = 0; r < 16; ++r) (base + (size_t)(32 * mi + cu(r)) * ldc + 32 * ni)[lo] = f2bf(acc[mi][ni][r]);
    }
};
struct EpiResidual {
    const float* srcL; const float* srcC; float* dstL; float* dstC; const float* mod; int gate_idx;
    template <int NI> DI void operator()(const f32x16 (&acc)[2][NI], int row0, int col0, int lane) const {
        const bool lat = row0 < NLAT;
        const float* src = (lat ? srcL + (size_t)row0 * DM : srcC + (size_t)(row0 - NLAT) * DM) + col0;
        float* dst = (lat ? dstL + (size_t)row0 * DM : dstC + (size_t)(row0 - NLAT) * DM) + col0;
        const float* g = mod + ((lat ? (row0 >> 13) : 8) * 6 + gate_idx) * 1024 + col0;
        const unsigned l31 = lane & 31, lo = (unsigned)(4 * (lane >> 5) * DM) + l31;
#pragma unroll
        for (int ni = 0; ni < NI; ++ni) {
            const float gv = (g + 32 * ni)[l31];
            float sv[32];
#pragma unroll
            for (int q = 0; q < 32; ++q) sv[q] = (src + (32 * (q >> 4) + cu(q & 15)) * DM + 32 * ni)[lo];
#pragma unroll
            for (int q = 0; q < 32; ++q) (dst + (32 * (q >> 4) + cu(q & 15)) * DM + 32 * ni)[lo] = sv[q] + gv * acc[q >> 4][ni][q & 15];
            asm volatile("" ::: "memory");
        }
    }
};
struct EpiInprojL0 {
    bf16_t* C; const float* qgain; const float* ct; const float* st; const float* kgain; bf16_t* KB; bf16_t* VT;
    template <int NI> DI void operator()(const f32x16 (&acc)[2][NI], int row0, int col0, int lane) const {
        const int l31 = lane & 31, lh = lane >> 5;
        const unsigned lo = (unsigned)(4 * lh * 1536 + l31);
        bf16_t* base = C + (size_t)row0 * 1536 + col0;
        const bool lat = row0 < NLAT;
        const int tlane = (row0 & 8191) + 4 * lh;
        if (col0 >= 1024) {
            const int j = (col0 - 1024) >> 7;
            const int bb = lat ? (row0 >> 13) : ((row0 - NLAT) >> 8), pos0 = lat ? (row0 & 8191) : SEQ + ((row0 - NLAT) & 255);
            if (j & 1) {
#pragma unroll
                for (int hp = 0; hp < NI / 2; ++hp) {
                    bf16_t* vb = VT + ((size_t)(bb * 4 + 2 * (j >> 1) + hp) * 64) * KVLEN + pos0;
                    const unsigned vlo = (unsigned)(l31 * KVLEN + 8 * lh);
#pragma unroll
                    for (int mi = 0; mi < 2; ++mi)
#pragma unroll
                        for (int g = 0; g < 4; ++g) {
                            bf16_t* p = vb + 16 * (2 * mi + (g >> 1)) + 4 * (g & 1);
                            u32x2 w1, w2;
                            w1.x = pk2(acc[mi][2 * hp][4 * g], acc[mi][2 * hp][4 * g + 1]); w1.y = pk2(acc[mi][2 * hp][4 * g + 2], acc[mi][2 * hp][4 * g + 3]);
                            w2.x = pk2(acc[mi][2 * hp + 1][4 * g], acc[mi][2 * hp + 1][4 * g + 1]); w2.y = pk2(acc[mi][2 * hp + 1][4 * g + 2], acc[mi][2 * hp + 1][4 * g + 3]);
                            *(u32x2*)(p + vlo) = w1; *(u32x2*)(p + (size_t)32 * KVLEN + vlo) = w2;
                        }
                }
                return;
            }
            const bool isBk = j == 2;
            const float kg1 = kgain[l31], kg2 = kgain[l31 + 32];
            const unsigned klo = (unsigned)(4 * lh * 64 + l31);
#pragma unroll
            for (int mi = 0; mi < 2; ++mi)
#pragma unroll
                for (int r = 0; r < 16; ++r) {
                    float c = 1.f, sn = 0.f;
                    if (lat) { const int t = tlane + 32 * mi + cu(r); const int pos = l31 < 16 ? (t >> 6) : (t & 63); c = ct[pos * 16 + (l31 & 15)]; sn = st[pos * 16 + (l31 & 15)]; }
#pragma unroll
                    for (int hp = 0; hp < NI / 2; ++hp) {
                        float x1 = acc[mi][2 * hp][r], x2 = acc[mi][2 * hp + 1][r];
                        if (isBk) {
                            float ss = x1 * x1 + x2 * x2;
#pragma unroll
                            for (int o = 16; o > 0; o >>= 1) ss += __shfl_xor(ss, o);
                            const float rs = rsqrtf(ss * (1.0f / 64.0f) + EPS);
                            x1 = x1 * rs * kg1; x2 = x2 * rs * kg2;
                        }
                        const float o1 = x1 * c - x2 * sn, o2 = x2 * c + x1 * sn;
                        bf16_t* p = KB + ((size_t)(bb * 4 + 2 * (j >> 1) + hp) * KVLEN + pos0 + 32 * mi + cu(r)) * 64;
                        p[klo] = f2bf(o1); (p + 32)[klo] = f2bf(o2);
                    }
                }
            return;
        }
        const bool isB = col0 >= 512;
        const float g1 = qgain[l31], g2 = qgain[l31 + 32];
#pragma unroll
        for (int mi = 0; mi < 2; ++mi)
#pragma unroll
            for (int r = 0; r < 16; ++r) {
                float c = 1.f, sn = 0.f;
                if (lat) { const int t = tlane + 32 * mi + cu(r); const int pos = l31 < 16 ? (t >> 6) : (t & 63); c = ct[pos * 16 + (l31 & 15)]; sn = st[pos * 16 + (l31 & 15)]; }
#pragma unroll
                for (int hp = 0; hp < NI / 2; ++hp) {
                    float x1 = acc[mi][2 * hp][r], x2 = acc[mi][2 * hp + 1][r];
                    if (isB) {
                        float ss = x1 * x1 + x2 * x2;
#pragma unroll
                        for (int o = 16; o > 0; o >>= 1) ss += __shfl_xor(ss, o);
                        const float rs = rsqrtf(ss * (1.0f / 64.0f) + EPS);
                        x1 = x1 * rs * g1; x2 = x2 * rs * g2;
                    }
                    const float o1 = x1 * c - x2 * sn, o2 = x2 * c + x1 * sn;
                    bf16_t* p = base + (size_t)(32 * mi + cu(r)) * 1536 + 64 * hp;
                    p[lo] = f2bf(o1 * QSCALE); (p + 32)[lo] = f2bf(o2 * QSCALE);
                }
            }
    }
};
struct EpiSwiglu {
    bf16_t* Hd;
    template <int NI> DI void operator()(const f32x16 (&acc)[2][NI], int row0, int col0, int lane) const {
        const unsigned lo = (unsigned)(4 * (lane >> 5) * FFH + (lane & 31));
        bf16_t* base = Hd + (size_t)row0 * FFH + (col0 >> 1);
#pragma unroll
        for (int pr = 0; pr < NI / 2; ++pr)
#pragma unroll
            for (int mi = 0; mi < 2; ++mi)
#pragma unroll
                for (int r = 0; r < 16; ++r) { const float g = acc[mi][2 * pr][r], u = acc[mi][2 * pr + 1][r]; __builtin_nontemporal_store(f2bf(g * sigmoidf_(g) * u), &(base + (32 * mi + cu(r)) * FFH + 32 * pr)[lo]); }
    }
};
struct EpiGateMul {
    bf16_t* Y;
    template <int NI> DI void operator()(const f32x16 (&acc)[2][NI], int row0, int col0, int lane) const {
        const unsigned lo = (unsigned)(4 * (lane >> 5) * DM + (lane & 31));
        bf16_t* base = Y + (size_t)row0 * DM + col0;
#pragma unroll
        for (int mi = 0; mi < 2; ++mi)
#pragma unroll
            for (int ni = 0; ni < NI; ++ni)
#pragma unroll
                for (int r = 0; r < 16; ++r) { bf16_t* p = base + (32 * mi + cu(r)) * DM + 32 * ni; p[lo] = f2bf(bf2f(p[lo]) * acc[mi][ni][r]); }
    }
};

DI void transpose_tile(const float* __restrict__ W, int ldw, int K, bf16_t* __restrict__ Wt, int k0, int n0, int ffn_map, float* t  ) {
    const int tid = otid();
    {
        const int n = tid & 63; int src = n0 + n;
        if (ffn_map) { const int np = n0 + n; const int j32 = np >> 6, s = (np >> 5) & 1, i = np & 31; src = s * FFH + j32 * 32 + i; }
#pragma unroll
        for (int i = 0; i < 16; ++i) { const int k = i * 4 + (tid >> 6); t[k * 65 + n] = W[(size_t)(k0 + k) * ldw + src]; }
    }
    __syncthreads();
#pragma unroll
    for (int i = 0; i < 2; ++i) {
        const int n = (tid >> 3) + 32 * i, kc = tid & 7;
        u32x4 v;
        v.x = pk2(t[(kc * 8 + 0) * 65 + n], t[(kc * 8 + 1) * 65 + n]); v.y = pk2(t[(kc * 8 + 2) * 65 + n], t[(kc * 8 + 3) * 65 + n]);
        v.z = pk2(t[(kc * 8 + 4) * 65 + n], t[(kc * 8 + 5) * 65 + n]); v.w = pk2(t[(kc * 8 + 6) * 65 + n], t[(kc * 8 + 7) * 65 + n]);
        *(u32x4*)(Wt + (size_t)(n0 + n) * K + k0 + kc * 8) = v;
    }
    __syncthreads();
}
DI void prep_phase(const Params& P, unsigned char* lds) {
    float* t = (float*)lds;
    unsigned char* ws = P.ws;
    for (int j = blockIdx.x; j < 5880; j += gridDim.x) {
        const float* W; int ldw, K, Nout, map = 0, jj = j; bf16_t* Wt;
        if (jj < 384) { W = P.ab_w_in; ldw = 1536; K = 1024; Nout = 1536; Wt = (bf16_t*)(ws + OFF_WAB_IN); }
        else if ((jj -= 384) < 256) { W = P.ab_w_out; ldw = 1024; K = 1024; Nout = 1024; Wt = (bf16_t*)(ws + OFF_WAB_OUT); }
        else if ((jj -= 256) < 736) { W = P.cd_w_in; ldw = CDIN; K = 1024; Nout = CDIN; Wt = (bf16_t*)(ws + OFF_WCD_IN); }
        else if ((jj -= 736) < 256) { W = P.cd_w_out; ldw = 1024; K = 1024; Nout = 1024; Wt = (bf16_t*)(ws + OFF_WCD_OUT); }
        else if ((jj -= 256) < 2816) { const int l = jj / 1408; jj -= l * 1408; W = P.ffn_w_in + (size_t)l * 1024 * 5632; ldw = 5632; K = 1024; Nout = 5632; map = 1; Wt = (bf16_t*)(ws + OFF_WFFN_IN + l * WFFN_IN_SZ); }
        else if ((jj -= 2816) < 1408) { const int l = jj / 704; jj -= l * 704; W = P.ffn_w_out + (size_t)l * FFH * 1024; ldw = 1024; K = FFH; Nout = 1024; Wt = (bf16_t*)(ws + OFF_WFFN_OUT + l * WFFN_OUT_SZ); }
        else { jj -= 1408; W = P.cd_g2; ldw = 768; K = 128; Nout = 768; Wt = (bf16_t*)(ws + OFF_WG2); }
        const int nNt = Nout / 64; const int kt = jj / nNt, nt = jj - kt * nNt;
        transpose_tile(W, ldw, K, Wt, kt * 64, nt * 64, map, t);
    }
    float* MODP = (float*)(ws + OFF_MODP);
    for (int j = blockIdx.x; j < 384; j += gridDim.x) {
        const int l = j / 192, r2 = j % 192, ks = r2 / 24, cb = r2 % 24;
        const int tid = otid();
        __syncthreads();
        for (int e = tid; e < 9 * 128; e += 256) { const int r = e >> 7, kk = e & 127; const float v = r < 8 ? P.c[r * 1024 + ks * 128 + kk] : P.c_ctx[ks * 128 + kk]; t[e] = v * sigmoidf_(v); }
        __syncthreads();
        const int col = cb * 256 + tid;
        const float* w = P.ada_w + ((size_t)l * 1024 + ks * 128) * 6144 + col;
        float a[9];
#pragma unroll
        for (int r = 0; r < 9; ++r) a[r] = 0.f;
#pragma unroll 4
        for (int kk = 0; kk < 128; ++kk) { const float wv = w[(size_t)kk * 6144];
#pragma unroll
            for (int r = 0; r < 9; ++r) a[r] += t[r * 128 + kk] * wv; }
#pragma unroll
        for (int r = 0; r < 9; ++r) MODP[((size_t)(ks * 2 + l) * 9 + r) * 6144 + col] = a[r];
    }
    if (blockIdx.x == 0) {
        float* ct = (float*)(ws + OFF_ROPE); float* st = ct + 2048;
        for (int e = otid(); e < 2048; e += 256) {
            const int pos = e >> 4, j = e & 15;
            const float inv = exp2f(-(float)j * (13.287712379549449f / 16.0f));
            const float ang = (float)pos * inv;
            double rev = (double)ang * 0.15915494309189535; rev -= floor(rev);
            const float rv = (float)rev;
            ct[e] = __builtin_amdgcn_cosf(rv); st[e] = __builtin_amdgcn_sinf(rv);
        }
    }
}
DI void modfinal_phase(const Params& P) {
    const float* MODP = (const float*)(P.ws + OFF_MODP); float* MOD = (float*)(P.ws + OFF_MOD);
    for (int e = blockIdx.x * 256 + otid(); e < 2 * 9 * 6144; e += gridDim.x * 256) {
        const int l = e / (9 * 6144), col = e % 6144;
        float s = P.ada_b[l * 6144 + col];
#pragma unroll
        for (int ks = 0; ks < 8; ++ks) s += MODP[(size_t)ks * (2 * 9 * 6144) + e];
        MOD[e] = s;
    }
}

DI void rownorm_phase(const float* srcL, const float* srcC, int M, const float* __restrict__ gain, const float* __restrict__ mod, int shift_idx, int scale_idx, bf16_t* __restrict__ H) {
    const int lane = otid() & 63, wave = otid() >> 6;
    for (int row = blockIdx.x * 4 + wave; row < M; row += gridDim.x * 4) {
        const bool lat = row < NLAT;
        const float* src = lat ? srcL + (size_t)row * DM : srcC + (size_t)(row - NLAT) * DM;
        const float* mrow = mod + (lat ? (row >> 13) : 8) * 6144;
        f32x4 v[4]; float ss = 0.f;
#pragma unroll
        for (int i = 0; i < 4; ++i) { v[i] = *(const f32x4*)(src + (i * 64 + lane) * 4); ss += v[i].x * v[i].x + v[i].y * v[i].y + v[i].z * v[i].z + v[i].w * v[i].w; }
#pragma unroll
        for (int o = 32; o > 0; o >>= 1) ss += __shfl_xor(ss, o);
        const float rs = rsqrtf(ss * (1.0f / 1024.0f) + EPS);
#pragma unroll
        for (int i = 0; i < 4; ++i) {
            const int col = (i * 64 + lane) * 4;
            const f32x4 g = *(const f32x4*)(gain + col), sc = *(const f32x4*)(mrow + scale_idx * 1024 + col), sh = *(const f32x4*)(mrow + shift_idx * 1024 + col);
            const f32x4 y = (v[i] * rs * g) * (sc + 1.0f) + sh;
            u32x2 o; o.x = pk2(y.x, y.y); o.y = pk2(y.z, y.w);
            *(u32x2*)(H + (size_t)row * DM + col) = o;
        }
    }
}
DI void finalnorm_phase(const Params& P) {
    const int lane = otid() & 63, wave = otid() >> 6;
    for (int row = blockIdx.x * 4 + wave; row < NLAT; row += gridDim.x * 4) {
        float* src = P.out + (size_t)row * DM;
        f32x4 v[4]; float ss = 0.f;
#pragma unroll
        for (int i = 0; i < 4; ++i) { v[i] = *(const f32x4*)(src + (i * 64 + lane) * 4); ss += v[i].x * v[i].x + v[i].y * v[i].y + v[i].z * v[i].z + v[i].w * v[i].w; }
#pragma unroll
        for (int o = 32; o > 0; o >>= 1) ss += __shfl_xor(ss, o);
        const float rs = rsqrtf(ss * (1.0f / 1024.0f) + EPS);
#pragma unroll
        for (int i = 0; i < 4; ++i) { const int col = (i * 64 + lane) * 4; *(f32x4*)(src + col) = v[i] * rs * *(const f32x4*)(P.final_gain + col); }
    }
}

DI void qkprep_phase(const Params& P) {
    bf16_t* PL = (bf16_t*)(P.ws + OFF_PL0); bf16_t* KB = (bf16_t*)(P.ws + OFF_KB); bf16_t* VT = (bf16_t*)(P.ws + OFF_VT);
    const float* ct = (const float*)(P.ws + OFF_ROPE); const float* st = ct + 2048;
    const int tid = otid(), hw = tid >> 5, i = tid & 31;
    for (int unit = blockIdx.x; unit < NTOK / 64; unit += gridDim.x) {
        const int row0 = unit * 64; const bool lat = row0 < NLAT;
        const int b = lat ? (row0 >> 13) : ((row0 - NLAT) >> 8);
        const int pos0 = lat ? (row0 & 8191) : SEQ + ((row0 - NLAT) & 255);
        for (int it = 0; it < 8; ++it) {
            float xa[4], xb[4];
#pragma unroll
            for (int u = 0; u < 4; ++u) {
                const int task = hw + 8 * (4 * it + u); const int tok = task >> 2, slot = 16 + (task & 3);
                const int col = slot < 16 ? slot * 64 : (slot < 18 ? 1024 + (slot - 16) * 64 : 1280 + (slot - 18) * 64);
                const bf16_t* p = PL + (size_t)(row0 + tok) * 1536 + col;
                xa[u] = bf2f(p[i]); xb[u] = bf2f(p[i + 32]);
            }
#pragma unroll
            for (int u = 0; u < 4; ++u) {
                const int task = hw + 8 * (4 * it + u); const int tok = task >> 2, slot = 16 + (task & 3);
                const int col = slot < 16 ? slot * 64 : (slot < 18 ? 1024 + (slot - 16) * 64 : 1280 + (slot - 18) * 64);
                bf16_t* p = PL + (size_t)(row0 + tok) * 1536 + col;
                float x1 = xa[u], x2 = xb[u];
                const bool isB = (slot >= 8 && slot < 16) || slot >= 18;
                if (isB) {
                    float ss = x1 * x1 + x2 * x2;
#pragma unroll
                    for (int o = 16; o > 0; o >>= 1) ss += __shfl_xor(ss, o);
                    const float rs = rsqrtf(ss * (1.0f / 64.0f) + EPS);
                    const float* g = slot < 16 ? P.ab_q_gain : P.ab_k_gain;
                    x1 = x1 * rs * g[i]; x2 = x2 * rs * g[i + 32];
                }
                if (lat) {
                    const int t = pos0 + tok; const int pos = i < 16 ? (t >> 6) : (t & 63);
                    const float c = ct[pos * 16 + (i & 15)], sn = st[pos * 16 + (i & 15)];
                    const float o1 = x1 * c - x2 * sn, o2 = x2 * c + x1 * sn; x1 = o1; x2 = o2;
                }
                if (slot < 16) { p[i] = f2bf(x1 * QSCALE); p[i + 32] = f2bf(x2 * QSCALE); }
                else { bf16_t* kp = KB + ((size_t)(b * 4 + (slot - 16)) * KVLEN + pos0 + tok) * 64; kp[i] = f2bf(x1); kp[i + 32] = f2bf(x2); }
            }
        }
        const int d = tid & 63, tg = tid >> 6;
#pragma unroll
        for (int vs = 0; vs < 4; ++vs) {
            const int col = 1024 + (vs < 2 ? 128 + vs * 64 : 384 + (vs - 2) * 64);
            const bf16_t* src = PL + (size_t)(row0 + 16 * tg) * 1536 + col + d;
            unsigned v[16];
#pragma unroll
            for (int j = 0; j < 16; ++j) v[j] = src[(size_t)j * 1536];
            u32x4 a, bq;
            a.x = v[0] | (v[1] << 16); a.y = v[2] | (v[3] << 16); a.z = v[8] | (v[9] << 16); a.w = v[10] | (v[11] << 16);
            bq.x = v[4] | (v[5] << 16); bq.y = v[6] | (v[7] << 16); bq.z = v[12] | (v[13] << 16); bq.w = v[14] | (v[15] << 16);
            bf16_t* dst = VT + ((size_t)(b * 4 + vs) * 64 + d) * KVLEN + pos0 + 16 * tg;
            *(u32x4*)dst = a; *(u32x4*)(dst + 8) = bq;
        }
    }
}

DI void attn_phase(const Params& P, unsigned char* lds) {
    const bf16_t* PL = (const bf16_t*)(P.ws + OFF_PL0); const bf16_t* KB = (const bf16_t*)(P.ws + OFF_KB); const bf16_t* VT = (const bf16_t*)(P.ws + OFF_VT);
    bf16_t* Y = (bf16_t*)(P.ws + OFF_H);
    const int tid = otid(), lane = tid & 63, wave = tid >> 6, l31 = lane & 31, lh = lane >> 5;
    const int lr = tid >> 3, lc = tid & 7;
    for (int unit = blockIdx.x; unit < 8448; unit += gridDim.x) {
        int b, hq, kvh, qrow0, nW, wlo, qpos0 = 0; bool masked = false, has_sink;
        if (unit < 8192) {
            const int u = unit & 4095; b = u >> 9; const int r = u & 511, kvl = r >> 8, hl = (r >> 6) & 3, qb = r & 63;
            qrow0 = b * SEQ + qb * 128; qpos0 = qb * 128;
            if (unit < 4096) { hq = 8 + kvl * 4 + hl; kvh = 2 + kvl; nW = 132; wlo = 0; has_sink = false; }
            else { hq = kvl * 4 + hl; kvh = kvl; masked = true; has_sink = true;
                   const int s0 = qpos0 - 128 < 0 ? 0 : qpos0 - 128, s1 = qpos0 + 256 > SEQ ? SEQ : qpos0 + 256; wlo = s0 >> 6; nW = (s1 >> 6) - wlo; }
        } else { const int u = unit - 8192; b = u >> 5; hq = (u >> 1) & 15; const int qb = u & 1; kvh = hq < 8 ? (hq >> 2) : 2 + ((hq - 8) >> 2);
                 qrow0 = NLAT + b * CTXL + qb * 128; nW = 0; wlo = 0; has_sink = hq < 8; }
        const int nt = masked ? nW + 4 : (nW ? nW : 4);
        const int qrow = qrow0 + 32 * wave + l31;
        const int qpos = qpos0 + 32 * wave + l31;
        bf16x8 qf[4];
        { const bf16_t* qp = PL + (size_t)qrow * 1536 + hq * 64 + 8 * lh;
#pragma unroll
          for (int ks = 0; ks < 4; ++ks) qf[ks] = *(const bf16x8*)(qp + 16 * ks); }
        f32x16 o[2];
#pragma unroll
        for (int r = 0; r < 16; ++r) { o[0][r] = 0.f; o[1][r] = 0.f; }
        float m = -1e30f, l = 0.f;
        const bf16_t* kbase = KB + (size_t)(b * 4 + kvh) * KVLEN * 64;
        const bf16_t* vbase = VT + (size_t)(b * 4 + kvh) * 64 * KVLEN;
        u32x4 rk[2], rv[2];
        auto tile_of = [&](int i) __attribute__((always_inline)) { return (masked && i >= nW) ? 128 + (i - nW) : wlo + i + ((!masked && nW == 0) ? 128 : 0); };
        {
            const int p0 = tile_of(0) * 64;
#pragma unroll
            for (int j = 0; j < 2; ++j) { rk[j] = *(const u32x4*)(kbase + (size_t)(p0 + lr + 32 * j) * 64 + lc * 8); rv[j] = *(const u32x4*)(vbase + (size_t)(lr + 32 * j) * KVLEN + p0 + lc * 8); }
#pragma unroll
            for (int j = 0; j < 2; ++j) { *(u32x4*)(lds + swz(lr + 32 * j, lc)) = rk[j]; *(u32x4*)(lds + 8192 + swz(lr + 32 * j, lc)) = rv[j]; }
        }
        __syncthreads();
        for (int i = 0; i < nt; ++i) {
            unsigned char* cur = lds + (i & 1) * 16384; unsigned char* nxt = lds + ((i + 1) & 1) * 16384;
            const int p0 = tile_of(i) * 64; const bool more = i + 1 < nt;
            if (more) { const int p1 = tile_of(i + 1) * 64;
#pragma unroll
                for (int j = 0; j < 2; ++j) { rk[j] = *(const u32x4*)(kbase + (size_t)(p1 + lr + 32 * j) * 64 + lc * 8); rv[j] = *(const u32x4*)(vbase + (size_t)(lr + 32 * j) * KVLEN + p1 + lc * 8); } }
            const bool wtile = masked && i < nW;
            bool active = true;
            if (wtile) { const int qmin = qpos0 + 32 * wave; active = (p0 <= qmin + 31 + 128) && (p0 + 63 >= qmin - 128); }
            if (active) {
                f32x16 s[2];
                __builtin_amdgcn_s_setprio(1);
#pragma unroll
                for (int kt = 0; kt < 2; ++kt) {
#pragma unroll
                    for (int r = 0; r < 16; ++r) s[kt][r] = 0.f;
#pragma unroll
                    for (int ks = 0; ks < 4; ++ks) { const bf16x8 kf = *(const bf16x8*)(cur + swz(32 * kt + l31, 2 * ks + lh)); s[kt] = MFMA32(kf, qf[ks], s[kt]); }
                }
                __builtin_amdgcn_s_setprio(0);
                if (wtile) {
#pragma unroll
                    for (int kt = 0; kt < 2; ++kt)
#pragma unroll
                        for (int r = 0; r < 16; ++r) { const int kp = p0 + 32 * kt + crow(r, lh); const int dlt = qpos - kp; if (dlt > 128 || dlt < -128) s[kt][r] = -INFINITY; }
                }
                float mx = s[0][0];
#pragma unroll
                for (int kt = 0; kt < 2; ++kt)
#pragma unroll
                    for (int r = 0; r < 16; ++r) mx = fmaxf(mx, s[kt][r]);
                mx = fmaxf(mx, __shfl_xor(mx, 32));
                const float mn = (mx > m + 8.0f) ? mx : m;
                if (__builtin_amdgcn_ballot_w64(mn != m) != 0ull) {
                    const float alpha = __builtin_amdgcn_exp2f(m - mn);
                    l *= alpha;
#pragma unroll
                    for (int r = 0; r < 16; ++r) { o[0][r] *= alpha; o[1][r] *= alpha; }
                    m = mn;
                }
                float ps = 0.f;
#pragma unroll
                for (int kt = 0; kt < 2; ++kt)
#pragma unroll
                    for (int r = 0; r < 16; ++r) { const float pv = __builtin_amdgcn_exp2f(s[kt][r] - mn); s[kt][r] = pv; ps += pv; }
                l += ps;
                __builtin_amdgcn_s_setprio(1);
#pragma unroll
                for (int kt = 0; kt < 2; ++kt)
#pragma unroll
                    for (int sx = 0; sx < 2; ++sx) {
                        union { u32x4 u; bf16x8 h; } pf;
                        pf.u.x = pk2(s[kt][8 * sx + 0], s[kt][8 * sx + 1]); pf.u.y = pk2(s[kt][8 * sx + 2], s[kt][8 * sx + 3]);
                        pf.u.z = pk2(s[kt][8 * sx + 4], s[kt][8 * sx + 5]); pf.u.w = pk2(s[kt][8 * sx + 6], s[kt][8 * sx + 7]);
#pragma unroll
                        for (int dt = 0; dt < 2; ++dt) { const bf16x8 vf = *(const bf16x8*)(cur + 8192 + swz(32 * dt + l31, 2 * (2 * kt + sx) + lh)); o[dt] = MFMA32(vf, pf.h, o[dt]); }
                    }
                __builtin_amdgcn_s_setprio(0);
            }
            if (more) {
#pragma unroll
                for (int j = 0; j < 2; ++j) { *(u32x4*)(nxt + swz(lr + 32 * j, lc)) = rk[j]; *(u32x4*)(nxt + 8192 + swz(lr + 32 * j, lc)) = rv[j]; }
            }
            __syncthreads();
        }
        l += __shfl_xor(l, 32);
        if (has_sink) l += __builtin_amdgcn_exp2f(P.ab_sink[hq] * LOG2E - m);
        const float inv = 1.0f / l;
        bf16_t* yp = Y + (size_t)qrow * DM + hq * 64 + 4 * lh;
#pragma unroll
        for (int dt = 0; dt < 2; ++dt)
#pragma unroll
            for (int g = 0; g < 4; ++g) { u32x2 w; w.x = pk2(o[dt][4 * g] * inv, o[dt][4 * g + 1] * inv); w.y = pk2(o[dt][4 * g + 2] * inv, o[dt][4 * g + 3] * inv); *(u32x2*)(yp + 32 * dt + 8 * g) = w; }
    }
}

DI float mix1(const bf16_t* p, bool hp, bool hn, float mu) {
    const float x = bf2f(p[0]); const float xp = hp ? bf2f(*(p - CDIN)) : 0.f; const float xn = hn ? bf2f(*(p + CDIN)) : 0.f;
    return x + (0.5f * (xp + xn) - x) * mu;
}
DI void mix8(const bf16_t* p, bool hp, bool hn, const float (&mu)[8], float (&o)[8]) {
    const u32x4 z = {0u, 0u, 0u, 0u};
    const u32x4 x = *(const u32x4*)p; const u32x4 xp = hp ? *(const u32x4*)(p - CDIN) : z; const u32x4 xn = hn ? *(const u32x4*)(p + CDIN) : z;
#pragma unroll
    for (int i = 0; i < 4; ++i) {
        const float a0 = lo16(x[i]), a1 = hi16(x[i]);
        o[2 * i] = a0 + (0.5f * (lo16(xp[i]) + lo16(xn[i])) - a0) * mu[2 * i];
        o[2 * i + 1] = a1 + (0.5f * (hi16(xp[i]) + hi16(xn[i])) - a1) * mu[2 * i + 1];
    }
}
template <int MODE>
DI void scan_chain(const Params& P, int chain, unsigned char* lds) {
    const int otid_ = otid(); const int lane = otid_ & 63, wave = (otid_ >> 6) ^ (((((int)blockIdx.x >> 8) ^ (int)blockIdx.x) & 1) ? 2 : 0), tid = wave * 64 + lane;
    const int half = chain & 1, chn = chain >> 1;
    const int b = chn / 24, rem = chn % 24, h = rem >> 1, dir = rem & 1;
    const bf16_t* PL = (const bf16_t*)(P.ws + OFF_PL1);
    bf16_t* Yd = (bf16_t*)(P.ws + (dir ? OFF_YB : OFF_YF));
    float* BON = (float*)(P.ws + OFF_BONUS) + (size_t)dir * NLAT * 12;
    float* buf = (float*)lds;
    float* ybuf = buf + 2 * 6144;
    const int NCH = 528;
    f32x2 S0[4], S1[4];
#pragma unroll
    for (int j = 0; j < 4; ++j) { S0[j] = (f32x2){0.f, 0.f}; S1[j] = (f32x2){0.f, 0.f}; }
    const int q8 = lane & 7, r0 = 32 * half + 16 * (wave & 1) + (lane >> 3), r1 = r0 + 8;
    const int kg = lane >> 4, n16 = lane & 15;
    bf16x8 lf[4][2];
    if (wave >= 2) {
        const float* l2 = (wave == 2 ? P.cd_a2 : P.cd_w2) + (size_t)dir * 64 * 768;
#pragma unroll
        for (int nt = 0; nt < 4; ++nt)
#pragma unroll
            for (int ks = 0; ks < 2; ++ks) {
                union { u32x4 u; bf16x8 hh; } f; const float* s = l2 + (size_t)(32 * ks + 8 * kg) * 768 + 64 * h + 16 * nt + n16;
                f.u.x = pk2(s[0], s[768]); f.u.y = pk2(s[2 * 768], s[3 * 768]); f.u.z = pk2(s[4 * 768], s[5 * 768]); f.u.w = pk2(s[6 * 768], s[7 * 768]);
                lf[nt][ks] = f.hh;
            }
    }
    float* cw = buf + 13312 + (wave & 1) * 384;
    if (wave >= 2) {
        const int ch = lane;
        if (wave == 2) { cw[ch] = P.cd_a0[dir * 768 + 64 * h + ch]; cw[64 + ch] = P.cd_k_k[64 * h + ch]; cw[128 + ch] = P.cd_k_a[64 * h + ch]; cw[192 + ch] = P.cd_r_k[64 * h + ch];
                         cw[256 + ch] = P.cd_mu[768 + 64 * h + ch]; cw[320 + ch] = P.cd_mu[64 * h + ch]; }
        else { cw[ch] = P.cd_w0[dir * 768 + 64 * h + ch]; cw[256 + ch] = P.cd_mu[1536 + 64 * h + ch]; cw[320 + ch] = P.cd_mu[64 * h + ch]; }
        buf[13312 + 768 + (wave - 2) * 64 + ch] = P.cd_mu[(wave == 2 ? 2432 : 2304) + 64 * dir + ch];
        asm volatile("s_waitcnt lgkmcnt(0)" ::: "memory");
    }
    auto chunk_info = [&](int c, int& seqrow0, int& len, int& t0) __attribute__((always_inline)) {
        if (c < 16) { seqrow0 = NLAT + b * CTXL; len = CTXL; t0 = dir ? 240 - 16 * c : 16 * c; }
        else { const int cc = c - 16; seqrow0 = b * SEQ; len = SEQ; t0 = dir ? SEQ - 16 - 16 * cc : 16 * cc; }
    };
    u32x4 xr[3][2], ar[3][2];
    auto issue_loads = [&](int c) __attribute__((always_inline)) {
        int seqrow0, len, t0; chunk_info(c, seqrow0, len, t0);
        const u32x4 z4 = {0u, 0u, 0u, 0u};
        { const int tok = lane >> 2, cq = lane & 3, t = t0 + tok; const bool hp = t > 0, hn = t + 1 < len;
          const bf16_t* prow = PL + (size_t)(seqrow0 + t) * CDIN + 64 * h + 16 * cq + (wave == 2 ? 768 : 1536);
#pragma unroll
          for (int j = 0; j < 2; ++j) { xr[1][j] = *(const u32x4*)(prow + 8 * j); xr[0][j] = hp ? *(const u32x4*)(prow - CDIN + 8 * j) : z4; xr[2][j] = hn ? *(const u32x4*)(prow + CDIN + 8 * j) : z4; } }
        { const int ta = t0 + n16; const bool hpa = ta > 0, hna = ta + 1 < len;
          const bf16_t* p = PL + (size_t)(seqrow0 + ta) * CDIN + (wave == 2 ? 2432 : 2304) + 64 * dir + 8 * kg;
#pragma unroll
          for (int ks = 0; ks < 2; ++ks) { ar[1][ks] = *(const u32x4*)(p + 32 * ks); ar[0][ks] = hpa ? *(const u32x4*)(p - CDIN + 32 * ks) : z4; ar[2][ks] = hna ? *(const u32x4*)(p + CDIN + 32 * ks) : z4; } }
    };
    auto produce = [&](int c) __attribute__((always_inline)) {
        int seqrow0, len, t0; chunk_info(c, seqrow0, len, t0);
        float* bb = buf + (c & 1) * 6144;
        float* scr = buf + 14336 + (wave - 2) * 1024;
        const int tok = lane >> 2, cq = lane & 3, t = t0 + tok; const bool hp = t > 0, hn = t + 1 < len;
        const bf16_t* prow = PL + (size_t)(seqrow0 + t) * CDIN + 64 * h + 16 * cq;
        const int cb = 64 * h + 16 * cq;
        const int xcol = wave == 2 ? 768 : 1536;
        const u32x4 z4 = {0u, 0u, 0u, 0u};
        u32x4 rr_[3][2];
#pragma unroll
        for (int j = 0; j < 2; ++j) { rr_[1][j] = *(const u32x4*)(prow + 8 * j); rr_[0][j] = hp ? *(const u32x4*)(prow - CDIN + 8 * j) : z4; rr_[2][j] = hn ? *(const u32x4*)(prow + CDIN + 8 * j) : z4; }
        bf16x8 af[2];
        {
            const float* mulp = buf + 13312 + 768 + (wave - 2) * 64 + 8 * kg;
#pragma unroll
            for (int ks = 0; ks < 2; ++ks) {
                const f32x4 m0 = *(const f32x4*)(mulp + 32 * ks), m1 = *(const f32x4*)(mulp + 32 * ks + 4);
                float xv[8];
#pragma unroll
                for (int e = 0; e < 4; ++e) {
                    const float a0 = lo16(ar[1][ks][e]), a1 = hi16(ar[1][ks][e]);
                    const float mu0 = e < 2 ? m0[2 * e] : m1[2 * e - 4], mu1 = e < 2 ? m0[2 * e + 1] : m1[2 * e - 3];
                    xv[2 * e] = a0 + (0.5f * (lo16(ar[0][ks][e]) + lo16(ar[2][ks][e])) - a0) * mu0;
                    xv[2 * e + 1] = a1 + (0.5f * (hi16(ar[0][ks][e]) + hi16(ar[2][ks][e])) - a1) * mu1;
                }
                if (wave == 3) {
#pragma unroll
                    for (int j = 0; j < 8; ++j) xv[j] = 1.0f - 2.0f * __builtin_amdgcn_rcpf(1.0f + __builtin_amdgcn_exp2f(2.8853900817779268f * xv[j]));
                }
                union { u32x4 u; bf16x8 hh; } f; f.u.x = pk2(xv[0], xv[1]); f.u.y = pk2(xv[2], xv[3]); f.u.z = pk2(xv[4], xv[5]); f.u.w = pk2(xv[6], xv[7]);
                af[ks] = f.hh;
            }
        }
        f32x4 acc[4];
#pragma unroll
        for (int nt = 0; nt < 4; ++nt) { acc[nt] = (f32x4){0.f, 0.f, 0.f, 0.f};
#pragma unroll
            for (int ks = 0; ks < 2; ++ks) acc[nt] = MFMA16(af[ks], lf[nt][ks], acc[nt]); }
#pragma unroll
        for (int nt = 0; nt < 4; ++nt)
#pragma unroll
            for (int rg = 0; rg < 4; ++rg) scr[(4 * kg + rg) * 64 + 16 * nt + n16] = acc[nt][rg];
        asm volatile("s_waitcnt lgkmcnt(0)" ::: "memory");
        const float* prep_ = scr + tok * 64 + 16 * cq;
        float xm[16];
        {
            const float* mux = cw + 256 + 16 * cq;
#pragma unroll
            for (int j = 0; j < 2; ++j)
#pragma unroll
                for (int e = 0; e < 4; ++e) {
                    const f32x2 mx2 = *(const f32x2*)(mux + 8 * j + 2 * e);
                    const float a0 = lo16(xr[1][j][e]), a1 = hi16(xr[1][j][e]);
                    xm[8 * j + 2 * e] = a0 + (0.5f * (lo16(xr[0][j][e]) + lo16(xr[2][j][e])) - a0) * mx2.x;
                    xm[8 * j + 2 * e + 1] = a1 + (0.5f * (hi16(xr[0][j][e]) + hi16(xr[2][j][e])) - a1) * mx2.y;
                }
        }
        float* o = bb + tok * 64 + 16 * cq;
        const float* mur = cw + 320 + 16 * cq;
        if (wave == 2) {
            float ss = 0.f, bonus = 0.f;
#pragma unroll
            for (int j = 0; j < 4; ++j) { const f32x4 kkc = *(const f32x4*)(cw + 64 + 16 * cq + 4 * j);
#pragma unroll
                for (int e = 0; e < 4; ++e) { const float kr = xm[4 * j + e] * kkc[e]; ss += kr * kr; } }
            ss = quad_sum(ss);
            const float inv = __builtin_amdgcn_rcpf(fmaxf(__builtin_amdgcn_sqrtf(ss), 1e-12f));
#pragma unroll
            for (int j = 0; j < 4; ++j) {
                asm volatile("" ::: "memory");
                const f32x4 a0 = *(const f32x4*)(cw + 16 * cq + 4 * j), kkc = *(const f32x4*)(cw + 64 + 16 * cq + 4 * j),
                            kac = *(const f32x4*)(cw + 128 + 16 * cq + 4 * j), rkc = *(const f32x4*)(cw + 192 + 16 * cq + 4 * j), mr = *(const f32x4*)(mur + 4 * j);
                const f32x4 pre = *(const f32x4*)(prep_ + 4 * j);
                f32x4 vkd, vb, vkk;
#pragma unroll
                for (int e = 0; e < 4; ++e) {
                    const int ix = 4 * j + e, jj = ix >> 3, ee = (ix & 7) >> 1; const bool hi = ix & 1;
                    const float r1 = hi ? hi16(rr_[1][jj][ee]) : lo16(rr_[1][jj][ee]), r0 = hi ? hi16(rr_[0][jj][ee]) : lo16(rr_[0][jj][ee]), r2 = hi ? hi16(rr_[2][jj][ee]) : lo16(rr_[2][jj][ee]);
                    const float r = r1 + (0.5f * (r0 + r2) - r1) * mr[e];
                    const float a = sigmoidf_(a0[e] + pre[e]);
                    const float kk = xm[ix] * kkc[e] * inv, kd = xm[ix] * (1.0f + (a - 1.0f) * kac[e]);
                    bonus += r * kd * rkc[e]; vkd[e] = kd; vb[e] = kk * a; vkk[e] = kk;
                }
                *(f32x4*)(o + 1024 + 4 * j) = vkd; *(f32x4*)(o + 2048 + 4 * j) = vb; *(f32x4*)(o + 3072 + 4 * j) = vkk;
            }
            bonus = quad_sum(bonus);
            if (c >= 16 && cq == 0 && half == 0) BON[(size_t)(seqrow0 + t) * 12 + h] = bonus;
        } else {
#pragma unroll
            for (int j = 0; j < 4; ++j) {
                asm volatile("" ::: "memory");
                const f32x4 w0 = *(const f32x4*)(cw + 16 * cq + 4 * j), mr = *(const f32x4*)(mur + 4 * j);
                const f32x4 pre = *(const f32x4*)(prep_ + 4 * j);
                f32x4 vw, vr, vv;
#pragma unroll
                for (int e = 0; e < 4; ++e) {
                    const int ix = 4 * j + e, jj = ix >> 3, ee = (ix & 7) >> 1; const bool hi = ix & 1;
                    const float r1 = hi ? hi16(rr_[1][jj][ee]) : lo16(rr_[1][jj][ee]), r0 = hi ? hi16(rr_[0][jj][ee]) : lo16(rr_[0][jj][ee]), r2 = hi ? hi16(rr_[2][jj][ee]) : lo16(rr_[2][jj][ee]);
                    vr[e] = r1 + (0.5f * (r0 + r2) - r1) * mr[e];
                    const float xs = -(w0[e] + pre[e]); const float sp = fmaxf(xs, 0.f) + 0.6931471805599453f * __builtin_amdgcn_logf(1.0f + __builtin_amdgcn_exp2f(-1.4426950408889634f * fabsf(xs)));
                    vw[e] = __builtin_amdgcn_exp2f(-1.4426950408889634f * __builtin_amdgcn_exp2f(-1.4426950408889634f * (sp + 0.5f))); vv[e] = xm[ix];
                }
                *(f32x4*)(o + 4 * j) = vw; *(f32x4*)(o + 4096 + 4 * j) = vr; *(f32x4*)(o + 5120 + 4 * j) = vv;
            }
        }
    };
    auto flush_y = [&](int c) __attribute__((always_inline)) {
        int seqrow0, len, t0; chunk_info(c, seqrow0, len, t0);
        const int p = tid - 128, tok = p >> 3, rl = (p & 7) * 4, rg = 32 * half + rl;
        const f32x4 a = *(const f32x4*)(ybuf + (c & 1) * 512 + tok * 32 + rl);
        u32x2 w; w.x = pk2(a.x, a.y); w.y = pk2(a.z, a.w);
        *(u32x2*)(Yd + (size_t)(seqrow0 + t0 + tok) * 768 + 64 * h + rg) = w;
    };
    struct SV { f32x4 kk[2], bv[2], kd[2], w[2], rr[2]; float v0, v1; };
#define SLOAD(S, TK) { const float* base_ = bb + (TK) * 64 + 8 * q8; \
        S.kk[0] = *(const f32x4*)(base_ + 3072); S.kk[1] = *(const f32x4*)(base_ + 3076); \
        S.bv[0] = *(const f32x4*)(base_ + 2048); S.bv[1] = *(const f32x4*)(base_ + 2052); S.kd[0] = *(const f32x4*)(base_ + 1024); S.kd[1] = *(const f32x4*)(base_ + 1028); \
        S.w[0] = *(const f32x4*)(base_); S.w[1] = *(const f32x4*)(base_ + 4); S.rr[0] = *(const f32x4*)(base_ + 4096); S.rr[1] = *(const f32x4*)(base_ + 4100); \
        S.v0 = bb[5 * 1024 + (TK) * 64 + r0]; S.v1 = bb[5 * 1024 + (TK) * 64 + r1]; }
#define SSTEP(S, TK) { \
        f32x2 a0 = {0.f, 0.f}, a1 = {0.f, 0.f}; \
        _Pragma("unroll") for (int j = 0; j < 4; ++j) { const f32x2 kj = {S.kk[j >> 1][2 * (j & 1)], S.kk[j >> 1][2 * (j & 1) + 1]}; a0 += S0[j] * kj; a1 += S1[j] * kj; } \
        const float sa0 = -oct_sum(a0.x + a0.y), sa1 = -oct_sum(a1.x + a1.y); \
        f32x2 y0 = {0.f, 0.f}, y1 = {0.f, 0.f}; \
        _Pragma("unroll") for (int j = 0; j < 4; ++j) { const int jj = j >> 1, e = 2 * (j & 1); \
            const f32x2 wj = {S.w[jj][e], S.w[jj][e + 1]}, bj = {S.bv[jj][e], S.bv[jj][e + 1]}, kj = {S.kd[jj][e], S.kd[jj][e + 1]}, rj = {S.rr[jj][e], S.rr[jj][e + 1]}; \
            S0[j] = S0[j] * wj + (bj * sa0 + kj * S.v0); S1[j] = S1[j] * wj + (bj * sa1 + kj * S.v1); \
            y0 += S0[j] * rj; y1 += S1[j] * rj; } \
        const float yy0 = oct_sum(y0.x + y0.y), yy1 = oct_sum(y1.x + y1.y); \
        if (q8 == 0) { yb[(TK) * 32 + (r0 & 31)] = yy0; yb[(TK) * 32 + (r1 & 31)] = yy1; } }
    auto scan_chunk = [&](int c) __attribute__((always_inline)) {
        const float* bb = buf + (c & 1) * 6144; float* yb = ybuf + (c & 1) * 512;
        const int t0s = dir ? 15 : 0, dt = dir ? -1 : 1;
        SV A, B;
        SLOAD(A, t0s)
        for (int ii = 0; ii < 16; ii += 2) {
            const int ta = t0s + dt * ii, tb = ta + dt, tc = tb + dt;
            SLOAD(B, tb)
            SSTEP(A, ta)
            if (ii + 2 < 16) SLOAD(A, tc)
            SSTEP(B, tb)
        }
    };
    if (__builtin_amdgcn_readfirstlane(wave) < 2) __builtin_amdgcn_s_setprio(2); else __builtin_amdgcn_s_setprio(1);
    if (wave >= 2) { issue_loads(0); produce(0); issue_loads(1); }
    __syncthreads();
    for (int c = 0; c < NCH; ++c) {
        if (wave < 2) { if (MODE != 1) scan_chunk(c); }
        else if (MODE != 2) {
            if (c >= 17) flush_y(c - 1);
            if (c + 1 < NCH) produce(c + 1);
            if (c + 2 < NCH) issue_loads(c + 2);
        }
        __syncthreads();
    }
    if (wave >= 2) flush_y(NCH - 1);
    __builtin_amdgcn_s_setprio(0);
    __syncthreads();
}

DI void pool_units(const Params& P, int first, int stride, unsigned char* lds) {
    const bf16_t* PL = (const bf16_t*)(P.ws + OFF_PL1); bf16_t* Y = (bf16_t*)(P.ws + OFF_H); bf16_t* AG = (bf16_t*)(P.ws + OFF_AG);
    float* pl = (float*)lds;
    const int tid = otid(), g = tid >> 6, i = tid & 63;
    float pw[64];
#pragma unroll
    for (int ii = 0; ii < 64; ++ii) pw[ii] = P.cd_pool_w[(size_t)(g * 64 + ii) * 64 + i];
    const float scale = P.cd_pool_scale[tid];
    const int wl = 1 << g, wr = 1 << g;
    float mug[8];
#pragma unroll
    for (int j = 0; j < 8; ++j) mug[j] = P.cd_mu[2560 + 8 * (tid & 15) + j];
    for (int u = first; u < NLAT / 32; u += stride) {
        const int row0 = u * 32, b = row0 >> 13, t0 = row0 & 8191;
        const bf16_t* col = PL + (size_t)(b * SEQ) * CDIN + 2688 + tid;
        __syncthreads();
        {
            int lo = t0 - wl < 0 ? 0 : t0 - wl, hi = t0 + wr > SEQ ? SEQ : t0 + wr;
            float sum = 0.f;
            for (int s = lo; s < hi; ++s) sum += bf2f(col[(size_t)s * CDIN]);
            for (int tok = 0; tok < 32; ++tok) {
                const int t = t0 + tok;
                lo = t - wl < 0 ? 0 : t - wl; hi = t + wr > SEQ ? SEQ : t + wr;
                pl[tok * 256 + tid] = sum / (float)(hi - lo) - bf2f(col[(size_t)t * CDIN]);
                if (t + wr < SEQ) sum += bf2f(col[(size_t)(t + wr) * CDIN]);
                if (t - wl >= 0) sum -= bf2f(col[(size_t)(t - wl) * CDIN]);
            }
        }
        __syncthreads();
        for (int tok = 0; tok < 32; ++tok) {
            const float* pp = pl + tok * 256 + g * 64; float acc = 0.f;
#pragma unroll
            for (int ii = 0; ii < 16; ++ii) { const f32x4 v = *(const f32x4*)(pp + 4 * ii); acc += v.x * pw[4 * ii] + v.y * pw[4 * ii + 1] + v.z * pw[4 * ii + 2] + v.w * pw[4 * ii + 3]; }
            Y[(size_t)(row0 + tok) * DM + 768 + tid] = f2bf(acc * scale);
        }
#pragma unroll
        for (int hh = 0; hh < 2; ++hh) {
            const int tok = (tid >> 4) + 16 * hh, t = t0 + tok;
            float xv[8]; mix8(PL + (size_t)(row0 + tok) * CDIN + 2560 + 8 * (tid & 15), t > 0, t + 1 < SEQ, mug, xv);
            u32x4 w; w.x = pk2(sigmoidf_(xv[0]), sigmoidf_(xv[1])); w.y = pk2(sigmoidf_(xv[2]), sigmoidf_(xv[3])); w.z = pk2(sigmoidf_(xv[4]), sigmoidf_(xv[5])); w.w = pk2(sigmoidf_(xv[6]), sigmoidf_(xv[7]));
            *(u32x4*)(AG + (size_t)(row0 + tok) * 128 + 8 * (tid & 15)) = w;
        }
    }
    __syncthreads();
}
DI void zpass_phase(const Params& P) {
    const bf16_t* PL = (const bf16_t*)(P.ws + OFF_PL1); const bf16_t* YF = (const bf16_t*)(P.ws + OFF_YF); const bf16_t* YB = (const bf16_t*)(P.ws + OFF_YB);
    const float* BON = (const float*)(P.ws + OFF_BONUS); bf16_t* Y = (bf16_t*)(P.ws + OFF_H); const bf16_t* Gt = (const bf16_t*)(P.ws + OFF_G);
    const int tid = otid(), hw = tid >> 5, i = tid & 31;
    const int stride = gridDim.x * 8;
    for (int task0 = blockIdx.x * 8 + hw; task0 < NLAT * 12; task0 += 4 * stride) {
        unsigned ya[4], yb[4]; float bon[4]; unsigned short vr[4][6];
#pragma unroll
        for (int u = 0; u < 4; ++u) {
            const int task = task0 + u * stride; const bool ok = task < NLAT * 12;
            const int row = ok ? task / 12 : 0, h = ok ? task - row * 12 : 0, t = row & 8191, c = 64 * h + 2 * i;
            ya[u] = *(const unsigned*)(YF + (size_t)row * 768 + c); yb[u] = *(const unsigned*)(YB + (size_t)row * 768 + c);
            bon[u] = BON[(size_t)row * 12 + h] + BON[(size_t)NLAT * 12 + (size_t)row * 12 + h];
            const bf16_t* pv = PL + (size_t)row * CDIN + 1536 + c;
            const unsigned cur = *(const unsigned*)pv, prv = t > 0 ? *(const unsigned*)(pv - CDIN) : 0u, nxt = t + 1 < SEQ ? *(const unsigned*)(pv + CDIN) : 0u;
            vr[u][0] = (unsigned short)(cur & 0xffff); vr[u][1] = (unsigned short)(cur >> 16); vr[u][2] = (unsigned short)(prv & 0xffff); vr[u][3] = (unsigned short)(prv >> 16);
            vr[u][4] = (unsigned short)(nxt & 0xffff); vr[u][5] = (unsigned short)(nxt >> 16);
        }
#pragma unroll
        for (int u = 0; u < 4; ++u) {
            const int task = task0 + u * stride; const bool ok = task < NLAT * 12;
            const int row = ok ? task / 12 : 0, h = ok ? task - row * 12 : 0, c = 64 * h + 2 * i;
            const float y0 = lo16(ya[u]) + lo16(yb[u]), y1 = hi16(ya[u]) + hi16(yb[u]);
            float sm = y0 + y1;
#pragma unroll
            for (int o = 16; o > 0; o >>= 1) sm += __shfl_xor(sm, o);
            const float mean = sm * (1.0f / 64.0f); const float d0 = y0 - mean, d1 = y1 - mean;
            float vs = d0 * d0 + d1 * d1;
#pragma unroll
            for (int o = 16; o > 0; o >>= 1) vs += __shfl_xor(vs, o);
            const float rs = rsqrtf(vs * (1.0f / 64.0f) + LNX_EPS);
            const float x0 = bf2f(vr[u][0]), x1 = bf2f(vr[u][1]);
            const float v0 = x0 + (0.5f * (bf2f(vr[u][2]) + bf2f(vr[u][4])) - x0) * P.cd_mu[1536 + c], v1 = x1 + (0.5f * (bf2f(vr[u][3]) + bf2f(vr[u][5])) - x1) * P.cd_mu[1536 + c + 1];
            const float z0 = d0 * rs * P.cd_lnx_w[c] + P.cd_lnx_b[c] + bon[u] * v0, z1 = d1 * rs * P.cd_lnx_w[c + 1] + P.cd_lnx_b[c + 1] + bon[u] * v1;
            const unsigned gg = *(const unsigned*)(Gt + (size_t)row * 768 + c);
            if (ok) *(unsigned*)(Y + (size_t)row * DM + c) = pk2(z0 * lo16(gg), z1 * hi16(gg));
        }
    }
}


constexpr size_t OFF_BAR = OFF_ROPE + 512 * 1024;
#define XB_TMO      128
#define XB_XCNT(j)  (256  + 64 * (j))
#define XB_XSUB(j)  (1280 + 64 * (j))
#define XB_XGEN(j)  (2304 + 64 * (j))
#define XB_TOP      3328
#define XB_TOPGEN   3392
#define XCD_BAR_WORDS 3456
#define XB_SPIN_CAP (1u << 22)
DI unsigned xb_ld(unsigned* p)              { return __hip_atomic_load(p, __ATOMIC_RELAXED, __HIP_MEMORY_SCOPE_AGENT); }
DI unsigned xb_add(unsigned* p, unsigned v) { return __hip_atomic_fetch_add(p, v, __ATOMIC_RELAXED, __HIP_MEMORY_SCOPE_AGENT); }
DI unsigned xb_xcc_id() { return (unsigned)__builtin_amdgcn_s_getreg((3 << 11) | 20) & 0xFu; }
#define XB_SPIN(cond, bar) do { unsigned _sp = 0; while (cond) { __builtin_amdgcn_s_sleep(1); \
    if ((++_sp & 255u) == 0u) { if (xb_ld(&(bar)[XB_TMO])) break; if (_sp > XB_SPIN_CAP) { atomicAdd(&(bar)[XB_TMO], 1u); break; } } } } while (0)
#define XB_GRP 192
struct XcdBar { unsigned* bar; unsigned x, nloc, nx; };
DI void group_barrier(unsigned* bar, unsigned n) {
    asm volatile("s_waitcnt vmcnt(0)" ::: "memory");
    __syncthreads();
    if (threadIdx.x == 0) {
        __builtin_amdgcn_fence(__ATOMIC_RELEASE, "agent");
        asm volatile("s_waitcnt vmcnt(0)" ::: "memory");
        (void)xb_add(&bar[XB_GRP], 1u);
        XB_SPIN(xb_ld(&bar[XB_GRP]) < n, bar);
        __builtin_amdgcn_fence(__ATOMIC_ACQUIRE, "agent");
        asm volatile("s_waitcnt vmcnt(0)" ::: "memory");
    }
    __syncthreads();
}
DI void xcd_barrier(const XcdBar& b) {
    asm volatile("s_waitcnt vmcnt(0)" ::: "memory");
    __syncthreads();
    if (threadIdx.x == 0) {
        unsigned* bar = b.bar;
        __builtin_amdgcn_s_waitcnt(0);
        const unsigned nloc = b.nloc, nx = b.nx;
        const unsigned old = xb_add(&bar[XB_XSUB(b.x)], 1u);
        const unsigned gen = old / nloc;
        if (old + 1u == (gen + 1u) * nloc) {
            __builtin_amdgcn_fence(__ATOMIC_RELEASE, "agent");
            asm volatile("s_waitcnt vmcnt(0)" ::: "memory");
            const unsigned og = xb_add(&bar[XB_TOP], 1u);
            const unsigned tg = og / nx;
            if (og + 1u == (tg + 1u) * nx) xb_add(&bar[XB_TOPGEN], 1u);
            else XB_SPIN(xb_ld(&bar[XB_TOPGEN]) == tg, bar);
            __builtin_amdgcn_fence(__ATOMIC_ACQUIRE, "agent");
            xb_add(&bar[XB_XGEN(b.x)], 1u);
            asm volatile("s_waitcnt vmcnt(0)" ::: "memory");
        } else {
            XB_SPIN(xb_ld(&bar[XB_XGEN(b.x)]) == gen, bar);
            __builtin_amdgcn_fence(__ATOMIC_ACQUIRE, "agent");
            asm volatile("s_waitcnt vmcnt(0)" ::: "memory");
        }
    }
    __syncthreads();
}

DI void scan_phase(const Params& P, unsigned char* lds, const XcdBar& xb) {
    const int G = gridDim.x;
    for (int c = blockIdx.x; c < 384; c += G) scan_chain<0>(P, c, lds);
    const bf16_t* AG = (const bf16_t*)(P.ws + OFF_AG); const bf16_t* WG2 = (const bf16_t*)(P.ws + OFF_WG2); bf16_t* Gb = (bf16_t*)(P.ws + OFF_G);
    if (G > 384 && ((G - 384) & 7) == 0) {
        if ((int)blockIdx.x >= 384) {
            pool_units(P, blockIdx.x - 384, G - 384, lds);
            group_barrier(xb.bar, (unsigned)(G - 384));
            gemm256_phase(AG, 128, WG2, 128, NLAT, 768, 128, EpiStoreBf16{Gb, 768}, lds, (int)blockIdx.x - 384, G - 384);
        }
    } else {
        pool_units(P, blockIdx.x, G, lds);
        xcd_barrier(xb);
        gemm256_phase(AG, 128, WG2, 128, NLAT, 768, 128, EpiStoreBf16{Gb, 768}, lds);
    }
}

#ifndef PHASE_MASK
#define PHASE_MASK 0xffff
#endif
#ifndef PHASE_LIMIT
#define PHASE_LIMIT 100
#endif
#ifndef REP_IDX
#define REP_IDX -1
#endif
#ifndef REP_N
#define REP_N 2
#endif
#define PH(n, idx) if ((((PHASE_MASK) >> (n)) & 1) && ((idx) < (PHASE_LIMIT) || (n) == 8))
__global__ void __launch_bounds__(256, 2) fwd_megakernel(Params P) {
    __shared__ __attribute__((aligned(16))) unsigned char lds[65536];
    cg::grid_group grid = cg::this_grid();
    XcdBar xb; xb.bar = (unsigned*)(P.ws + OFF_BAR); xb.x = xb_xcc_id();
    if (threadIdx.x == 0) (void)xb_add(&xb.bar[XB_XCNT(xb.x)], 1u);
    unsigned char* ws = P.ws;
    const float* MOD = (const float*)(ws + OFF_MOD);
    bf16_t* H = (bf16_t*)(ws + OFF_H);
    float* XLC = (float*)(ws + OFF_XLC);
    PH(0, 0) prep_phase(P, lds);
    grid.sync();
    {
        unsigned mine = 0u, cnt = 0u;
#pragma unroll
        for (unsigned j = 0; j < 16; ++j) { const unsigned c = xb_ld(&xb.bar[XB_XCNT(j)]); cnt += (c > 0u) ? 1u : 0u; mine = (j == xb.x) ? c : mine; }
        xb.nloc = __builtin_amdgcn_readfirstlane(mine > 0u ? mine : 1u); xb.nx = __builtin_amdgcn_readfirstlane(cnt > 0u ? cnt : 1u);
    }
    PH(1, 1) modfinal_phase(P);
    xcd_barrier(xb);
    PH(2, 2) rownorm_phase(P.x, P.ctx, NTOK, P.norm_gain, MOD, 0, 1, H);
    xcd_barrier(xb);
    PH(3, 3) gemm256_phase((const bf16_t*)H, DM, (const bf16_t*)(ws + OFF_WAB_IN), DM, NTOK, 1536, DM, EpiInprojL0{(bf16_t*)(ws + OFF_PL0), P.ab_q_gain, (const float*)(ws + OFF_ROPE), (const float*)(ws + OFF_ROPE) + 2048, P.ab_k_gain, (bf16_t*)(ws + OFF_KB), (bf16_t*)(ws + OFF_VT)}, lds);
    xcd_barrier(xb);
    PH(5, 5) attn_phase(P, lds);
#if REP_IDX == 5
    { xcd_barrier(xb); attn_phase(P, lds); }
#endif
    xcd_barrier(xb);
    PH(3, 6) gemm256_phase((const bf16_t*)H, DM, (const bf16_t*)(ws + OFF_WAB_OUT), DM, NTOK, DM, DM, EpiResidual{P.x, P.ctx, P.out, XLC, MOD, 2}, lds);
    xcd_barrier(xb);
    PH(2, 7) rownorm_phase(P.out, XLC, NTOK, P.norm_gain + 1024, MOD, 3, 4, H);
    xcd_barrier(xb);
    PH(3, 8) gemm256_phase((const bf16_t*)H, DM, (const bf16_t*)(ws + OFF_WFFN_IN), DM, NTOK, 5632, DM, EpiSwiglu{(bf16_t*)(ws + OFF_HID)}, lds);
#if REP_IDX == 8
    { xcd_barrier(xb); gemm256_phase((const bf16_t*)H, DM, (const bf16_t*)(ws + OFF_WFFN_IN), DM, NTOK, 5632, DM, EpiSwiglu{(bf16_t*)(ws + OFF_HID)}, lds); }
#endif
    xcd_barrier(xb);
    PH(3, 9) gemm256_phase((const bf16_t*)(ws + OFF_HID), FFH, (const bf16_t*)(ws + OFF_WFFN_OUT), FFH, NTOK, DM, FFH, EpiResidual{P.out, XLC, P.out, XLC, MOD, 5}, lds);
    xcd_barrier(xb);
    const float* MOD1 = MOD + 9 * 6144;
    PH(2, 10) rownorm_phase(P.out, XLC, NTOK, P.norm_gain + 2048, MOD1, 0, 1, H);
    xcd_barrier(xb);
    PH(3, 11) gemm256_phase((const bf16_t*)H, DM, (const bf16_t*)(ws + OFF_WCD_IN), DM, NTOK, 3072, DM, EpiStoreBf16{(bf16_t*)(ws + OFF_PL1), CDIN}, lds);
    xcd_barrier(xb);
    PH(6, 12) scan_phase(P, lds, xb);
#if REP_IDX == 12
    { xcd_barrier(xb); scan_phase(P, lds, xb); }
#endif
    xcd_barrier(xb);
    PH(7, 13) zpass_phase(P);
    xcd_barrier(xb);
    PH(3, 15) gemm256_phase((const bf16_t*)H, DM, (const bf16_t*)(ws + OFF_WCD_OUT), DM, NLAT, DM, DM, EpiResidual{P.out, XLC, P.out, XLC, MOD1, 2}, lds);
    xcd_barrier(xb);
    PH(2, 16) rownorm_phase(P.out, XLC, NLAT, P.norm_gain + 3072, MOD1, 3, 4, H);
    xcd_barrier(xb);
    PH(3, 17) gemm256_phase((const bf16_t*)H, DM, (const bf16_t*)(ws + OFF_WFFN_IN + WFFN_IN_SZ), DM, NLAT, 5632, DM, EpiSwiglu{(bf16_t*)(ws + OFF_HID)}, lds);
    xcd_barrier(xb);
    PH(3, 18) gemm256_phase((const bf16_t*)(ws + OFF_HID), FFH, (const bf16_t*)(ws + OFF_WFFN_OUT + WFFN_OUT_SZ), FFH, NLAT, DM, FFH, EpiResidual{P.out, XLC, P.out, XLC, MOD1, 5}, lds);
    xcd_barrier(xb);
    PH(8, 19) finalnorm_phase(P);
}

extern "C" void kernel_launch(void* const* d_in, const int* in_sizes, int n_in, void* d_out, int out_size, void* d_ws, size_t ws_size, hipStream_t stream) {
    static int grid_blocks = 0;
    if (!grid_blocks) {
        int dev = 0, cus = 0, per_cu = 0;
        hipGetDevice(&dev);
        hipDeviceGetAttribute(&cus, hipDeviceAttributeMultiprocessorCount, dev);
        hipOccupancyMaxActiveBlocksPerMultiprocessor(&per_cu, (const void*)fwd_megakernel, 256, 0);
        if (per_cu < 1) per_cu = 1;
        if (per_cu > 2) per_cu = 2;
        grid_blocks = cus * per_cu;
    }
    Params p{};
    const float** pp = (const float**)&p;
    for (int i = 0; i < 30; ++i) pp[i] = (const float*)d_in[i];
    p.out = (float*)d_out; p.ws = (unsigned char*)d_ws;
    (void)hipMemsetAsync((unsigned char*)d_ws + OFF_BAR, 0, XCD_BAR_WORDS * 4, stream);
    void* args[] = {&p};
    hipError_t e = hipLaunchCooperativeKernel((const void*)fwd_megakernel, dim3(grid_blocks), dim3(256), args, 0, stream);
    if (e != hipSuccess) fprintf(stderr, "cooperative launch failed: %s (grid %d)\n", hipGetErrorString(e), grid_blocks);
}
```

```cpp
#include <hip/hip_runtime.h>
#include <hip/hip_cooperative_groups.h>
#include <cstdio>
#include <cstdint>
namespace cg = cooperative_groups;

typedef unsigned short bf16_t;
typedef short bf16x8 __attribute__((ext_vector_type(8)));
typedef float f32x4 __attribute__((ext_vector_type(4)));
typedef float f32x16 __attribute__((ext_vector_type(16)));
typedef float f32x2 __attribute__((ext_vector_type(2)));
typedef unsigned u32x4 __attribute__((ext_vector_type(4)));
typedef unsigned u32x2 __attribute__((ext_vector_type(2)));
#define DI __device__ __forceinline__

constexpr int NLAT = 65536, NCTX = 2048, NTOK = NLAT + NCTX, DM = 1024, SEQ = 8192, CTXL = 256;
constexpr int FFH = 2816, CDIN = 2944, KVLEN = SEQ + CTXL;
constexpr float EPS = 1e-6f, LNX_EPS = 64e-5f;
constexpr float QSCALE = 0.125f * 1.4426950408889634f, LOG2E = 1.4426950408889634f;

constexpr size_t MB = 1u << 20;
constexpr size_t OFF_WAB_IN = 0, OFF_WAB_OUT = 3 * MB, OFF_WCD_IN = 5 * MB, OFF_WCD_OUT = 11 * MB, OFF_WFFN_IN = 13 * MB, OFF_WFFN_OUT = 35 * MB,
                 OFF_WG2 = 46 * MB, OFF_MOD = 47 * MB, OFF_MODP = 48 * MB, OFF_ROPE = 52 * MB, OFF_XLC = 53 * MB, OFF_H = 61 * MB, OFF_BIG = 193 * MB;
constexpr size_t OFF_PL0 = OFF_BIG, OFF_KB = OFF_BIG + 198 * MB, OFF_VT = OFF_BIG + 231 * MB;
constexpr size_t OFF_HID = OFF_BIG;
constexpr size_t OFF_PL1 = OFF_BIG, OFF_YF = OFF_BIG + 380 * MB, OFF_YB = OFF_BIG + 476 * MB, OFF_AG = OFF_BIG + 572 * MB, OFF_BONUS = OFF_BIG + 588 * MB;
constexpr size_t OFF_G = OFF_BIG + 600 * MB;
constexpr size_t WFFN_IN_SZ = 11 * MB, WFFN_OUT_SZ = (size_t)1024 * 2816 * 2;

struct Params {
    const float *x, *c, *ctx, *c_ctx, *norm_gain, *ada_w, *ada_b, *ffn_w_in, *ffn_w_out, *final_gain, *ab_w_in, *ab_q_gain, *ab_k_gain, *ab_sink, *ab_w_out,
        *cd_w_in, *cd_mu, *cd_w0, *cd_w2, *cd_a0, *cd_a2, *cd_g2, *cd_k_k, *cd_k_a, *cd_r_k, *cd_lnx_w, *cd_lnx_b, *cd_pool_w, *cd_pool_scale, *cd_w_out;
    float* out; unsigned char* ws;
};

DI float bf2f(bf16_t b) { return __uint_as_float(((unsigned)b) << 16); }
typedef __bf16 bf16x2v __attribute__((ext_vector_type(2)));
DI unsigned pk2(float lo, float hi) { const f32x2 v = {lo, hi}; return __builtin_bit_cast(unsigned, __builtin_convertvector(v, bf16x2v)); }
DI bf16_t f2bf(float f) { return __builtin_bit_cast(bf16_t, (__bf16)f); }
DI float lo16(unsigned u) { return __uint_as_float(u << 16); }
DI float hi16(unsigned u) { return __uint_as_float(u & 0xffff0000u); }
DI float sigmoidf_(float x) { return __builtin_amdgcn_rcpf(1.0f + __builtin_amdgcn_exp2f(-1.4426950408889634f * x)); }
DI float quad_sum(float x) {
    x += __int_as_float(__builtin_amdgcn_mov_dpp(__float_as_int(x), 0xB1, 0xf, 0xf, true));
    x += __int_as_float(__builtin_amdgcn_mov_dpp(__float_as_int(x), 0x4E, 0xf, 0xf, true));
    return x;
}
DI float oct_sum(float x) { x = quad_sum(x); x += __int_as_float(__builtin_amdgcn_mov_dpp(__float_as_int(x), 0x141, 0xf, 0xf, true)); return x; }
DI int otid() { int t = threadIdx.x; asm volatile("" : "+v"(t)); return t; }
DI unsigned swz(int row, int chunk) { return (unsigned)row * 128u + (unsigned)((chunk ^ ((row >> 1) & 7)) << 4); }
#define MFMA32(a, b, c) __builtin_amdgcn_mfma_f32_32x32x16_bf16((a), (b), (c), 0, 0, 0)
#define MFMA16(a, b, c) __builtin_amdgcn_mfma_f32_16x16x32_bf16((a), (b), (c), 0, 0, 0)
DI int crow(int r, int hi) { return (r & 3) + 8 * (r >> 2) + 4 * hi; }

template <class Epi>
DI void gemm_phase(const bf16_t* __restrict__ A, int lda, const bf16_t* __restrict__ Bt, int ldb, int M, int N, int K, const Epi& epi, unsigned char* lds) {
    const int tid = otid(), lane = tid & 63, wave = tid >> 6, wm = wave >> 1, wn = wave & 1;
    const int nNt = N / 128, nk = K / 64;
    const int lr = tid >> 3, lc = tid & 7, l31 = lane & 31, lh = lane >> 5;
    const int G8 = gridDim.x >> 3, xcd = blockIdx.x & 7, lb = blockIdx.x >> 3, mper = (M / 128) >> 3, per = mper * nNt;
    for (int lt = lb; lt < per; lt += G8) {
        const int grp = lt / (8 * nNt), q = lt - grp * 8 * nNt, gs = (mper - grp * 8) < 8 ? (mper - grp * 8) : 8;
        const int tn = q / gs, tm = xcd * mper + grp * 8 + (q - tn * gs);
        const bf16_t* Ag = A + (size_t)(tm * 128 + lr) * lda + lc * 8;
        const bf16_t* Bg = Bt + (size_t)(tn * 128 + lr) * ldb + lc * 8;
        f32x16 acc[2][2];
#pragma unroll
        for (int i = 0; i < 2; ++i)
#pragma unroll
            for (int j = 0; j < 2; ++j)
#pragma unroll
                for (int r = 0; r < 16; ++r) acc[i][j][r] = 0.f;
        u32x4 ra0[4], rb0[4], ra1[4], rb1[4];
#define G_LOAD(RA, RB, KT) { _Pragma("unroll") for (int i = 0; i < 4; ++i) { RA[i] = *(const u32x4*)(Ag + (size_t)(32 * i) * lda + (KT) * 64); RB[i] = *(const u32x4*)(Bg + (size_t)(32 * i) * ldb + (KT) * 64); } }
#define G_STORE(RA, RB, BUF) { _Pragma("unroll") for (int i = 0; i < 4; ++i) { *(u32x4*)((BUF) + swz(lr + 32 * i, lc)) = RA[i]; *(u32x4*)((BUF) + 16384 + swz(lr + 32 * i, lc)) = RB[i]; } }
#define G_COMPUTE(BUF) { _Pragma("unroll") for (int ks = 0; ks < 4; ++ks) { bf16x8 af[2], bfr[2]; \
            _Pragma("unroll") for (int i = 0; i < 2; ++i) { af[i] = *(const bf16x8*)((BUF) + swz(wm * 64 + i * 32 + l31, 2 * ks + lh)); bfr[i] = *(const bf16x8*)((BUF) + 16384 + swz(wn * 64 + i * 32 + l31, 2 * ks + lh)); } \
            _Pragma("unroll") for (int i = 0; i < 2; ++i) _Pragma("unroll") for (int j = 0; j < 2; ++j) acc[i][j] = MFMA32(af[i], bfr[j], acc[i][j]); } }
        G_LOAD(ra0, rb0, 0)
        if (nk > 1) G_LOAD(ra1, rb1, 1)
        G_STORE(ra0, rb0, lds)
        __syncthreads();
        for (int kt = 0; kt < nk; kt += 2) {
            if (kt + 2 < nk) G_LOAD(ra0, rb0, kt + 2)
            G_COMPUTE(lds)
            if (kt + 1 < nk) G_STORE(ra1, rb1, lds + 32768)
            __syncthreads();
            if (kt + 1 < nk) {
                if (kt + 3 < nk) G_LOAD(ra1, rb1, kt + 3)
                G_COMPUTE(lds + 32768)
                if (kt + 2 < nk) G_STORE(ra0, rb0, lds)
                __syncthreads();
            }
        }
#undef G_LOAD
#undef G_STORE
#undef G_COMPUTE
        int lane_e = lane; asm volatile("" : "+v"(lane_e));
        epi.template operator()<2>(acc, tm * 128 + wm * 64, tn * 128 + wn * 64, lane_e);
    }
}

template <class Epi>
DI void gemm256_phase(const bf16_t* __restrict__ A, int lda, const bf16_t* __restrict__ Bt, int ldb, int M, int N, int K, const Epi& epi, unsigned char* lds, int vb = -1, int vn = 0) {
    const int tid = otid(), lane = tid & 63, wave = tid >> 6, wm = wave >> 1, wn = wave & 1;
    const int nNt = N / 256, nk = K / 64;
    const int lr = tid >> 3, lc = tid & 7, l31 = lane & 31, lh = lane >> 5;
    const int bix = vb >= 0 ? vb : (int)blockIdx.x, nbl = vb >= 0 ? vn : (int)gridDim.x;
    const int G8 = nbl >> 3, xcd = bix & 7, lb = bix >> 3, mper = (M / 128) >> 3, per = mper * nNt;
    const unsigned c0 = (unsigned)(lh ^ ((l31 >> 1) & 7)), roA = (unsigned)(wm * 8192 + l31 * 128), roB = (unsigned)(16384 + wn * 16384 + l31 * 128);
    for (int lt = lb; lt < per; lt += G8) {
        const int grp = lt / (8 * nNt), q = lt - grp * 8 * nNt, gs = (mper - grp * 8) < 8 ? (mper - grp * 8) : 8;
        const int tn = q / gs, tm = xcd * mper + grp * 8 + (q - tn * gs);
        const bf16_t* Au = A + (size_t)(tm * 128) * lda;
        const bf16_t* Bu = Bt + (size_t)(tn * 256) * ldb;
        const unsigned voA = (unsigned)(lr * lda + lc * 8), voB = (unsigned)(lr * ldb + lc * 8);
        f32x16 acc[2][4];
#pragma unroll
        for (int i = 0; i < 2; ++i)
#pragma unroll
            for (int j = 0; j < 4; ++j)
#pragma unroll
                for (int r = 0; r < 16; ++r) acc[i][j][r] = 0.f;
        u32x4 ra[4], rb[8];
#pragma unroll
        for (int i = 0; i < 4; ++i) ra[i] = *(const u32x4*)((Au + (size_t)(32 * i) * lda) + voA);
#pragma unroll
        for (int i = 0; i < 8; ++i) rb[i] = *(const u32x4*)((Bu + (size_t)(32 * i) * ldb) + voB);
        for (int kt = 0; kt < nk; ++kt) {
#pragma unroll
            for (int i = 0; i < 4; ++i) *(u32x4*)(lds + swz(lr + 32 * i, lc)) = ra[i];
#pragma unroll
            for (int i = 0; i < 8; ++i) *(u32x4*)(lds + 16384 + swz(lr + 32 * i, lc)) = rb[i];
            __syncthreads();
            if (kt + 1 < nk) {
#pragma unroll
                for (int i = 0; i < 4; ++i) ra[i] = *(const u32x4*)((Au + (size_t)(32 * i) * lda + (kt + 1) * 64) + voA);
#pragma unroll
                for (int i = 0; i < 8; ++i) rb[i] = *(const u32x4*)((Bu + (size_t)(32 * i) * ldb + (kt + 1) * 64) + voB);
            }
            __builtin_amdgcn_s_setprio(1);
#pragma unroll 2
            for (int ks = 0; ks < 4; ++ks) {
                bf16x8 af[2], bfr[4];
                const unsigned xo = (c0 ^ (unsigned)(2 * ks)) << 4;
#pragma unroll
                for (int i = 0; i < 2; ++i) af[i] = *(const bf16x8*)(lds + (roA + xo) + i * 4096);
#pragma unroll
                for (int j = 0; j < 4; ++j) bfr[j] = *(const bf16x8*)(lds + (roB + xo) + j * 4096);
#pragma unroll
                for (int i = 0; i < 2; ++i)
#pragma unroll
                    for (int j = 0; j < 4; ++j) acc[i][j] = MFMA32(af[i], bfr[j], acc[i][j]);
            }
            __builtin_amdgcn_s_setprio(0);
            __syncthreads();
        }
        int lane_e = lane; asm volatile("" : "+v"(lane_e));
        epi.template operator()<4>(acc, tm * 128 + wm * 64, tn * 256 + wn * 128, lane_e);
    }
}

DI int cu(int r) { return (r & 3) + 8 * (r >> 2); }
struct EpiStoreBf16 {
    bf16_t* C; int ldc;
    template <int NI> DI void operator()(const f32x16 (&acc)[2][NI], int row0, int col0, int lane) const {
        if (col0 >= ldc) return;
        const unsigned lo = (unsigned)(4 * (lane >> 5) * ldc + (lane & 31));
        bf16_t* base = C + (size_t)row0 * ldc + col0;
#pragma unroll
        for (int mi = 0; mi < 2; ++mi)
#pragma unroll
            for (int ni = 0; ni < NI; ++ni)
#pragma unroll
                for (int r = 0; r < 16; ++r) (base + (size_t)(32 * mi + cu(r)) * ldc + 32 * ni)[lo] = f2bf(acc[mi][ni][r]);
    }
};
struct EpiResidual {
    const float* srcL; const float* srcC; float* dstL; float* dstC; const float* mod; int gate_idx;
    template <int NI> DI void operator()(const f32x16 (&acc)[2][NI], int row0, int col0, int lane) const {
        const bool lat = row0 < NLAT;
        const float* src = (lat ? srcL + (size_t)row0 * DM : srcC + (size_t)(row0 - NLAT) * DM) + col0;
        float* dst = (lat ? dstL + (size_t)row0 * DM : dstC + (size_t)(row0 - NLAT) * DM) + col0;
        const float* g = mod + ((lat ? (row0 >> 13) : 8) * 6 + gate_idx) * 1024 + col0;
        const unsigned l31 = lane & 31, lo = (unsigned)(4 * (lane >> 5) * DM) + l31;
#pragma unroll
        for (int ni = 0; ni < NI; ++ni) {
            const float gv = (g + 32 * ni)[l31];
            float sv[32];
#pragma unroll
            for (int q = 0; q < 32; ++q) sv[q] = __builtin_nontemporal_load(&(src + (32 * (q >> 4) + cu(q & 15)) * DM + 32 * ni)[lo]);
#pragma unroll
            for (int q = 0; q < 32; ++q) (dst + (32 * (q >> 4) + cu(q & 15)) * DM + 32 * ni)[lo] = sv[q] + gv * acc[q >> 4][ni][q & 15];
            asm volatile("" ::: "memory");
        }
    }
};
struct EpiInprojL0 {
    bf16_t* C; const float* qgain; const float* ct; const float* st; const float* kgain; bf16_t* KB; bf16_t* VT;
    template <int NI> DI void operator()(const f32x16 (&acc)[2][NI], int row0, int col0, int lane) const {
        const int l31 = lane & 31, lh = lane >> 5;
        const unsigned lo = (unsigned)(4 * lh * 1536 + l31);
        bf16_t* base = C + (size_t)row0 * 1536 + col0;
        const bool lat = row0 < NLAT;
        const int tlane = (row0 & 8191) + 4 * lh;
        if (col0 >= 1024) {
            const int j = (col0 - 1024) >> 7;
            const int bb = lat ? (row0 >> 13) : ((row0 - NLAT) >> 8), pos0 = lat ? (row0 & 8191) : SEQ + ((row0 - NLAT) & 255);
            if (j & 1) {
#pragma unroll
                for (int hp = 0; hp < NI / 2; ++hp) {
                    bf16_t* vb = VT + ((size_t)(bb * 4 + 2 * (j >> 1) + hp) * 64) * KVLEN + pos0;
                    const unsigned vlo = (unsigned)(l31 * KVLEN + 8 * lh);
#pragma unroll
                    for (int mi = 0; mi < 2; ++mi)
#pragma unroll
                        for (int g = 0; g < 4; ++g) {
                            bf16_t* p = vb + 16 * (2 * mi + (g >> 1)) + 4 * (g & 1);
                            u32x2 w1, w2;
                            w1.x = pk2(acc[mi][2 * hp][4 * g], acc[mi][2 * hp][4 * g + 1]); w1.y = pk2(acc[mi][2 * hp][4 * g + 2], acc[mi][2 * hp][4 * g + 3]);
                            w2.x = pk2(acc[mi][2 * hp + 1][4 * g], acc[mi][2 * hp + 1][4 * g + 1]); w2.y = pk2(acc[mi][2 * hp + 1][4 * g + 2], acc[mi][2 * hp + 1][4 * g + 3]);
                            *(u32x2*)(p + vlo) = w1; *(u32x2*)(p + (size_t)32 * KVLEN + vlo) = w2;
                        }
                }
                return;
            }
            const bool isBk = j == 2;
            const float kg1 = kgain[l31], kg2 = kgain[l31 + 32];
            const unsigned klo = (unsigned)(4 * lh * 64 + l31);
#pragma unroll
            for (int mi = 0; mi < 2; ++mi)
#pragma unroll
                for (int r = 0; r < 16; ++r) {
                    float c = 1.f, sn = 0.f;
                    if (lat) { const int t = tlane + 32 * mi + cu(r); const int pos = l31 < 16 ? (t >> 6) : (t & 63); c = ct[pos * 16 + (l31 & 15)]; sn = st[pos * 16 + (l31 & 15)]; }
#pragma unroll
                    for (int hp = 0; hp < NI / 2; ++hp) {
                        float x1 = acc[mi][2 * hp][r], x2 = acc[mi][2 * hp + 1][r];
                        if (isBk) {
                            float ss = x1 * x1 + x2 * x2;
#pragma unroll
                            for (int o = 16; o > 0; o >>= 1) ss += __shfl_xor(ss, o);
                            const float rs = rsqrtf(ss * (1.0f / 64.0f) + EPS);
                            x1 = x1 * rs * kg1; x2 = x2 * rs * kg2;
                        }
                        const float o1 = x1 * c - x2 * sn, o2 = x2 * c + x1 * sn;
                        bf16_t* p = KB + ((size_t)(bb * 4 + 2 * (j >> 1) + hp) * KVLEN + pos0 + 32 * mi + cu(r)) * 64;
                        p[klo] = f2bf(o1); (p + 32)[klo] = f2bf(o2);
                    }
                }
            return;
        }
        const bool isB = col0 >= 512;
        const float g1 = qgain[l31], g2 = qgain[l31 + 32];
#pragma unroll
        for (int mi = 0; mi < 2; ++mi)
#pragma unroll
            for (int r = 0; r < 16; ++r) {
                float c = 1.f, sn = 0.f;
                if (lat) { const int t = tlane + 32 * mi + cu(r); const int pos = l31 < 16 ? (t >> 6) : (t & 63); c = ct[pos * 16 + (l31 & 15)]; sn = st[pos * 16 + (l31 & 15)]; }
#pragma unroll
                for (int hp = 0; hp < NI / 2; ++hp) {
                    float x1 = acc[mi][2 * hp][r], x2 = acc[mi][2 * hp + 1][r];
                    if (isB) {
                        float ss = x1 * x1 + x2 * x2;
#pragma unroll
                        for (int o = 16; o > 0; o >>= 1) ss += __shfl_xor(ss, o);
                        const float rs = rsqrtf(ss * (1.0f / 64.0f) + EPS);
                        x1 = x1 * rs * g1; x2 = x2 * rs * g2;
                    }
                    const float o1 = x1 * c - x2 * sn, o2 = x2 * c + x1 * sn;
                    bf16_t* p = base + (size_t)(32 * mi + cu(r)) * 1536 + 64 * hp;
                    p[lo] = f2bf(o1 * QSCALE); (p + 32)[lo] = f2bf(o2 * QSCALE);
                }
            }
    }
};
struct EpiSwiglu {
    bf16_t* Hd;
    template <int NI> DI void operator()(const f32x16 (&acc)[2][NI], int row0, int col0, int lane) const {
        const unsigned lo = (unsigned)(4 * (lane >> 5) * FFH + (lane & 31));
        bf16_t* base = Hd + (size_t)row0 * FFH + (col0 >> 1);
#pragma unroll
        for (int pr = 0; pr < NI / 2; ++pr)
#pragma unroll
            for (int mi = 0; mi < 2; ++mi)
#pragma unroll
                for (int r = 0; r < 16; ++r) { const float g = acc[mi][2 * pr][r], u = acc[mi][2 * pr + 1][r]; __builtin_nontemporal_store(f2bf(g * sigmoidf_(g) * u), &(base + (32 * mi + cu(r)) * FFH + 32 * pr)[lo]); }
    }
};
struct EpiGateMul {
    bf16_t* Y;
    template <int NI> DI void operator()(const f32x16 (&acc)[2][NI], int row0, int col0, int lane) const {
        const unsigned lo = (unsigned)(4 * (lane >> 5) * DM + (lane & 31));
        bf16_t* base = Y + (size_t)row0 * DM + col0;
#pragma unroll
        for (int mi = 0; mi < 2; ++mi)
#pragma unroll
            for (int ni = 0; ni < NI; ++ni)
#pragma unroll
                for (int r = 0; r < 16; ++r) { bf16_t* p = base + (32 * mi + cu(r)) * DM + 32 * ni; p[lo] = f2bf(bf2f(p[lo]) * acc[mi][ni][r]); }
    }
};

DI void transpose_tile(const float* __restrict__ W, int ldw, int K, bf16_t* __restrict__ Wt, int k0, int n0, int ffn_map, float* t  ) {
    const int tid = otid();
    {
        const int n = tid & 63; int src = n0 + n;
        if (ffn_map) { const int np = n0 + n; const int j32 = np >> 6, s = (np >> 5) & 1, i = np & 31; src = s * FFH + j32 * 32 + i; }
#pragma unroll
        for (int i = 0; i < 16; ++i) { const int k = i * 4 + (tid >> 6); t[k * 65 + n] = W[(size_t)(k0 + k) * ldw + src]; }
    }
    __syncthreads();
#pragma unroll
    for (int i = 0; i < 2; ++i) {
        const int n = (tid >> 3) + 32 * i, kc = tid & 7;
        u32x4 v;
        v.x = pk2(t[(kc * 8 + 0) * 65 + n], t[(kc * 8 + 1) * 65 + n]); v.y = pk2(t[(kc * 8 + 2) * 65 + n], t[(kc * 8 + 3) * 65 + n]);
        v.z = pk2(t[(kc * 8 + 4) * 65 + n], t[(kc * 8 + 5) * 65 + n]); v.w = pk2(t[(kc * 8 + 6) * 65 + n], t[(kc * 8 + 7) * 65 + n]);
        *(u32x4*)(Wt + (size_t)(n0 + n) * K + k0 + kc * 8) = v;
    }
    __syncthreads();
}
DI void prep_phase(const Params& P, unsigned char* lds) {
    float* t = (float*)lds;
    unsigned char* ws = P.ws;
    for (int j = blockIdx.x; j < 5880; j += gridDim.x) {
        const float* W; int ldw, K, Nout, map = 0, jj = j; bf16_t* Wt;
        if (jj < 384) { W = P.ab_w_in; ldw = 1536; K = 1024; Nout = 1536; Wt = (bf16_t*)(ws + OFF_WAB_IN); }
        else if ((jj -= 384) < 256) { W = P.ab_w_out; ldw = 1024; K = 1024; Nout = 1024; Wt = (bf16_t*)(ws + OFF_WAB_OUT); }
        else if ((jj -= 256) < 736) { W = P.cd_w_in; ldw = CDIN; K = 1024; Nout = CDIN; Wt = (bf16_t*)(ws + OFF_WCD_IN); }
        else if ((jj -= 736) < 256) { W = P.cd_w_out; ldw = 1024; K = 1024; Nout = 1024; Wt = (bf16_t*)(ws + OFF_WCD_OUT); }
        else if ((jj -= 256) < 2816) { const int l = jj / 1408; jj -= l * 1408; W = P.ffn_w_in + (size_t)l * 1024 * 5632; ldw = 5632; K = 1024; Nout = 5632; map = 1; Wt = (bf16_t*)(ws + OFF_WFFN_IN + l * WFFN_IN_SZ); }
        else if ((jj -= 2816) < 1408) { const int l = jj / 704; jj -= l * 704; W = P.ffn_w_out + (size_t)l * FFH * 1024; ldw = 1024; K = FFH; Nout = 1024; Wt = (bf16_t*)(ws + OFF_WFFN_OUT + l * WFFN_OUT_SZ); }
        else { jj -= 1408; W = P.cd_g2; ldw = 768; K = 128; Nout = 768; Wt = (bf16_t*)(ws + OFF_WG2); }
        const int nNt = Nout / 64; const int kt = jj / nNt, nt = jj - kt * nNt;
        transpose_tile(W, ldw, K, Wt, kt * 64, nt * 64, map, t);
    }
    float* MODP = (float*)(ws + OFF_MODP);
    for (int j = blockIdx.x; j < 384; j += gridDim.x) {
        const int l = j / 192, r2 = j % 192, ks = r2 / 24, cb = r2 % 24;
        const int tid = otid();
        __syncthreads();
        for (int e = tid; e < 9 * 128; e += 256) { const int r = e >> 7, kk = e & 127; const float v = r < 8 ? P.c[r * 1024 + ks * 128 + kk] : P.c_ctx[ks * 128 + kk]; t[e] = v * sigmoidf_(v); }
        __syncthreads();
        const int col = cb * 256 + tid;
        const float* w = P.ada_w + ((size_t)l * 1024 + ks * 128) * 6144 + col;
        float a[9];
#pragma unroll
        for (int r = 0; r < 9; ++r) a[r] = 0.f;
#pragma unroll 4
        for (int kk = 0; kk < 128; ++kk) { const float wv = w[(size_t)kk * 6144];
#pragma unroll
            for (int r = 0; r < 9; ++r) a[r] += t[r * 128 + kk] * wv; }
#pragma unroll
        for (int r = 0; r < 9; ++r) MODP[((size_t)(ks * 2 + l) * 9 + r) * 6144 + col] = a[r];
    }
    if (blockIdx.x == 0) {
        float* ct = (float*)(ws + OFF_ROPE); float* st = ct + 2048;
        for (int e = otid(); e < 2048; e += 256) {
            const int pos = e >> 4, j = e & 15;
            const float inv = exp2f(-(float)j * (13.287712379549449f / 16.0f));
            const float ang = (float)pos * inv;
            double rev = (double)ang * 0.15915494309189535; rev -= floor(rev);
            const float rv = (float)rev;
            ct[e] = __builtin_amdgcn_cosf(rv); st[e] = __builtin_amdgcn_sinf(rv);
        }
    }
}
DI void modfinal_phase(const Params& P) {
    const float* MODP = (const float*)(P.ws + OFF_MODP); float* MOD = (float*)(P.ws + OFF_MOD);
    for (int e = blockIdx.x * 256 + otid(); e < 2 * 9 * 6144; e += gridDim.x * 256) {
        const int l = e / (9 * 6144), col = e % 6144;
        float s = P.ada_b[l * 6144 + col];
#pragma unroll
        for (int ks = 0; ks < 8; ++ks) s += MODP[(size_t)ks * (2 * 9 * 6144) + e];
        MOD[e] = s;
    }
}

DI void rownorm_phase(const float* srcL, const float* srcC, int M, const float* __restrict__ gain, const float* __restrict__ mod, int shift_idx, int scale_idx, bf16_t* __restrict__ H) {
    const int lane = otid() & 63, wave = otid() >> 6;
    for (int row = blockIdx.x * 4 + wave; row < M; row += gridDim.x * 4) {
        const bool lat = row < NLAT;
        const float* src = lat ? srcL + (size_t)row * DM : srcC + (size_t)(row - NLAT) * DM;
        const float* mrow = mod + (lat ? (row >> 13) : 8) * 6144;
        f32x4 v[4]; float ss = 0.f;
#pragma unroll
        for (int i = 0; i < 4; ++i) { v[i] = __builtin_nontemporal_load((const f32x4*)(src + (i * 64 + lane) * 4)); ss += v[i].x * v[i].x + v[i].y * v[i].y + v[i].z * v[i].z + v[i].w * v[i].w; }
#pragma unroll
        for (int o = 32; o > 0; o >>= 1) ss += __shfl_xor(ss, o);
        const float rs = rsqrtf(ss * (1.0f / 1024.0f) + EPS);
#pragma unroll
        for (int i = 0; i < 4; ++i) {
            const int col = (i * 64 + lane) * 4;
            const f32x4 g = *(const f32x4*)(gain + col), sc = *(const f32x4*)(mrow + scale_idx * 1024 + col), sh = *(const f32x4*)(mrow + shift_idx * 1024 + col);
            const f32x4 y = (v[i] * rs * g) * (sc + 1.0f) + sh;
            u32x2 o; o.x = pk2(y.x, y.y); o.y = pk2(y.z, y.w);
            *(u32x2*)(H + (size_t)row * DM + col) = o;
        }
    }
}
DI void finalnorm_phase(const Params& P) {
    const int lane = otid() & 63, wave = otid() >> 6;
    for (int row = blockIdx.x * 4 + wave; row < NLAT; row += gridDim.x * 4) {
        float* src = P.out + (size_t)row * DM;
        f32x4 v[4]; float ss = 0.f;
#pragma unroll
        for (int i = 0; i < 4; ++i) { v[i] = __builtin_nontemporal_load((const f32x4*)(src + (i * 64 + lane) * 4)); ss += v[i].x * v[i].x + v[i].y * v[i].y + v[i].z * v[i].z + v[i].w * v[i].w; }
#pragma unroll
        for (int o = 32; o > 0; o >>= 1) ss += __shfl_xor(ss, o);
        const float rs = rsqrtf(ss * (1.0f / 1024.0f) + EPS);
#pragma unroll
        for (int i = 0; i < 4; ++i) { const int col = (i * 64 + lane) * 4; *(f32x4*)(src + col) = v[i] * rs * *(const f32x4*)(P.final_gain + col); }
    }
}

DI void qkprep_phase(const Params& P) {
    bf16_t* PL = (bf16_t*)(P.ws + OFF_PL0); bf16_t* KB = (bf16_t*)(P.ws + OFF_KB); bf16_t* VT = (bf16_t*)(P.ws + OFF_VT);
    const float* ct = (const float*)(P.ws + OFF_ROPE); const float* st = ct + 2048;
    const int tid = otid(), hw = tid >> 5, i = tid & 31;
    for (int unit = blockIdx.x; unit < NTOK / 64; unit += gridDim.x) {
        const int row0 = unit * 64; const bool lat = row0 < NLAT;
        const int b = lat ? (row0 >> 13) : ((row0 - NLAT) >> 8);
        const int pos0 = lat ? (row0 & 8191) : SEQ + ((row0 - NLAT) & 255);
        for (int it = 0; it < 8; ++it) {
            float xa[4], xb[4];
#pragma unroll
            for (int u = 0; u < 4; ++u) {
                const int task = hw + 8 * (4 * it + u); const int tok = task >> 2, slot = 16 + (task & 3);
                const int col = slot < 16 ? slot * 64 : (slot < 18 ? 1024 + (slot - 16) * 64 : 1280 + (slot - 18) * 64);
                const bf16_t* p = PL + (size_t)(row0 + tok) * 1536 + col;
                xa[u] = bf2f(p[i]); xb[u] = bf2f(p[i + 32]);
            }
#pragma unroll
            for (int u = 0; u < 4; ++u) {
                const int task = hw + 8 * (4 * it + u); const int tok = task >> 2, slot = 16 + (task & 3);
                const int col = slot < 16 ? slot * 64 : (slot < 18 ? 1024 + (slot - 16) * 64 : 1280 + (slot - 18) * 64);
                bf16_t* p = PL + (size_t)(row0 + tok) * 1536 + col;
                float x1 = xa[u], x2 = xb[u];
                const bool isB = (slot >= 8 && slot < 16) || slot >= 18;
                if (isB) {
                    float ss = x1 * x1 + x2 * x2;
#pragma unroll
                    for (int o = 16; o > 0; o >>= 1) ss += __shfl_xor(ss, o);
                    const float rs = rsqrtf(ss * (1.0f / 64.0f) + EPS);
                    const float* g = slot < 16 ? P.ab_q_gain : P.ab_k_gain;
                    x1 = x1 * rs * g[i]; x2 = x2 * rs * g[i + 32];
                }
                if (lat) {
                    const int t = pos0 + tok; const int pos = i < 16 ? (t >> 6) : (t & 63);
                    const float c = ct[pos * 16 + (i & 15)], sn = st[pos * 16 + (i & 15)];
                    const float o1 = x1 * c - x2 * sn, o2 = x2 * c + x1 * sn; x1 = o1; x2 = o2;
                }
                if (slot < 16) { p[i] = f2bf(x1 * QSCALE); p[i + 32] = f2bf(x2 * QSCALE); }
                else { bf16_t* kp = KB + ((size_t)(b * 4 + (slot - 16)) * KVLEN + pos0 + tok) * 64; kp[i] = f2bf(x1); kp[i + 32] = f2bf(x2); }
            }
        }
        const int d = tid & 63, tg = tid >> 6;
#pragma unroll
        for (int vs = 0; vs < 4; ++vs) {
            const int col = 1024 + (vs < 2 ? 128 + vs * 64 : 384 + (vs - 2) * 64);
            const bf16_t* src = PL + (size_t)(row0 + 16 * tg) * 1536 + col + d;
            unsigned v[16];
#pragma unroll
            for (int j = 0; j < 16; ++j) v[j] = src[(size_t)j * 1536];
            u32x4 a, bq;
            a.x = v[0] | (v[1] << 16); a.y = v[2] | (v[3] << 16); a.z = v[8] | (v[9] << 16); a.w = v[10] | (v[11] << 16);
            bq.x = v[4] | (v[5] << 16); bq.y = v[6] | (v[7] << 16); bq.z = v[12] | (v[13] << 16); bq.w = v[14] | (v[15] << 16);
            bf16_t* dst = VT + ((size_t)(b * 4 + vs) * 64 + d) * KVLEN + pos0 + 16 * tg;
            *(u32x4*)dst = a; *(u32x4*)(dst + 8) = bq;
        }
    }
}

DI void attn_phase(const Params& P, unsigned char* lds) {
    const bf16_t* PL = (const bf16_t*)(P.ws + OFF_PL0); const bf16_t* KB = (const bf16_t*)(P.ws + OFF_KB); const bf16_t* VT = (const bf16_t*)(P.ws + OFF_VT);
    bf16_t* Y = (bf16_t*)(P.ws + OFF_H);
    const int tid = otid(), lane = tid & 63, wave = tid >> 6, l31 = lane & 31, lh = lane >> 5;
    const int lr = tid >> 3, lc = tid & 7;
    for (int unit = blockIdx.x; unit < 8448; unit += gridDim.x) {
        int b, hq, kvh, qrow0, nW, wlo, qpos0 = 0; bool masked = false, has_sink;
        if (unit < 8192) {
            const int u = unit & 4095; b = u >> 9; const int r = u & 511, kvl = r >> 8, hl = (r >> 6) & 3, qb = r & 63;
            qrow0 = b * SEQ + qb * 128; qpos0 = qb * 128;
            if (unit < 4096) { hq = 8 + kvl * 4 + hl; kvh = 2 + kvl; nW = 132; wlo = 0; has_sink = false; }
            else { hq = kvl * 4 + hl; kvh = kvl; masked = true; has_sink = true;
                   const int s0 = qpos0 - 128 < 0 ? 0 : qpos0 - 128, s1 = qpos0 + 256 > SEQ ? SEQ : qpos0 + 256; wlo = s0 >> 6; nW = (s1 >> 6) - wlo; }
        } else { const int u = unit - 8192; b = u >> 5; hq = (u >> 1) & 15; const int qb = u & 1; kvh = hq < 8 ? (hq >> 2) : 2 + ((hq - 8) >> 2);
                 qrow0 = NLAT + b * CTXL + qb * 128; nW = 0; wlo = 0; has_sink = hq < 8; }
        const int nt = masked ? nW + 4 : (nW ? nW : 4);
        const int qrow = qrow0 + 32 * wave + l31;
        const int qpos = qpos0 + 32 * wave + l31;
        bf16x8 qf[4];
        { const bf16_t* qp = PL + (size_t)qrow * 1536 + hq * 64 + 8 * lh;
#pragma unroll
          for (int ks = 0; ks < 4; ++ks) qf[ks] = *(const bf16x8*)(qp + 16 * ks); }
        f32x16 o[2];
#pragma unroll
        for (int r = 0; r < 16; ++r) { o[0][r] = 0.f; o[1][r] = 0.f; }
        float m = -1e30f, l = 0.f;
        const bf16_t* kbase = KB + (size_t)(b * 4 + kvh) * KVLEN * 64;
        const bf16_t* vbase = VT + (size_t)(b * 4 + kvh) * 64 * KVLEN;
        u32x4 rk[2], rv[2];
        auto tile_of = [&](int i) __attribute__((always_inline)) { return (masked && i >= nW) ? 128 + (i - nW) : wlo + i + ((!masked && nW == 0) ? 128 : 0); };
        {
            const int p0 = tile_of(0) * 64;
#pragma unroll
            for (int j = 0; j < 2; ++j) { rk[j] = *(const u32x4*)(kbase + (size_t)(p0 + lr + 32 * j) * 64 + lc * 8); rv[j] = *(const u32x4*)(vbase + (size_t)(lr + 32 * j) * KVLEN + p0 + lc * 8); }
#pragma unroll
            for (int j = 0; j < 2; ++j) { *(u32x4*)(lds + swz(lr + 32 * j, lc)) = rk[j]; *(u32x4*)(lds + 8192 + swz(lr + 32 * j, lc)) = rv[j]; }
        }
        __syncthreads();
        for (int i = 0; i < nt; ++i) {
            unsigned char* cur = lds + (i & 1) * 16384; unsigned char* nxt = lds + ((i + 1) & 1) * 16384;
            const int p0 = tile_of(i) * 64; const bool more = i + 1 < nt;
            if (more) { const int p1 = tile_of(i + 1) * 64;
#pragma unroll
                for (int j = 0; j < 2; ++j) { rk[j] = *(const u32x4*)(kbase + (size_t)(p1 + lr + 32 * j) * 64 + lc * 8); rv[j] = *(const u32x4*)(vbase + (size_t)(lr + 32 * j) * KVLEN + p1 + lc * 8); } }
            const bool wtile = masked && i < nW;
            bool active = true;
            if (wtile) { const int qmin = qpos0 + 32 * wave; active = (p0 <= qmin + 31 + 128) && (p0 + 63 >= qmin - 128); }
            if (active) {
                f32x16 s[2];
                __builtin_amdgcn_s_setprio(1);
#pragma unroll
                for (int kt = 0; kt < 2; ++kt) {
#pragma unroll
                    for (int r = 0; r < 16; ++r) s[kt][r] = 0.f;
#pragma unroll
                    for (int ks = 0; ks < 4; ++ks) { const bf16x8 kf = *(const bf16x8*)(cur + swz(32 * kt + l31, 2 * ks + lh)); s[kt] = MFMA32(kf, qf[ks], s[kt]); }
                }
                __builtin_amdgcn_s_setprio(0);
                if (wtile) {
#pragma unroll
                    for (int kt = 0; kt < 2; ++kt)
#pragma unroll
                        for (int r = 0; r < 16; ++r) { const int kp = p0 + 32 * kt + crow(r, lh); const int dlt = qpos - kp; if (dlt > 128 || dlt < -128) s[kt][r] = -INFINITY; }
                }
                float mx = s[0][0];
#pragma unroll
                for (int kt = 0; kt < 2; ++kt)
#pragma unroll
                    for (int r = 0; r < 16; ++r) mx = fmaxf(mx, s[kt][r]);
                mx = fmaxf(mx, __shfl_xor(mx, 32));
                const float mn = (mx > m + 8.0f) ? mx : m;
                if (__builtin_amdgcn_ballot_w64(mn != m) != 0ull) {
                    const float alpha = __builtin_amdgcn_exp2f(m - mn);
                    l *= alpha;
#pragma unroll
                    for (int r = 0; r < 16; ++r) { o[0][r] *= alpha; o[1][r] *= alpha; }
                    m = mn;
                }
                float ps = 0.f;
#pragma unroll
                for (int kt = 0; kt < 2; ++kt)
#pragma unroll
                    for (int r = 0; r < 16; ++r) { const float pv = __builtin_amdgcn_exp2f(s[kt][r] - mn); s[kt][r] = pv; ps += pv; }
                l += ps;
                __builtin_amdgcn_s_setprio(1);
#pragma unroll
                for (int kt = 0; kt < 2; ++kt)
#pragma unroll
                    for (int sx = 0; sx < 2; ++sx) {
                        union { u32x4 u; bf16x8 h; } pf;
                        pf.u.x = pk2(s[kt][8 * sx + 0], s[kt][8 * sx + 1]); pf.u.y = pk2(s[kt][8 * sx + 2], s[kt][8 * sx + 3]);
                        pf.u.z = pk2(s[kt][8 * sx + 4], s[kt][8 * sx + 5]); pf.u.w = pk2(s[kt][8 * sx + 6], s[kt][8 * sx + 7]);
#pragma unroll
                        for (int dt = 0; dt < 2; ++dt) { const bf16x8 vf = *(const bf16x8*)(cur + 8192 + swz(32 * dt + l31, 2 * (2 * kt + sx) + lh)); o[dt] = MFMA32(vf, pf.h, o[dt]); }
                    }
                __builtin_amdgcn_s_setprio(0);
            }
            if (more) {
#pragma unroll
                for (int j = 0; j < 2; ++j) { *(u32x4*)(nxt + swz(lr + 32 * j, lc)) = rk[j]; *(u32x4*)(nxt + 8192 + swz(lr + 32 * j, lc)) = rv[j]; }
            }
            __syncthreads();
        }
        l += __shfl_xor(l, 32);
        if (has_sink) l += __builtin_amdgcn_exp2f(P.ab_sink[hq] * LOG2E - m);
        const float inv = 1.0f / l;
        bf16_t* yp = Y + (size_t)qrow * DM + hq * 64 + 4 * lh;
#pragma unroll
        for (int dt = 0; dt < 2; ++dt)
#pragma unroll
            for (int g = 0; g < 4; ++g) { u32x2 w; w.x = pk2(o[dt][4 * g] * inv, o[dt][4 * g + 1] * inv); w.y = pk2(o[dt][4 * g + 2] * inv, o[dt][4 * g + 3] * inv); *(u32x2*)(yp + 32 * dt + 8 * g) = w; }
    }
}

DI float mix1(const bf16_t* p, bool hp, bool hn, float mu) {
    const float x = bf2f(p[0]); const float xp = hp ? bf2f(*(p - CDIN)) : 0.f; const float xn = hn ? bf2f(*(p + CDIN)) : 0.f;
    return x + (0.5f * (xp + xn) - x) * mu;
}
DI void mix8(const bf16_t* p, bool hp, bool hn, const float (&mu)[8], float (&o)[8]) {
    const u32x4 z = {0u, 0u, 0u, 0u};
    const u32x4 x = *(const u32x4*)p; const u32x4 xp = hp ? *(const u32x4*)(p - CDIN) : z; const u32x4 xn = hn ? *(const u32x4*)(p + CDIN) : z;
#pragma unroll
    for (int i = 0; i < 4; ++i) {
        const float a0 = lo16(x[i]), a1 = hi16(x[i]);
        o[2 * i] = a0 + (0.5f * (lo16(xp[i]) + lo16(xn[i])) - a0) * mu[2 * i];
        o[2 * i + 1] = a1 + (0.5f * (hi16(xp[i]) + hi16(xn[i])) - a1) * mu[2 * i + 1];
    }
}
template <int MODE>
DI void scan_chain(const Params& P, int chain, unsigned char* lds) {
    const int otid_ = otid(); const int lane = otid_ & 63, wave = (otid_ >> 6) ^ (((((int)blockIdx.x >> 8) ^ (int)blockIdx.x) & 1) ? 2 : 0), tid = wave * 64 + lane;
    const int half = chain & 1, chn = chain >> 1;
    const int b = chn / 24, rem = chn % 24, h = rem >> 1, dir = rem & 1;
    const bf16_t* PL = (const bf16_t*)(P.ws + OFF_PL1);
    bf16_t* Yd = (bf16_t*)(P.ws + (dir ? OFF_YB : OFF_YF));
    float* BON = (float*)(P.ws + OFF_BONUS) + (size_t)dir * NLAT * 12;
    float* buf = (float*)lds;
    float* ybuf = buf + 2 * 6144;
    const int NCH = 528;
    f32x2 S0[4], S1[4];
#pragma unroll
    for (int j = 0; j < 4; ++j) { S0[j] = (f32x2){0.f, 0.f}; S1[j] = (f32x2){0.f, 0.f}; }
    const int q8 = lane & 7, r0 = 32 * half + 16 * (wave & 1) + (lane >> 3), r1 = r0 + 8;
    const int kg = lane >> 4, n16 = lane & 15;
    bf16x8 lf[4][2];
    if (wave >= 2) {
        const float* l2 = (wave == 2 ? P.cd_a2 : P.cd_w2) + (size_t)dir * 64 * 768;
#pragma unroll
        for (int nt = 0; nt < 4; ++nt)
#pragma unroll
            for (int ks = 0; ks < 2; ++ks) {
                union { u32x4 u; bf16x8 hh; } f; const float* s = l2 + (size_t)(32 * ks + 8 * kg) * 768 + 64 * h + 16 * nt + n16;
                f.u.x = pk2(s[0], s[768]); f.u.y = pk2(s[2 * 768], s[3 * 768]); f.u.z = pk2(s[4 * 768], s[5 * 768]); f.u.w = pk2(s[6 * 768], s[7 * 768]);
                lf[nt][ks] = f.hh;
            }
    }
    float* cw = buf + 13312 + (wave & 1) * 384;
    if (wave >= 2) {
        const int ch = lane;
        if (wave == 2) { cw[ch] = P.cd_a0[dir * 768 + 64 * h + ch]; cw[64 + ch] = P.cd_k_k[64 * h + ch]; cw[128 + ch] = P.cd_k_a[64 * h + ch]; cw[192 + ch] = P.cd_r_k[64 * h + ch];
                         cw[256 + ch] = P.cd_mu[768 + 64 * h + ch]; cw[320 + ch] = P.cd_mu[64 * h + ch]; }
        else { cw[ch] = P.cd_w0[dir * 768 + 64 * h + ch]; cw[256 + ch] = P.cd_mu[1536 + 64 * h + ch]; cw[320 + ch] = P.cd_mu[64 * h + ch]; }
        buf[13312 + 768 + (wave - 2) * 64 + ch] = P.cd_mu[(wave == 2 ? 2432 : 2304) + 64 * dir + ch];
        asm volatile("s_waitcnt lgkmcnt(0)" ::: "memory");
    }
    auto chunk_info = [&](int c, int& seqrow0, int& len, int& t0) __attribute__((always_inline)) {
        if (c < 16) { seqrow0 = NLAT + b * CTXL; len = CTXL; t0 = dir ? 240 - 16 * c : 16 * c; }
        else { const int cc = c - 16; seqrow0 = b * SEQ; len = SEQ; t0 = dir ? SEQ - 16 - 16 * cc : 16 * cc; }
    };
    u32x4 xr[3][2], ar[3][2];
    auto issue_loads = [&](int c) __attribute__((always_inline)) {
        int seqrow0, len, t0; chunk_info(c, seqrow0, len, t0);
        const u32x4 z4 = {0u, 0u, 0u, 0u};
        { const int tok = lane >> 2, cq = lane & 3, t = t0 + tok; const bool hp = t > 0, hn = t + 1 < len;
          const bf16_t* prow = PL + (size_t)(seqrow0 + t) * CDIN + 64 * h + 16 * cq + (wave == 2 ? 768 : 1536);
#pragma unroll
          for (int j = 0; j < 2; ++j) { xr[1][j] = *(const u32x4*)(prow + 8 * j); xr[0][j] = hp ? *(const u32x4*)(prow - CDIN + 8 * j) : z4; xr[2][j] = hn ? *(const u32x4*)(prow + CDIN + 8 * j) : z4; } }
        { const int ta = t0 + n16; const bool hpa = ta > 0, hna = ta + 1 < len;
          const bf16_t* p = PL + (size_t)(seqrow0 + ta) * CDIN + (wave == 2 ? 2432 : 2304) + 64 * dir + 8 * kg;
#pragma unroll
          for (int ks = 0; ks < 2; ++ks) { ar[1][ks] = *(const u32x4*)(p + 32 * ks); ar[0][ks] = hpa ? *(const u32x4*)(p - CDIN + 32 * ks) : z4; ar[2][ks] = hna ? *(const u32x4*)(p + CDIN + 32 * ks) : z4; } }
    };
    auto produce = [&](int c) __attribute__((always_inline)) {
        int seqrow0, len, t0; chunk_info(c, seqrow0, len, t0);
        float* bb = buf + (c & 1) * 6144;
        float* scr = buf + 14336 + (wave - 2) * 1024;
        const int tok = lane >> 2, cq = lane & 3, t = t0 + tok; const bool hp = t > 0, hn = t + 1 < len;
        const bf16_t* prow = PL + (size_t)(seqrow0 + t) * CDIN + 64 * h + 16 * cq;
        const int cb = 64 * h + 16 * cq;
        const int xcol = wave == 2 ? 768 : 1536;
        const u32x4 z4 = {0u, 0u, 0u, 0u};
        u32x4 rr_[3][2];
#pragma unroll
        for (int j = 0; j < 2; ++j) { rr_[1][j] = *(const u32x4*)(prow + 8 * j); rr_[0][j] = hp ? *(const u32x4*)(prow - CDIN + 8 * j) : z4; rr_[2][j] = hn ? *(const u32x4*)(prow + CDIN + 8 * j) : z4; }
        bf16x8 af[2];
        {
            const float* mulp = buf + 13312 + 768 + (wave - 2) * 64 + 8 * kg;
#pragma unroll
            for (int ks = 0; ks < 2; ++ks) {
                const f32x4 m0 = *(const f32x4*)(mulp + 32 * ks), m1 = *(const f32x4*)(mulp + 32 * ks + 4);
                float xv[8];
#pragma unroll
                for (int e = 0; e < 4; ++e) {
                    const float a0 = lo16(ar[1][ks][e]), a1 = hi16(ar[1][ks][e]);
                    const float mu0 = e < 2 ? m0[2 * e] : m1[2 * e - 4], mu1 = e < 2 ? m0[2 * e + 1] : m1[2 * e - 3];
                    xv[2 * e] = a0 + (0.5f * (lo16(ar[0][ks][e]) + lo16(ar[2][ks][e])) - a0) * mu0;
                    xv[2 * e + 1] = a1 + (0.5f * (hi16(ar[0][ks][e]) + hi16(ar[2][ks][e])) - a1) * mu1;
                }
                if (wave == 3) {
#pragma unroll
                    for (int j = 0; j < 8; ++j) xv[j] = 1.0f - 2.0f * __builtin_amdgcn_rcpf(1.0f + __builtin_amdgcn_exp2f(2.8853900817779268f * xv[j]));
                }
                union { u32x4 u; bf16x8 hh; } f; f.u.x = pk2(xv[0], xv[1]); f.u.y = pk2(xv[2], xv[3]); f.u.z = pk2(xv[4], xv[5]); f.u.w = pk2(xv[6], xv[7]);
                af[ks] = f.hh;
            }
        }
        f32x4 acc[4];
#pragma unroll
        for (int nt = 0; nt < 4; ++nt) { acc[nt] = (f32x4){0.f, 0.f, 0.f, 0.f};
#pragma unroll
            for (int ks = 0; ks < 2; ++ks) acc[nt] = MFMA16(af[ks], lf[nt][ks], acc[nt]); }
#pragma unroll
        for (int nt = 0; nt < 4; ++nt)
#pragma unroll
            for (int rg = 0; rg < 4; ++rg) scr[(4 * kg + rg) * 64 + 16 * nt + n16] = acc[nt][rg];
        asm volatile("s_waitcnt lgkmcnt(0)" ::: "memory");
        const float* prep_ = scr + tok * 64 + 16 * cq;
        float xm[16];
        {
            const float* mux = cw + 256 + 16 * cq;
#pragma unroll
            for (int j = 0; j < 2; ++j)
#pragma unroll
                for (int e = 0; e < 4; ++e) {
                    const f32x2 mx2 = *(const f32x2*)(mux + 8 * j + 2 * e);
                    const float a0 = lo16(xr[1][j][e]), a1 = hi16(xr[1][j][e]);
                    xm[8 * j + 2 * e] = a0 + (0.5f * (lo16(xr[0][j][e]) + lo16(xr[2][j][e])) - a0) * mx2.x;
                    xm[8 * j + 2 * e + 1] = a1 + (0.5f * (hi16(xr[0][j][e]) + hi16(xr[2][j][e])) - a1) * mx2.y;
                }
        }
        float* o = bb + tok * 64 + 16 * cq;
        const float* mur = cw + 320 + 16 * cq;
        if (wave == 2) {
            float ss = 0.f, bonus = 0.f;
#pragma unroll
            for (int j = 0; j < 4; ++j) { const f32x4 kkc = *(const f32x4*)(cw + 64 + 16 * cq + 4 * j);
#pragma unroll
                for (int e = 0; e < 4; ++e) { const float kr = xm[4 * j + e] * kkc[e]; ss += kr * kr; } }
            ss = quad_sum(ss);
            const float inv = __builtin_amdgcn_rcpf(fmaxf(__builtin_amdgcn_sqrtf(ss), 1e-12f));
#pragma unroll
            for (int j = 0; j < 4; ++j) {
                asm volatile("" ::: "memory");
                const f32x4 a0 = *(const f32x4*)(cw + 16 * cq + 4 * j), kkc = *(const f32x4*)(cw + 64 + 16 * cq + 4 * j),
                            kac = *(const f32x4*)(cw + 128 + 16 * cq + 4 * j), rkc = *(const f32x4*)(cw + 192 + 16 * cq + 4 * j), mr = *(const f32x4*)(mur + 4 * j);
                const f32x4 pre = *(const f32x4*)(prep_ + 4 * j);
                f32x4 vkd, vb, vkk;
#pragma unroll
                for (int e = 0; e < 4; ++e) {
                    const int ix = 4 * j + e, jj = ix >> 3, ee = (ix & 7) >> 1; const bool hi = ix & 1;
                    const float r1 = hi ? hi16(rr_[1][jj][ee]) : lo16(rr_[1][jj][ee]), r0 = hi ? hi16(rr_[0][jj][ee]) : lo16(rr_[0][jj][ee]), r2 = hi ? hi16(rr_[2][jj][ee]) : lo16(rr_[2][jj][ee]);
                    const float r = r1 + (0.5f * (r0 + r2) - r1) * mr[e];
                    const float a = sigmoidf_(a0[e] + pre[e]);
                    const float kk = xm[ix] * kkc[e] * inv, kd = xm[ix] * (1.0f + (a - 1.0f) * kac[e]);
                    bonus += r * kd * rkc[e]; vkd[e] = kd; vb[e] = kk * a; vkk[e] = kk;
                }
                *(f32x4*)(o + 1024 + 4 * j) = vkd; *(f32x4*)(o + 2048 + 4 * j) = vb; *(f32x4*)(o + 3072 + 4 * j) = vkk;
            }
            bonus = quad_sum(bonus);
            if (c >= 16 && cq == 0 && half == 0) BON[(size_t)(seqrow0 + t) * 12 + h] = bonus;
        } else {
#pragma unroll
            for (int j = 0; j < 4; ++j) {
                asm volatile("" ::: "memory");
                const f32x4 w0 = *(const f32x4*)(cw + 16 * cq + 4 * j), mr = *(const f32x4*)(mur + 4 * j);
                const f32x4 pre = *(const f32x4*)(prep_ + 4 * j);
                f32x4 vw, vr, vv;
#pragma unroll
                for (int e = 0; e < 4; ++e) {
                    const int ix = 4 * j + e, jj = ix >> 3, ee = (ix & 7) >> 1; const bool hi = ix & 1;
                    const float r1 = hi ? hi16(rr_[1][jj][ee]) : lo16(rr_[1][jj][ee]), r0 = hi ? hi16(rr_[0][jj][ee]) : lo16(rr_[0][jj][ee]), r2 = hi ? hi16(rr_[2][jj][ee]) : lo16(rr_[2][jj][ee]);
                    vr[e] = r1 + (0.5f * (r0 + r2) - r1) * mr[e];
                    const float xs = -(w0[e] + pre[e]); const float sp = fmaxf(xs, 0.f) + 0.6931471805599453f * __builtin_amdgcn_logf(1.0f + __builtin_amdgcn_exp2f(-1.4426950408889634f * fabsf(xs)));
                    vw[e] = __builtin_amdgcn_exp2f(-1.4426950408889634f * __builtin_amdgcn_exp2f(-1.4426950408889634f * (sp + 0.5f))); vv[e] = xm[ix];
                }
                *(f32x4*)(o + 4 * j) = vw; *(f32x4*)(o + 4096 + 4 * j) = vr; *(f32x4*)(o + 5120 + 4 * j) = vv;
            }
        }
    };
    auto flush_y = [&](int c) __attribute__((always_inline)) {
        int seqrow0, len, t0; chunk_info(c, seqrow0, len, t0);
        const int p = tid - 128, tok = p >> 3, rl = (p & 7) * 4, rg = 32 * half + rl;
        const f32x4 a = *(const f32x4*)(ybuf + (c & 1) * 512 + tok * 32 + rl);
        u32x2 w; w.x = pk2(a.x, a.y); w.y = pk2(a.z, a.w);
        *(u32x2*)(Yd + (size_t)(seqrow0 + t0 + tok) * 768 + 64 * h + rg) = w;
    };
    struct SV { f32x4 kk[2], bv[2], kd[2], w[2], rr[2]; float v0, v1; };
#define SLOAD(S, TK) { const float* base_ = bb + (TK) * 64 + 8 * q8; \
        S.kk[0] = *(const f32x4*)(base_ + 3072); S.kk[1] = *(const f32x4*)(base_ + 3076); \
        S.bv[0] = *(const f32x4*)(base_ + 2048); S.bv[1] = *(const f32x4*)(base_ + 2052); S.kd[0] = *(const f32x4*)(base_ + 1024); S.kd[1] = *(const f32x4*)(base_ + 1028); \
        S.w[0] = *(const f32x4*)(base_); S.w[1] = *(const f32x4*)(base_ + 4); S.rr[0] = *(const f32x4*)(base_ + 4096); S.rr[1] = *(const f32x4*)(base_ + 4100); \
        S.v0 = bb[5 * 1024 + (TK) * 64 + r0]; S.v1 = bb[5 * 1024 + (TK) * 64 + r1]; }
#define SSTEP(S, TK) { \
        f32x2 a0 = {0.f, 0.f}, a1 = {0.f, 0.f}; \
        _Pragma("unroll") for (int j = 0; j < 4; ++j) { const f32x2 kj = {S.kk[j >> 1][2 * (j & 1)], S.kk[j >> 1][2 * (j & 1) + 1]}; a0 += S0[j] * kj; a1 += S1[j] * kj; } \
        const float sa0 = -oct_sum(a0.x + a0.y), sa1 = -oct_sum(a1.x + a1.y); \
        f32x2 y0 = {0.f, 0.f}, y1 = {0.f, 0.f}; \
        _Pragma("unroll") for (int j = 0; j < 4; ++j) { const int jj = j >> 1, e = 2 * (j & 1); \
            const f32x2 wj = {S.w[jj][e], S.w[jj][e + 1]}, bj = {S.bv[jj][e], S.bv[jj][e + 1]}, kj = {S.kd[jj][e], S.kd[jj][e + 1]}, rj = {S.rr[jj][e], S.rr[jj][e + 1]}; \
            S0[j] = S0[j] * wj + (bj * sa0 + kj * S.v0); S1[j] = S1[j] * wj + (bj * sa1 + kj * S.v1); \
            y0 += S0[j] * rj; y1 += S1[j] * rj; } \
        const float yy0 = oct_sum(y0.x + y0.y), yy1 = oct_sum(y1.x + y1.y); \
        if (q8 == 0) { yb[(TK) * 32 + (r0 & 31)] = yy0; yb[(TK) * 32 + (r1 & 31)] = yy1; } }
    auto scan_chunk = [&](int c) __attribute__((always_inline)) {
        const float* bb = buf + (c & 1) * 6144; float* yb = ybuf + (c & 1) * 512;
        const int t0s = dir ? 15 : 0, dt = dir ? -1 : 1;
        SV A, B;
        SLOAD(A, t0s)
        for (int ii = 0; ii < 16; ii += 2) {
            const int ta = t0s + dt * ii, tb = ta + dt, tc = tb + dt;
            SLOAD(B, tb)
            SSTEP(A, ta)
            if (ii + 2 < 16) SLOAD(A, tc)
            SSTEP(B, tb)
        }
    };
    if (__builtin_amdgcn_readfirstlane(wave) < 2) __builtin_amdgcn_s_setprio(2); else __builtin_amdgcn_s_setprio(1);
    if (wave >= 2) { issue_loads(0); produce(0); issue_loads(1); }
    __syncthreads();
    for (int c = 0; c < NCH; ++c) {
        if (wave < 2) { if (MODE != 1) scan_chunk(c); }
        else if (MODE != 2) {
            if (c >= 17) flush_y(c - 1);
            if (c + 1 < NCH) produce(c + 1);
            if (c + 2 < NCH) issue_loads(c + 2);
        }
        __syncthreads();
    }
    if (wave >= 2) flush_y(NCH - 1);
    __builtin_amdgcn_s_setprio(0);
    __syncthreads();
}

DI void pool_units(const Params& P, int first, int stride, unsigned char* lds) {
    const bf16_t* PL = (const bf16_t*)(P.ws + OFF_PL1); bf16_t* Y = (bf16_t*)(P.ws + OFF_H); bf16_t* AG = (bf16_t*)(P.ws + OFF_AG);
    float* pl = (float*)lds;
    const int tid = otid(), g = tid >> 6, i = tid & 63;
    float pw[64];
#pragma unroll
    for (int ii = 0; ii < 64; ++ii) pw[ii] = P.cd_pool_w[(size_t)(g * 64 + ii) * 64 + i];
    const float scale = P.cd_pool_scale[tid];
    const int wl = 1 << g, wr = 1 << g;
    float mug[8];
#pragma unroll
    for (int j = 0; j < 8; ++j) mug[j] = P.cd_mu[2560 + 8 * (tid & 15) + j];
    for (int u = first; u < NLAT / 32; u += stride) {
        const int row0 = u * 32, b = row0 >> 13, t0 = row0 & 8191;
        const bf16_t* col = PL + (size_t)(b * SEQ) * CDIN + 2688 + tid;
        __syncthreads();
        {
            int lo = t0 - wl < 0 ? 0 : t0 - wl, hi = t0 + wr > SEQ ? SEQ : t0 + wr;
            float sum = 0.f;
            for (int s = lo; s < hi; ++s) sum += bf2f(col[(size_t)s * CDIN]);
            for (int tok = 0; tok < 32; ++tok) {
                const int t = t0 + tok;
                lo = t - wl < 0 ? 0 : t - wl; hi = t + wr > SEQ ? SEQ : t + wr;
                pl[tok * 256 + tid] = sum / (float)(hi - lo) - bf2f(col[(size_t)t * CDIN]);
                if (t + wr < SEQ) sum += bf2f(col[(size_t)(t + wr) * CDIN]);
                if (t - wl >= 0) sum -= bf2f(col[(size_t)(t - wl) * CDIN]);
            }
        }
        __syncthreads();
        for (int tok = 0; tok < 32; ++tok) {
            const float* pp = pl + tok * 256 + g * 64; float acc = 0.f;
#pragma unroll
            for (int ii = 0; ii < 16; ++ii) { const f32x4 v = *(const f32x4*)(pp + 4 * ii); acc += v.x * pw[4 * ii] + v.y * pw[4 * ii + 1] + v.z * pw[4 * ii + 2] + v.w * pw[4 * ii + 3]; }
            Y[(size_t)(row0 + tok) * DM + 768 + tid] = f2bf(acc * scale);
        }
#pragma unroll
        for (int hh = 0; hh < 2; ++hh) {
            const int tok = (tid >> 4) + 16 * hh, t = t0 + tok;
            float xv[8]; mix8(PL + (size_t)(row0 + tok) * CDIN + 2560 + 8 * (tid & 15), t > 0, t + 1 < SEQ, mug, xv);
            u32x4 w; w.x = pk2(sigmoidf_(xv[0]), sigmoidf_(xv[1])); w.y = pk2(sigmoidf_(xv[2]), sigmoidf_(xv[3])); w.z = pk2(sigmoidf_(xv[4]), sigmoidf_(xv[5])); w.w = pk2(sigmoidf_(xv[6]), sigmoidf_(xv[7]));
            *(u32x4*)(AG + (size_t)(row0 + tok) * 128 + 8 * (tid & 15)) = w;
        }
    }
    __syncthreads();
}
DI void zpass_phase(const Params& P) {
    const bf16_t* PL = (const bf16_t*)(P.ws + OFF_PL1); const bf16_t* YF = (const bf16_t*)(P.ws + OFF_YF); const bf16_t* YB = (const bf16_t*)(P.ws + OFF_YB);
    const float* BON = (const float*)(P.ws + OFF_BONUS); bf16_t* Y = (bf16_t*)(P.ws + OFF_H); const bf16_t* Gt = (const bf16_t*)(P.ws + OFF_G);
    const int tid = otid(), hw = tid >> 5, i = tid & 31;
    const int stride = gridDim.x * 8;
    for (int task0 = blockIdx.x * 8 + hw; task0 < NLAT * 12; task0 += 4 * stride) {
        unsigned ya[4], yb[4]; float bon[4]; unsigned short vr[4][6];
#pragma unroll
        for (int u = 0; u < 4; ++u) {
            const int task = task0 + u * stride; const bool ok = task < NLAT * 12;
            const int row = ok ? task / 12 : 0, h = ok ? task - row * 12 : 0, t = row & 8191, c = 64 * h + 2 * i;
            ya[u] = *(const unsigned*)(YF + (size_t)row * 768 + c); yb[u] = *(const unsigned*)(YB + (size_t)row * 768 + c);
            bon[u] = BON[(size_t)row * 12 + h] + BON[(size_t)NLAT * 12 + (size_t)row * 12 + h];
            const bf16_t* pv = PL + (size_t)row * CDIN + 1536 + c;
            const unsigned cur = *(const unsigned*)pv, prv = t > 0 ? *(const unsigned*)(pv - CDIN) : 0u, nxt = t + 1 < SEQ ? *(const unsigned*)(pv + CDIN) : 0u;
            vr[u][0] = (unsigned short)(cur & 0xffff); vr[u][1] = (unsigned short)(cur >> 16); vr[u][2] = (unsigned short)(prv & 0xffff); vr[u][3] = (unsigned short)(prv >> 16);
            vr[u][4] = (unsigned short)(nxt & 0xffff); vr[u][5] = (unsigned short)(nxt >> 16);
        }
#pragma unroll
        for (int u = 0; u < 4; ++u) {
            const int task = task0 + u * stride; const bool ok = task < NLAT * 12;
            const int row = ok ? task / 12 : 0, h = ok ? task - row * 12 : 0, c = 64 * h + 2 * i;
            const float y0 = lo16(ya[u]) + lo16(yb[u]), y1 = hi16(ya[u]) + hi16(yb[u]);
            float sm = y0 + y1;
#pragma unroll
            for (int o = 16; o > 0; o >>= 1) sm += __shfl_xor(sm, o);
            const float mean = sm * (1.0f / 64.0f); const float d0 = y0 - mean, d1 = y1 - mean;
            float vs = d0 * d0 + d1 * d1;
#pragma unroll
            for (int o = 16; o > 0; o >>= 1) vs += __shfl_xor(vs, o);
            const float rs = rsqrtf(vs * (1.0f / 64.0f) + LNX_EPS);
            const float x0 = bf2f(vr[u][0]), x1 = bf2f(vr[u][1]);
            const float v0 = x0 + (0.5f * (bf2f(vr[u][2]) + bf2f(vr[u][4])) - x0) * P.cd_mu[1536 + c], v1 = x1 + (0.5f * (bf2f(vr[u][3]) + bf2f(vr[u][5])) - x1) * P.cd_mu[1536 + c + 1];
            const float z0 = d0 * rs * P.cd_lnx_w[c] + P.cd_lnx_b[c] + bon[u] * v0, z1 = d1 * rs * P.cd_lnx_w[c + 1] + P.cd_lnx_b[c + 1] + bon[u] * v1;
            const unsigned gg = *(const unsigned*)(Gt + (size_t)row * 768 + c);
            if (ok) *(unsigned*)(Y + (size_t)row * DM + c) = pk2(z0 * lo16(gg), z1 * hi16(gg));
        }
    }
}


constexpr size_t OFF_BAR = OFF_ROPE + 512 * 1024;
#define XB_TMO      128
#define XB_XCNT(j)  (256  + 64 * (j))
#define XB_XSUB(j)  (1280 + 64 * (j))
#define XB_XGEN(j)  (2304 + 64 * (j))
#define XB_TOP      3328
#define XB_TOPGEN   3392
#define XCD_BAR_WORDS 3456
#define XB_SPIN_CAP (1u << 22)
DI unsigned xb_ld(unsigned* p)              { return __hip_atomic_load(p, __ATOMIC_RELAXED, __HIP_MEMORY_SCOPE_AGENT); }
DI unsigned xb_add(unsigned* p, unsigned v) { return __hip_atomic_fetch_add(p, v, __ATOMIC_RELAXED, __HIP_MEMORY_SCOPE_AGENT); }
DI unsigned xb_xcc_id() { return (unsigned)__builtin_amdgcn_s_getreg((3 << 11) | 20) & 0xFu; }
#define XB_SPIN(cond, bar) do { unsigned _sp = 0; while (cond) { __builtin_amdgcn_s_sleep(1); \
    if ((++_sp & 255u) == 0u) { if (xb_ld(&(bar)[XB_TMO])) break; if (_sp > XB_SPIN_CAP) { atomicAdd(&(bar)[XB_TMO], 1u); break; } } } } while (0)
#define XB_GRP 192
struct XcdBar { unsigned* bar; unsigned x, nloc, nx; };
DI void group_barrier(unsigned* bar, unsigned n) {
    asm volatile("s_waitcnt vmcnt(0)" ::: "memory");
    __syncthreads();
    if (threadIdx.x == 0) {
        __builtin_amdgcn_fence(__ATOMIC_RELEASE, "agent");
        asm volatile("s_waitcnt vmcnt(0)" ::: "memory");
        (void)xb_add(&bar[XB_GRP], 1u);
        XB_SPIN(xb_ld(&bar[XB_GRP]) < n, bar);
        __builtin_amdgcn_fence(__ATOMIC_ACQUIRE, "agent");
        asm volatile("s_waitcnt vmcnt(0)" ::: "memory");
    }
    __syncthreads();
}
DI void xcd_barrier(const XcdBar& b) {
    asm volatile("s_waitcnt vmcnt(0)" ::: "memory");
    __syncthreads();
    if (threadIdx.x == 0) {
        unsigned* bar = b.bar;
        __builtin_amdgcn_s_waitcnt(0);
        const unsigned nloc = b.nloc, nx = b.nx;
        const unsigned old = xb_add(&bar[XB_XSUB(b.x)], 1u);
        const unsigned gen = old / nloc;
        if (old + 1u == (gen + 1u) * nloc) {
            __builtin_amdgcn_fence(__ATOMIC_RELEASE, "agent");
            asm volatile("s_waitcnt vmcnt(0)" ::: "memory");
            const unsigned og = xb_add(&bar[XB_TOP], 1u);
            const unsigned tg = og / nx;
            if (og + 1u == (tg + 1u) * nx) xb_add(&bar[XB_TOPGEN], 1u);
            else XB_SPIN(xb_ld(&bar[XB_TOPGEN]) == tg, bar);
            __builtin_amdgcn_fence(__ATOMIC_ACQUIRE, "agent");
            xb_add(&bar[XB_XGEN(b.x)], 1u);
            asm volatile("s_waitcnt vmcnt(0)" ::: "memory");
        } else {
            XB_SPIN(xb_ld(&bar[XB_XGEN(b.x)]) == gen, bar);
            __builtin_amdgcn_fence(__ATOMIC_ACQUIRE, "agent");
            asm volatile("s_waitcnt vmcnt(0)" ::: "memory");
        }
    }
    __syncthreads();
}

DI void scan_phase(const Params& P, unsigned char* lds, const XcdBar& xb) {
    const int G = gridDim.x;
    for (int c = blockIdx.x; c < 384; c += G) scan_chain<0>(P, c, lds);
    const bf16_t* AG = (const bf16_t*)(P.ws + OFF_AG); const bf16_t* WG2 = (const bf16_t*)(P.ws + OFF_WG2); bf16_t* Gb = (bf16_t*)(P.ws + OFF_G);
    if (G > 384 && ((G - 384) & 7) == 0) {
        if ((int)blockIdx.x >= 384) {
            pool_units(P, blockIdx.x - 384, G - 384, lds);
            group_barrier(xb.bar, (unsigned)(G - 384));
            gemm256_phase(AG, 128, WG2, 128, NLAT, 768, 128, EpiStoreBf16{Gb, 768}, lds, (int)blockIdx.x - 384, G - 384);
        }
    } else {
        pool_units(P, blockIdx.x, G, lds);
        xcd_barrier(xb);
        gemm256_phase(AG, 128, WG2, 128, NLAT, 768, 128, EpiStoreBf16{Gb, 768}, lds);
    }
}

#ifndef PHASE_MASK
#define PHASE_MASK 0xffff
#endif
#ifndef PHASE_LIMIT
#define PHASE_LIMIT 100
#endif
#ifndef REP_IDX
#define REP_IDX -1
#endif
#ifndef REP_N
#define REP_N 2
#endif
#define PH(n, idx) if ((((PHASE_MASK) >> (n)) & 1) && ((idx) < (PHASE_LIMIT) || (n) == 8))
__global__ void __launch_bounds__(256, 2) fwd_megakernel(Params P) {
    __shared__ __attribute__((aligned(16))) unsigned char lds[65536];
    cg::grid_group grid = cg::this_grid();
    XcdBar xb; xb.bar = (unsigned*)(P.ws + OFF_BAR); xb.x = xb_xcc_id();
    if (threadIdx.x == 0) (void)xb_add(&xb.bar[XB_XCNT(xb.x)], 1u);
    unsigned char* ws = P.ws;
    const float* MOD = (const float*)(ws + OFF_MOD);
    bf16_t* H = (bf16_t*)(ws + OFF_H);
    float* XLC = (float*)(ws + OFF_XLC);
    PH(0, 0) prep_phase(P, lds);
    grid.sync();
    {
        unsigned mine = 0u, cnt = 0u;
#pragma unroll
        for (unsigned j = 0; j < 16; ++j) { const unsigned c = xb_ld(&xb.bar[XB_XCNT(j)]); cnt += (c > 0u) ? 1u : 0u; mine = (j == xb.x) ? c : mine; }
        xb.nloc = __builtin_amdgcn_readfirstlane(mine > 0u ? mine : 1u); xb.nx = __builtin_amdgcn_readfirstlane(cnt > 0u ? cnt : 1u);
    }
    PH(1, 1) modfinal_phase(P);
    xcd_barrier(xb);
    PH(2, 2) rownorm_phase(P.x, P.ctx, NTOK, P.norm_gain, MOD, 0, 1, H);
    xcd_barrier(xb);
    PH(3, 3) gemm256_phase((const bf16_t*)H, DM, (const bf16_t*)(ws + OFF_WAB_IN), DM, NTOK, 1536, DM, EpiInprojL0{(bf16_t*)(ws + OFF_PL0), P.ab_q_gain, (const float*)(ws + OFF_ROPE), (const float*)(ws + OFF_ROPE) + 2048, P.ab_k_gain, (bf16_t*)(ws + OFF_KB), (bf16_t*)(ws + OFF_VT)}, lds);
    xcd_barrier(xb);
    PH(5, 5) attn_phase(P, lds);
#if REP_IDX == 5
    { xcd_barrier(xb); attn_phase(P, lds); }
#endif
    xcd_barrier(xb);
    PH(3, 6) gemm256_phase((const bf16_t*)H, DM, (const bf16_t*)(ws + OFF_WAB_OUT), DM, NTOK, DM, DM, EpiResidual{P.x, P.ctx, P.out, XLC, MOD, 2}, lds);
    xcd_barrier(xb);
    PH(2, 7) rownorm_phase(P.out, XLC, NTOK, P.norm_gain + 1024, MOD, 3, 4, H);
    xcd_barrier(xb);
    PH(3, 8) gemm256_phase((const bf16_t*)H, DM, (const bf16_t*)(ws + OFF_WFFN_IN), DM, NTOK, 5632, DM, EpiSwiglu{(bf16_t*)(ws + OFF_HID)}, lds);
#if REP_IDX == 8
    { xcd_barrier(xb); gemm256_phase((const bf16_t*)H, DM, (const bf16_t*)(ws + OFF_WFFN_IN), DM, NTOK, 5632, DM, EpiSwiglu{(bf16_t*)(ws + OFF_HID)}, lds); }
#endif
    xcd_barrier(xb);
    PH(3, 9) gemm256_phase((const bf16_t*)(ws + OFF_HID), FFH, (const bf16_t*)(ws + OFF_WFFN_OUT), FFH, NTOK, DM, FFH, EpiResidual{P.out, XLC, P.out, XLC, MOD, 5}, lds);
    xcd_barrier(xb);
    const float* MOD1 = MOD + 9 * 6144;
    PH(2, 10) rownorm_phase(P.out, XLC, NTOK, P.norm_gain + 2048, MOD1, 0, 1, H);
    xcd_barrier(xb);
    PH(3, 11) gemm256_phase((const bf16_t*)H, DM, (const bf16_t*)(ws + OFF_WCD_IN), DM, NTOK, 3072, DM, EpiStoreBf16{(bf16_t*)(ws + OFF_PL1), CDIN}, lds);
    xcd_barrier(xb);
    PH(6, 12) scan_phase(P, lds, xb);
#if REP_IDX == 12
    { xcd_barrier(xb); scan_phase(P, lds, xb); }
#endif
    xcd_barrier(xb);
    PH(7, 13) zpass_phase(P);
    xcd_barrier(xb);
    PH(3, 15) gemm256_phase((const bf16_t*)H, DM, (const bf16_t*)(ws + OFF_WCD_OUT), DM, NLAT, DM, DM, EpiResidual{P.out, XLC, P.out, XLC, MOD1, 2}, lds);
    xcd_barrier(xb);
    PH(2, 16) rownorm_phase(P.out, XLC, NLAT, P.norm_gain + 3072, MOD1, 3, 4, H);
    xcd_barrier(xb);
    PH(3, 17) gemm256_phase((const bf16_t*)H, DM, (const bf16_t*)(ws + OFF_WFFN_IN + WFFN_IN_SZ), DM, NLAT, 5632, DM, EpiSwiglu{(bf16_t*)(ws + OFF_HID)}, lds);
    xcd_barrier(xb);
    PH(3, 18) gemm256_phase((const bf16_t*)(ws + OFF_HID), FFH, (const bf16_t*)(ws + OFF_WFFN_OUT + WFFN_OUT_SZ), FFH, NLAT, DM, FFH, EpiResidual{P.out, XLC, P.out, XLC, MOD1, 5}, lds);
    xcd_barrier(xb);
    PH(8, 19) finalnorm_phase(P);
}

extern "C" void kernel_launch(void* const* d_in, const int* in_sizes, int n_in, void* d_out, int out_size, void* d_ws, size_t ws_size, hipStream_t stream) {
    static int grid_blocks = 0;
    if (!grid_blocks) {
        int dev = 0, cus = 0, per_cu = 0;
        hipGetDevice(&dev);
        hipDeviceGetAttribute(&cus, hipDeviceAttributeMultiprocessorCount, dev);
        hipOccupancyMaxActiveBlocksPerMultiprocessor(&per_cu, (const void*)fwd_megakernel, 256, 0);
        if (per_cu < 1) per_cu = 1;
        if (per_cu > 2) per_cu = 2;
        grid_blocks = cus * per_cu;
    }
    Params p{};
    const float** pp = (const float**)&p;
    for (int i = 0; i < 30; ++i) pp[i] = (const float*)d_in[i];
    p.out = (float*)d_out; p.ws = (unsigned char*)d_ws;
    (void)hipMemsetAsync((unsigned char*)d_ws + OFF_BAR, 0, XCD_BAR_WORDS * 4, stream);
    void* args[] = {&p};
    hipError_t e = hipLaunchCooperativeKernel((const void*)fwd_megakernel, dim3(grid_blocks), dim3(256), args, 0, stream);
    if (e != hipSuccess) fprintf(stderr, "cooperative launch failed: %s (grid %d)\n", hipGetErrorString(e), grid_blocks);
}
```
